# Optimizing an MI355X kernel written in HIP

```python
import math
import jax, jax.numpy as jnp
from jax import lax
import numpy as np

D_MODEL = 1024
BATCH = 8
SEQ = 4096
DEPTH = 4

N_MEM = 256
MIX_WIDTH = D_MODEL
N_GROUPS = 4
GROUP_WIDTH = MIX_WIDTH // N_GROUPS
CONF_WIDTH = 31
HG_HEADS = 4
HG_DK = GROUP_WIDTH // HG_HEADS
HG_DV = GROUP_WIDTH // HG_HEADS
HG_CHUNK = 64
SC_WIDTH = 3
MLA_HEADS = 4
MLA_NOPE = 64
MLA_ROPE = 32
MLA_V = GROUP_WIDTH // MLA_HEADS
MLA_Q_LORA = 256
MLA_KV_LORA = 128
ROPE_BASE = 10000.0
Q_BLOCK = 128
XA_HEADS = 4
XA_HEAD_DIM = 64
D_FF = -(-8 * D_MODEL // (3 * 256)) * 256
EPS = 1e-6
A_COLS = 2 * GROUP_WIDTH
B_COLS = 5 * GROUP_WIDTH
C_COLS = 3 * GROUP_WIDTH
D_COLS = MLA_Q_LORA + MLA_KV_LORA + MLA_ROPE
IN_COLS = A_COLS + B_COLS + C_COLS + D_COLS
SPLITS = [A_COLS, A_COLS + B_COLS, A_COLS + B_COLS + C_COLS]

kernel_name = "hybrid_parallel_group_encoder"


def rms_norm(x, g):
    xf = x.astype(jnp.float32)
    y = xf * lax.rsqrt(jnp.mean(xf * xf, axis=-1, keepdims=True) + EPS)
    return (y * g.astype(jnp.float32)).astype(x.dtype)


def layer_norm(x, g, b):
    xf = x.astype(jnp.float32)
    mu = jnp.mean(xf, axis=-1, keepdims=True)
    xc = xf - mu
    y = xc * lax.rsqrt(jnp.mean(xc * xc, axis=-1, keepdims=True) + EPS)
    return (y * g.astype(jnp.float32) + b.astype(jnp.float32)).astype(x.dtype)


def depthwise_conv(x, w, b):
    c = x.shape[-1]
    y = lax.conv_general_dilated(x, w[:, None, :].astype(x.dtype), window_strides=(1,),
                                 padding='SAME', dimension_numbers=('NWC', 'WIO', 'NWC'),
                                 feature_group_count=c)
    return y + b.astype(x.dtype)


def rope_tables(positions):
    inv = ROPE_BASE ** (-jnp.arange(0, MLA_ROPE, 2, dtype=jnp.float32) / MLA_ROPE)
    ang = positions.astype(jnp.float32)[..., None] * inv
    return jnp.cos(ang)[:, :, None, :], jnp.sin(ang)[:, :, None, :]


def apply_rope(x, cos, sin):
    x1, x2 = jnp.split(x, 2, axis=-1)
    return jnp.concatenate([x1 * cos - x2 * sin, x2 * cos + x1 * sin], axis=-1).astype(x.dtype)


def blocked_attention(q, k, v):
    b, s, h, d = q.shape
    scale = d ** -0.5
    qb = q.reshape(b, s // Q_BLOCK, Q_BLOCK, h, d).transpose(1, 0, 2, 3, 4)

    def one_block(qblk):
        sc = jnp.einsum('bqhd,bkhd->bhqk', qblk, k).astype(jnp.float32) * scale
        p = jax.nn.softmax(sc, axis=-1)
        return jnp.einsum('bhqk,bkhe->bqhe', p.astype(v.dtype), v)

    out = lax.map(one_block, qb)
    return out.transpose(1, 0, 2, 3, 4).reshape(b, s, h, v.shape[-1])


def conformer_conv(ua, dw_w, dw_b, ln_g, ln_b):
    a, gate = jnp.split(ua, 2, axis=-1)
    h = a * jax.nn.sigmoid(gate)
    h = depthwise_conv(h, dw_w, dw_b)
    h = layer_norm(h, ln_g, ln_b)
    return jax.nn.silu(h)


def hgrn2_bidir(ub, lb_fwd, lb_bwd, onorm_g):
    b, s, _ = ub.shape
    f32 = jnp.float32
    q, zf, zb, v, g = jnp.split(ub, 5, axis=-1)

    def log_forget(z, lb):
        zf32 = z.astype(f32)
        return jnp.log(jax.nn.sigmoid(zf32) + lb * jax.nn.sigmoid(-zf32))

    rev = lambda t: t[:, ::-1]
    logf = jnp.stack([log_forget(zf, lb_fwd), log_forget(rev(zb), lb_bwd)])
    qd = jnp.stack([q, rev(q)]).astype(f32)
    vd = jnp.stack([v, rev(v)]).astype(f32)
    n_chunks = s // HG_CHUNK

    def to_chunks(t, d):
        return t.reshape(2, b, n_chunks, HG_CHUNK, HG_HEADS, d).transpose(2, 0, 1, 4, 3, 5)

    mask = jnp.tril(jnp.ones((HG_CHUNK, HG_CHUNK), dtype=f32))[..., None]

    def step(state, inp):
        qc, lfc, vc = inp
        bcum = jnp.cumsum(lfc, axis=-2)
        kc = -jnp.expm1(lfc)
        o_inter = jnp.einsum('zbhcd,zbhde->zbhce', qc * jnp.exp(bcum), state)
        diff = bcum[..., :, None, :] - bcum[..., None, :, :]
        decay = jnp.exp(diff * mask) * mask
        attn = jnp.sum(qc[..., :, None, :] * kc[..., None, :, :] * decay, axis=-1)
        o_intra = jnp.einsum('zbhts,zbhse->zbhte', attn, vc)
        blast = bcum[..., -1:, :]
        new_state = jnp.exp(blast[..., 0, :])[..., :, None] * state + \
            jnp.einsum('zbhsd,zbhse->zbhde', kc * jnp.exp(blast - bcum), vc)
        return new_state, o_inter + o_intra

    init = jnp.zeros((2, b, HG_HEADS, HG_DK, HG_DV), f32)
    _, ys = lax.scan(step, init, (to_chunks(qd, HG_DK), to_chunks(logf, HG_DK), to_chunks(vd, HG_DV)))
    ys = ys.transpose(1, 2, 0, 4, 3, 5).reshape(2, b, s, HG_HEADS, HG_DV)
    o = ys[0] + ys[1][:, ::-1]
    o = rms_norm(o, onorm_g.reshape(HG_HEADS, HG_DV)) * \
        jax.nn.silu(g.astype(f32)).reshape(b, s, HG_HEADS, HG_DV)
    return o.reshape(b, s, GROUP_WIDTH).astype(ub.dtype)


def short_gated_conv(uc, dw_w, dw_b):
    gb, gc, xin = jnp.split(uc, 3, axis=-1)
    return gb * depthwise_conv(gc * xin, dw_w, dw_b)


def mla(ud, cos, sin, qa_g, wuq, kva_g, wukv, qn_g, kn_g):
    b, s, _ = ud.shape
    cq, ckv, kr = jnp.split(ud, [MLA_Q_LORA, MLA_Q_LORA + MLA_KV_LORA], axis=-1)
    q = (rms_norm(cq, qa_g) @ wuq).reshape(b, s, MLA_HEADS, MLA_NOPE + MLA_ROPE)
    kv = (rms_norm(ckv, kva_g) @ wukv).reshape(b, s, MLA_HEADS, MLA_NOPE + MLA_V)
    k_nope, v = jnp.split(kv, [MLA_NOPE], axis=-1)
    k = jnp.concatenate([k_nope, jnp.broadcast_to(kr[:, :, None, :], (b, s, MLA_HEADS, MLA_ROPE))], axis=-1)
    q = rms_norm(q, qn_g)
    k = rms_norm(k, kn_g)
    q = jnp.concatenate([q[..., :MLA_NOPE], apply_rope(q[..., MLA_NOPE:], cos, sin)], axis=-1)
    k = jnp.concatenate([k[..., :MLA_NOPE], apply_rope(k[..., MLA_NOPE:], cos, sin)], axis=-1)
    return blocked_attention(q, k, v).reshape(b, s, MLA_HEADS * MLA_V)


def setup_inputs(seed: int = 0) -> dict:
    key = jax.random.key(seed)
    ks = iter(jax.random.split(key, 40))
    L = DEPTH
    f32 = jnp.float32

    def nrm(shape, fan_in):
        return jax.random.normal(next(ks), shape, f32) * fan_in ** -0.5

    def gain(shape):
        return 1.0 + 0.01 * jax.random.normal(next(ks), shape, f32)

    def bias(shape):
        return 0.01 * jax.random.normal(next(ks), shape, f32)

    x = jax.random.normal(next(ks), (BATCH, SEQ, D_MODEL), f32)
    mem = jax.random.normal(next(ks), (BATCH, N_MEM, D_MODEL), f32)
    positions = jnp.arange(SEQ, dtype=jnp.int32)[None, :] + \
        jax.random.randint(next(ks), (BATCH, 1), 0, 1024, dtype=jnp.int32)
    return {
        "x": x,
        "mem": mem,
        "positions": positions,
        "g_mix": gain((L, D_MODEL)),
        "w_in": nrm((L, D_MODEL, IN_COLS), D_MODEL),
        "a_dw_w": nrm((L, CONF_WIDTH, GROUP_WIDTH), CONF_WIDTH),
        "a_dw_b": bias((L, GROUP_WIDTH)),
        "a_ln_g": gain((L, GROUP_WIDTH)),
        "a_ln_b": bias((L, GROUP_WIDTH)),
        "h_gamma": 0.5 * jax.random.normal(next(ks), (2, L, GROUP_WIDTH), f32),
        "h_onorm_g": gain((L, GROUP_WIDTH)),
        "c_dw_w": nrm((L, SC_WIDTH, GROUP_WIDTH), SC_WIDTH),
        "c_dw_b": bias((L, GROUP_WIDTH)),
        "m_qa_g": gain((L, MLA_Q_LORA)),
        "m_wuq": nrm((L, MLA_Q_LORA, MLA_HEADS * (MLA_NOPE + MLA_ROPE)), MLA_Q_LORA),
        "m_kva_g": gain((L, MLA_KV_LORA)),
        "m_wukv": nrm((L, MLA_KV_LORA, MLA_HEADS * (MLA_NOPE + MLA_V)), MLA_KV_LORA),
        "m_qn_g": gain((L, MLA_NOPE + MLA_ROPE)),
        "m_kn_g": gain((L, MLA_NOPE + MLA_ROPE)),
        "g_branch": gain((L, MIX_WIDTH)),
        "w_out": nrm((L, MIX_WIDTH, D_MODEL), MIX_WIDTH),
        "g_xq": gain((L, D_MODEL)),
        "g_mem": gain((L, D_MODEL)),
        "x_wq": nrm((L, D_MODEL, XA_HEADS * XA_HEAD_DIM), D_MODEL),
        "x_wkv": nrm((L, D_MODEL, 2 * XA_HEADS * XA_HEAD_DIM), D_MODEL),
        "x_qn_g": gain((L, XA_HEAD_DIM)),
        "x_kn_g": gain((L, XA_HEAD_DIM)),
        "x_wo": nrm((L, XA_HEADS * XA_HEAD_DIM, D_MODEL), XA_HEADS * XA_HEAD_DIM),
        "g_ffn": gain((L, D_MODEL)),
        "f_w13": nrm((L, D_MODEL, 2 * D_FF), D_MODEL),
        "f_w2": nrm((L, D_FF, D_MODEL), D_FF),
    }


def reference(x, mem, positions, g_mix, w_in, a_dw_w, a_dw_b, a_ln_g, a_ln_b, h_gamma, h_onorm_g,
              c_dw_w, c_dw_b, m_qa_g, m_wuq, m_kva_g, m_wukv, m_qn_g, m_kn_g, g_branch, w_out,
              g_xq, g_mem, x_wq, x_wkv, x_qn_g, x_kn_g, x_wo, g_ffn, f_w13, f_w2):
    b, s, _ = x.shape
    n_mem = mem.shape[1]
    cos, sin = rope_tables(positions)
    p = jax.nn.softmax(h_gamma.astype(jnp.float32), axis=1)
    lower = jnp.cumsum(p, axis=1) - p[:, :1]
    for l in range(DEPTH):
        n = rms_norm(x, g_mix[l])
        u = n @ w_in[l]
        ua, ub, uc, ud = jnp.split(u, SPLITS, axis=-1)
        y_a = conformer_conv(ua, a_dw_w[l], a_dw_b[l], a_ln_g[l], a_ln_b[l])
        y_b = hgrn2_bidir(ub, lower[0, l], lower[1, l], h_onorm_g[l])
        y_c = short_gated_conv(uc, c_dw_w[l], c_dw_b[l])
        y_d = mla(ud, cos, sin, m_qa_g[l], m_wuq[l], m_kva_g[l], m_wukv[l], m_qn_g[l], m_kn_g[l])
        cat = jnp.concatenate([y_a, y_b, y_c, y_d], axis=-1).reshape(b, s, N_GROUPS, GROUP_WIDTH)
        cat = rms_norm(cat, g_branch[l].reshape(N_GROUPS, GROUP_WIDTH)).reshape(b, s, MIX_WIDTH)
        x = x + cat @ w_out[l]
        hq = rms_norm(x, g_xq[l])
        mn = rms_norm(mem, g_mem[l])
        q = (hq @ x_wq[l]).reshape(b, s, XA_HEADS, XA_HEAD_DIM)
        kv = (mn @ x_wkv[l]).reshape(b, n_mem, XA_HEADS, 2 * XA_HEAD_DIM)
        k, v = jnp.split(kv, 2, axis=-1)
        q = rms_norm(q, x_qn_g[l])
        k = rms_norm(k, x_kn_g[l])
        o = blocked_attention(q, k, v).reshape(b, s, XA_HEADS * XA_HEAD_DIM)
        x = x + o @ x_wo[l]
        h = rms_norm(x, g_ffn[l])
        a1, a3 = jnp.split(h @ f_w13[l], 2, axis=-1)
        x = x + (jax.nn.silu(a1) * a3) @ f_w2[l]
    return x
```

```cpp
#include <hip/hip_runtime.h>
#include <hip/hip_cooperative_groups.h>
#include <cstdio>
#include <cstdint>
namespace cg = cooperative_groups;

#ifndef MEGA
#define MEGA 1
#endif

typedef unsigned short bf16_t;
typedef short bf16x8 __attribute__((ext_vector_type(8)));
typedef float f32x4 __attribute__((ext_vector_type(4)));
typedef unsigned u32x4 __attribute__((ext_vector_type(4)));
typedef unsigned u32x2 __attribute__((ext_vector_type(2)));

#define DI __device__ __forceinline__
#define MFMA16(a, b, c) __builtin_amdgcn_mfma_f32_16x16x32_bf16((a), (b), (c), 0, 0, 0)

constexpr int T_TOK = 32768, SEQ = 4096, NB = 8, DM = 1024, NL = 4;
constexpr int UC = 3072;
constexpr int INC = 2976;
constexpr int DFF = 2816;
constexpr float EPS = 1e-6f;
constexpr int LDS_BYTES = 73728;
constexpr int LDS_ALLOC = 2 * LDS_BYTES + 16;

constexpr size_t SZ_W = 13533184ull * 2;
constexpr size_t OFF_W = 0;
constexpr size_t OFF_XWKV = OFF_W + SZ_W;
constexpr size_t OFF_XB = OFF_XWKV + 4ull * 512 * 1024 * 2;
constexpr size_t OFF_MEMB = OFF_XB + (size_t)T_TOK * 1024 * 2;
constexpr size_t OFF_U = OFF_MEMB + 2048ull * 1024 * 2;
constexpr size_t OFF_CAT = OFF_U + (size_t)T_TOK * UC * 2;
constexpr size_t OFF_MQ = OFF_CAT + (size_t)T_TOK * 1024 * 2;
constexpr size_t OFF_MK = OFF_MQ + (size_t)T_TOK * 384 * 2;
constexpr size_t OFF_MVT = OFF_MK + (size_t)T_TOK * 384 * 2;
constexpr size_t OFF_HST = OFF_MVT + (size_t)T_TOK * 256 * 2;
constexpr size_t OFF_HDEC = OFF_HST + 64ull * 64 * 4096 * 4;
constexpr size_t OFF_XK = OFF_HDEC + 64ull * 64 * 64 * 4;
constexpr size_t OFF_XVT = OFF_XK + 4ull * 8 * 4 * 256 * 64 * 2;
constexpr size_t OFF_ROPE = OFF_XVT + 4ull * 8 * 4 * 256 * 64 * 2;
constexpr size_t OFF_ROWSQ = OFF_ROPE + (size_t)T_TOK * 16 * 2 * 4;
constexpr size_t OFF_MEMSQ = OFF_ROWSQ + (size_t)T_TOK * 16 * 4;
constexpr size_t OFF_SSQB = OFF_MEMSQ + 2048 * 4;
constexpr size_t OFF_SSQD = OFF_SSQB + (size_t)T_TOK * 4 * 4;
constexpr size_t WS_BAR = OFF_SSQD + (size_t)T_TOK * 4 * 4;
constexpr size_t WS_END = WS_BAR + 16384;
constexpr size_t OFF_QRAW = OFF_XB;
constexpr size_t OFF_KVRAW = OFF_XB + (size_t)T_TOK * 384 * 2;
constexpr size_t OFF_KVMEM = OFF_MQ;
constexpr size_t OFF_XQ = OFF_U;
constexpr size_t OFF_XO = OFF_U + (size_t)T_TOK * 256 * 2;
constexpr size_t OFF_HFF = OFF_U;
constexpr size_t W_IN = 0, W_OUT = 3145728, W_UQ = 4194304, W_UKV = 4292608, W_XQ = 4358144, W_XO = 4620288, W_13 = 4882432, W_2 = 10649600;

enum { I_X = 0, I_MEM, I_POS, I_GMIX, I_WIN, I_ADWW, I_ADWB, I_ALNG, I_ALNB, I_HGAM, I_HONG, I_CDWW, I_CDWB, I_MQAG, I_MWUQ, I_MKVAG,
       I_MWUKV, I_MQNG, I_MKNG, I_GBR, I_WOUT, I_GXQ, I_GMEM, I_XWQ, I_XWKV, I_XQNG, I_XKNG, I_XWO, I_GFFN, I_W13, I_W2, N_IN };

struct Params {
    const float* in[N_IN];
    float* out;
    unsigned char* ws;
    int ph_lo, ph_hi;
    int layer, pad;
};

typedef __bf16 bf2_t __attribute__((ext_vector_type(2)));
typedef float f2_t __attribute__((ext_vector_type(2)));
DI unsigned cvt_pk(float lo, float hi) { f2_t v = {lo, hi}; bf2_t b = __builtin_convertvector(v, bf2_t); return __builtin_bit_cast(unsigned, b); }
DI bf16_t f2bf(float x) { return (bf16_t)(cvt_pk(x, 0.f) & 0xffffu); }
DI float bf2f(bf16_t h) { return __uint_as_float(((unsigned)h) << 16); }
DI float bflo(unsigned w) { return __uint_as_float(w << 16); }
DI float bfhi(unsigned w) { return __uint_as_float(w & 0xffff0000u); }
DI float sigmoidf_(float x) { return __builtin_amdgcn_rcpf(1.f + __expf(-x)); }
DI int tidx() { int t = threadIdx.x & 255; asm volatile("" : "+v"(t)); return t; }
DI float wave_sum(float v) {
#pragma unroll
    for (int o = 32; o > 0; o >>= 1) v += __shfl_xor(v, o);
    return v;
}

DI int sw_off(int row, int chunk) { return row * 128 + ((chunk ^ ((row >> 1) & 7)) << 4); }

DI void scale_chunk(uint4& v, float s) {
    v.x = cvt_pk(bflo(v.x) * s, bfhi(v.x) * s); v.y = cvt_pk(bflo(v.y) * s, bfhi(v.y) * s);
    v.z = cvt_pk(bflo(v.z) * s, bfhi(v.z) * s); v.w = cvt_pk(bflo(v.w) * s, bfhi(v.w) * s);
}

template <bool ASC>
DI void gemm_mainloop(const bf16_t* __restrict__ A, int lda, const bf16_t* __restrict__ Bt, int K, int row0, int col0,
                      unsigned char* smem, f32x4 (&acc)[4][4]) {
    const int tid = tidx(), lane = tid & 63, w = tid >> 6, wr = w >> 1, wc = w & 1, l15 = lane & 15, quad = lane >> 4;
    const int lr = tid >> 3, lc = tid & 7;
    const bf16_t* Ap = A + (size_t)(row0 + lr) * lda + lc * 8;
    const bf16_t* Bp = Bt + (size_t)(col0 + lr) * K + lc * 8;
    const size_t as1 = (size_t)32 * lda, bs1 = (size_t)32 * K;
    const float* asc = (const float*)(smem + 66048);
    uint4 ra0, ra1, ra2, ra3, rb0, rb1, rb2, rb3;
#define G_LOAD(ko) do { ra0 = *(const uint4*)(Ap + (ko)); ra1 = *(const uint4*)(Ap + as1 + (ko)); ra2 = *(const uint4*)(Ap + 2 * as1 + (ko)); ra3 = *(const uint4*)(Ap + 3 * as1 + (ko)); \
                        rb0 = *(const uint4*)(Bp + (ko)); rb1 = *(const uint4*)(Bp + bs1 + (ko)); rb2 = *(const uint4*)(Bp + 2 * bs1 + (ko)); rb3 = *(const uint4*)(Bp + 3 * bs1 + (ko)); } while (0)
#define G_STORE(buf) do { unsigned char* Ad_ = smem + (buf) * 16384; unsigned char* Bd_ = smem + 32768 + (buf) * 16384; const int o_ = sw_off(lr, lc); \
                          *(uint4*)(Ad_ + o_) = ra0; *(uint4*)(Ad_ + o_ + 4096) = ra1; *(uint4*)(Ad_ + o_ + 8192) = ra2; *(uint4*)(Ad_ + o_ + 12288) = ra3; \
                          *(uint4*)(Bd_ + o_) = rb0; *(uint4*)(Bd_ + o_ + 4096) = rb1; *(uint4*)(Bd_ + o_ + 8192) = rb2; *(uint4*)(Bd_ + o_ + 12288) = rb3; } while (0)
    const int plc = (tid & 7) ^ ((tid >> 4) & 7);
    const bf16_t* Adp = A + (size_t)(row0 + lr) * lda + plc * 8;
    const bf16_t* Bdp = Bt + (size_t)(col0 + lr) * K + plc * 8;
#define D_STAGE(buf, ko) do { _Pragma("unroll") for (int i_ = 0; i_ < 4; ++i_) { \
        __builtin_amdgcn_global_load_lds((const unsigned*)(Adp + i_ * as1 + (ko)), (unsigned*)(smem + (buf) * 16384 + i_ * 4096 + tid * 16), 16, 0, 0); \
        __builtin_amdgcn_global_load_lds((const unsigned*)(Bdp + i_ * bs1 + (ko)), (unsigned*)(smem + 32768 + (buf) * 16384 + i_ * 4096 + tid * 16), 16, 0, 0); } } while (0)
    if (ASC) { G_LOAD(0); } else { D_STAGE(0, 0); }
#pragma unroll
    for (int m = 0; m < 4; ++m)
#pragma unroll
        for (int n = 0; n < 4; ++n) acc[m][n] = (f32x4){0.f, 0.f, 0.f, 0.f};
    if (ASC) { G_STORE(0); }
    __syncthreads();
    const int nk = K >> 6;
    for (int kt = 0; kt < nk; ++kt) {
        const int cur = kt & 1;
        const bool more = (kt + 1 < nk);
        if (more) { const int ko = (kt + 1) * 64; if (ASC) { G_LOAD(ko); } else { D_STAGE(cur ^ 1, ko); } }
        __builtin_amdgcn_sched_barrier(0);
        const unsigned char* As = smem + cur * 16384;
        const unsigned char* Bs = smem + 32768 + cur * 16384;
#pragma unroll
        for (int ks = 0; ks < 2; ++ks) {
            bf16x8 af[4], bfv[4];
#pragma unroll
            for (int m = 0; m < 4; ++m) af[m] = *(const bf16x8*)(As + sw_off(wr * 64 + m * 16 + l15, ks * 4 + quad));
#pragma unroll
            for (int n = 0; n < 4; ++n) bfv[n] = *(const bf16x8*)(Bs + sw_off(wc * 64 + n * 16 + l15, ks * 4 + quad));
#pragma unroll
            for (int m = 0; m < 4; ++m)
#pragma unroll
                for (int n = 0; n < 4; ++n) acc[m][n] = MFMA16(bfv[n], af[m], acc[m][n]);
        }
        __builtin_amdgcn_sched_barrier(0);
        if (ASC && more) {
            const int grp = ((kt + 1) * 64) >> 8;
            if (grp & 1) {
                const int which = grp >> 1;
                scale_chunk(ra0, asc[lr * 2 + which]); scale_chunk(ra1, asc[(lr + 32) * 2 + which]);
                scale_chunk(ra2, asc[(lr + 64) * 2 + which]); scale_chunk(ra3, asc[(lr + 96) * 2 + which]);
            }
            G_STORE(cur ^ 1);
        }
        __syncthreads();
    }
#undef G_LOAD
#undef G_STORE
#undef D_STAGE
}

DI void tile_order(int L, int nM, int nN, int& pm, int& pn) {
    const int nwg = nM * nN;
    int wgid = L;
    { const int q = nwg / 8, r = nwg % 8, xcd = wgid % 8, off = wgid / 8; wgid = (xcd < r ? xcd * (q + 1) : r * (q + 1) + (xcd - r) * q) + off; }
    const int WGM = 8;
    const int nig = WGM * nN, gid = wgid / nig, fm = gid * WGM, gsz = (nM - fm) < WGM ? (nM - fm) : WGM;
    pm = fm + ((wgid % nig) % gsz); pn = (wgid % nig) / gsz;
}

DI void fill_rs(unsigned char* smem, const float* part, int npart, int row0, float inv_n) {
    float* rs = (float*)(smem + 65536);
    const int tid = tidx();
    if (tid < 128) {
        float s = 0.f;
        for (int i = 0; i < npart; ++i) s += part[(size_t)(row0 + tid) * npart + i];
        rs[tid] = __builtin_amdgcn_rsqf(s * inv_n + EPS);
    }
}

DI void epi_bf16(const f32x4 (&acc)[4][4], bf16_t* O, int ldo, int row0, int col0, const float* rs) {
    const int lane = tidx() & 63, w = tidx() >> 6, wr = w >> 1, wc = w & 1, l15 = lane & 15, quad = lane >> 4;
#pragma unroll
    for (int m = 0; m < 4; ++m) {
        const int rl = wr * 64 + m * 16 + l15;
        const float sc = rs ? rs[rl] : 1.f;
        bf16_t* rowp = O + (size_t)(row0 + rl) * ldo + col0 + wc * 64 + quad * 4;
#pragma unroll
        for (int n = 0; n < 4; ++n) {
            u32x2 v; v.x = cvt_pk(acc[m][n][0] * sc, acc[m][n][1] * sc); v.y = cvt_pk(acc[m][n][2] * sc, acc[m][n][3] * sc);
            *(u32x2*)(rowp + n * 16) = v;
        }
    }
}
DI void epi_resid(const f32x4 (&acc)[4][4], float* X, bf16_t* XB, float* rowsq, int row0, int col0) {
    const int lane = tidx() & 63, w = tidx() >> 6, wr = w >> 1, wc = w & 1, l15 = lane & 15, quad = lane >> 4;
    const int pn = col0 >> 7;
#pragma unroll
    for (int m = 0; m < 4; ++m) {
        const int row = row0 + wr * 64 + m * 16 + l15;
        float ss = 0.f;
#pragma unroll
        for (int n = 0; n < 4; ++n) {
            const int col = col0 + wc * 64 + n * 16 + quad * 4;
            float4* xp = (float4*)(X + (size_t)row * DM + col);
            float4 xv = *xp;
            xv.x += acc[m][n][0]; xv.y += acc[m][n][1]; xv.z += acc[m][n][2]; xv.w += acc[m][n][3];
            *xp = xv;
            u32x2 v; v.x = cvt_pk(xv.x, xv.y); v.y = cvt_pk(xv.z, xv.w);
            *(u32x2*)(XB + (size_t)row * DM + col) = v;
            ss += xv.x * xv.x + xv.y * xv.y + xv.z * xv.z + xv.w * xv.w;
        }
        ss += __shfl_xor(ss, 16); ss += __shfl_xor(ss, 32);
        if (quad == 0) rowsq[(size_t)row * 16 + pn * 2 + wc] = ss;
    }
}
DI void epi_swiglu(const f32x4 (&acc)[4][4], bf16_t* H, int row0, int col0, const float* rs) {
    const int lane = tidx() & 63, w = tidx() >> 6, wr = w >> 1, wc = w & 1, l15 = lane & 15, quad = lane >> 4;
#pragma unroll
    for (int m = 0; m < 4; ++m) {
        const int rl = wr * 64 + m * 16 + l15;
        const float sc = rs[rl];
        bf16_t* rowp = H + (size_t)(row0 + rl) * DFF + ((col0 + wc * 64) >> 1) + quad * 4;
#pragma unroll
        for (int np = 0; np < 2; ++np) {
            float h[4];
#pragma unroll
            for (int j = 0; j < 4; ++j) { const float a1 = acc[m][2 * np][j] * sc, a3 = acc[m][2 * np + 1][j] * sc; h[j] = a1 * sigmoidf_(a1) * a3; }
            u32x2 v; v.x = cvt_pk(h[0], h[1]); v.y = cvt_pk(h[2], h[3]);
            *(u32x2*)(rowp + np * 16) = v;
        }
    }
}

DI void conv_tile(const float* __restrict__ src, int K, int N, int Npad, const float* __restrict__ gain, int perm, bf16_t* __restrict__ dst, int tile, unsigned char* smem) {
    float* lds = (float*)smem;
    const int nkt = K >> 6, kt = tile % nkt, nt = tile / nkt, k0 = kt * 64, n0 = nt * 64;
    const int tid = tidx(), nl = tid & 63, kq = tid >> 6;
    const int R = n0 + nl;
    int sc = R;
    if (perm == 1) { const int g = R >> 5, j = R & 31; sc = (j < 16) ? (16 * g + j) : (DFF + 16 * g + j - 16); }
    const bool ok = R < N;
#pragma unroll
    for (int i = 0; i < 16; ++i) { const int kl = kq + 4 * i; lds[kl * 65 + nl] = ok ? src[(size_t)(k0 + kl) * N + sc] : 0.f; }
    __syncthreads();
    const int kc = tid & 7, nr = tid >> 3;
    int kd0 = k0;
    if (perm == 2) { const int g = k0 >> 8; const int gm = (g == 0) ? 2 : (g == 1) ? 0 : (g == 2) ? 3 : 1; kd0 = gm * 256 + (k0 & 255); }
    float g8[8];
#pragma unroll
    for (int j = 0; j < 8; ++j) g8[j] = gain ? gain[k0 + kc * 8 + j] : 1.f;
#pragma unroll
    for (int i = 0; i < 2; ++i) {
        const int nl2 = nr + 32 * i;
        float v[8];
#pragma unroll
        for (int j = 0; j < 8; ++j) v[j] = lds[(kc * 8 + j) * 65 + nl2] * g8[j];
        uint4 o; o.x = cvt_pk(v[0], v[1]); o.y = cvt_pk(v[2], v[3]); o.z = cvt_pk(v[4], v[5]); o.w = cvt_pk(v[6], v[7]);
        *(uint4*)(dst + (size_t)(n0 + nl2) * K + kd0 + kc * 8) = o;
    }
    __syncthreads();
}

constexpr int CONV_TILES = 768 + 256 + 24 + 16 + 64 + 64 + 1408 + 704;
DI void conv_layer_item(const Params& p, int l, int it, unsigned char* smem) {
    bf16_t* W = (bf16_t*)(p.ws + OFF_W);
    if (it < 768) { conv_tile(p.in[I_WIN] + (size_t)l * DM * INC, DM, INC, UC, p.in[I_GMIX] + l * DM, 0, W + W_IN, it, smem); return; } it -= 768;
    if (it < 256) { conv_tile(p.in[I_WOUT] + (size_t)l * DM * DM, DM, DM, DM, p.in[I_GBR] + l * DM, 2, W + W_OUT, it, smem); return; } it -= 256;
    if (it < 24) { conv_tile(p.in[I_MWUQ] + (size_t)l * 256 * 384, 256, 384, 384, p.in[I_MQAG] + l * 256, 0, W + W_UQ, it, smem); return; } it -= 24;
    if (it < 16) { conv_tile(p.in[I_MWUKV] + (size_t)l * 128 * 512, 128, 512, 512, p.in[I_MKVAG] + l * 128, 0, W + W_UKV, it, smem); return; } it -= 16;
    if (it < 64) { conv_tile(p.in[I_XWQ] + (size_t)l * DM * 256, DM, 256, 256, p.in[I_GXQ] + l * DM, 0, W + W_XQ, it, smem); return; } it -= 64;
    if (it < 64) { conv_tile(p.in[I_XWO] + (size_t)l * 256 * DM, 256, DM, DM, nullptr, 0, W + W_XO, it, smem); return; } it -= 64;
    if (it < 1408) { conv_tile(p.in[I_W13] + (size_t)l * DM * 2 * DFF, DM, 2 * DFF, 2 * DFF, p.in[I_GFFN] + l * DM, 1, W + W_13, it, smem); return; } it -= 1408;
    conv_tile(p.in[I_W2] + (size_t)l * DFF * DM, DFF, DM, DM, nullptr, 0, W + W_2, it, smem);
}

DI void pro_rows(const float* __restrict__ src, float* __restrict__ cpy, bf16_t* __restrict__ dstb, float* __restrict__ sq, int sqstride, int item) {
    const int w = tidx() >> 6, lane = tidx() & 63;
    for (int r = 0; r < 4; ++r) {
        const int row = item * 16 + w * 4 + r;
        const float4* s4 = (const float4*)(src + (size_t)row * DM);
        float s = 0.f;
#pragma unroll
        for (int i = 0; i < 4; ++i) {
            const float4 v = s4[lane + 64 * i];
            if (cpy) ((float4*)(cpy + (size_t)row * DM))[lane + 64 * i] = v;
            u32x2 o; o.x = cvt_pk(v.x, v.y); o.y = cvt_pk(v.z, v.w);
            *(u32x2*)(dstb + (size_t)row * DM + (lane + 64 * i) * 4) = o;
            s += v.x * v.x + v.y * v.y + v.z * v.z + v.w * v.w;
        }
        s = wave_sum(s);
        if (lane < sqstride) sq[(size_t)row * sqstride + lane] = (lane == 0) ? s : 0.f;
    }
}
DI void pro_rope(const Params& p, int item) {
    const int tok = item * 256 + tidx();
    const int* pos = (const int*)p.in[I_POS];
    float* cs = (float*)(p.ws + OFF_ROPE);
    float* sn = cs + (size_t)T_TOK * 16;
    const float pf = (float)pos[tok];
#pragma unroll
    for (int i = 0; i < 16; ++i) {
        const float inv = powf(10000.0f, -(float)(2 * i) / 32.0f);
        const float ang = pf * inv;
        cs[(size_t)tok * 16 + i] = cosf(ang);
        sn[(size_t)tok * 16 + i] = sinf(ang);
    }
}

DI void conformer_tile(const Params& p, int l, int tile, unsigned char* smem) {
    float* hs = (float*)smem;
    const bf16_t* U = (const bf16_t*)(p.ws + OFF_U);
    bf16_t* CAT = (bf16_t*)(p.ws + OFF_CAT);
    const int tid = tidx(), b = tile >> 7, t0 = (tile & 127) * 32;
    {
        const int c2 = (tid & 127) * 2, half = tid >> 7;
        for (int r0 = half; r0 < 62; r0 += 32) {
            unsigned av[16], gv[16];
#pragma unroll
            for (int k = 0; k < 16; ++k) {
                const int r = r0 + 2 * k, t = t0 - 15 + r;
                av[k] = 0u; gv[k] = 0u;
                if (r < 62 && t >= 0 && t < SEQ) {
                    const bf16_t* up = U + (size_t)(b * SEQ + t) * UC;
                    av[k] = *(const unsigned*)(up + c2); gv[k] = *(const unsigned*)(up + 256 + c2);
                }
            }
#pragma unroll
            for (int k = 0; k < 16; ++k) {
                const int r = r0 + 2 * k;
                if (r < 62) {
                    hs[r * 256 + c2] = bflo(av[k]) * sigmoidf_(bflo(gv[k]));
                    hs[r * 256 + c2 + 1] = bfhi(av[k]) * sigmoidf_(bfhi(gv[k]));
                }
            }
        }
    }
    __syncthreads();
    {
        const int c = tid;
        float wv[31];
        const float* wp = p.in[I_ADWW] + (size_t)l * 31 * 256 + c;
#pragma unroll
        for (int j = 0; j < 31; ++j) wv[j] = wp[j * 256];
        const float bias = p.in[I_ADWB][l * 256 + c];
        for (int t = 0; t < 32; ++t) {
            float y = bias;
#pragma unroll
            for (int j = 0; j < 31; ++j) y += wv[j] * hs[(t + j) * 256 + c];
            hs[t * 256 + c] = y;
        }
    }
    __syncthreads();
    {
        const int w = tid >> 6, lane = tid & 63;
        const float4 g4 = *(const float4*)(p.in[I_ALNG] + l * 256 + lane * 4), b4 = *(const float4*)(p.in[I_ALNB] + l * 256 + lane * 4);
        for (int r = 0; r < 8; ++r) {
            const int t = w * 8 + r;
            float4 v = *(const float4*)(hs + t * 256 + lane * 4);
            const float mu = wave_sum(v.x + v.y + v.z + v.w) * (1.f / 256.f);
            v.x -= mu; v.y -= mu; v.z -= mu; v.w -= mu;
            const float var = wave_sum(v.x * v.x + v.y * v.y + v.z * v.z + v.w * v.w) * (1.f / 256.f);
            const float rstd = __builtin_amdgcn_rsqf(var + EPS);
            float y0 = v.x * rstd * g4.x + b4.x, y1 = v.y * rstd * g4.y + b4.y, y2 = v.z * rstd * g4.z + b4.z, y3 = v.w * rstd * g4.w + b4.w;
            y0 *= sigmoidf_(y0); y1 *= sigmoidf_(y1); y2 *= sigmoidf_(y2); y3 *= sigmoidf_(y3);
            const float ss = wave_sum(y0 * y0 + y1 * y1 + y2 * y2 + y3 * y3);
            const float rb = __builtin_amdgcn_rsqf(ss * (1.f / 256.f) + EPS);
            u32x2 o; o.x = cvt_pk(y0 * rb, y1 * rb); o.y = cvt_pk(y2 * rb, y3 * rb);
            *(u32x2*)(CAT + (size_t)(b * SEQ + t0 + t) * DM + 512 + lane * 4) = o;
        }
    }
    __syncthreads();
}

DI void shortconv_tile(const Params& p, int l, int tile) {
    const bf16_t* U = (const bf16_t*)(p.ws + OFF_U);
    bf16_t* CAT = (bf16_t*)(p.ws + OFF_CAT);
    const int w = tidx() >> 6, lane = tidx() & 63, c = lane * 4;
    const float* wp = p.in[I_CDWW] + (size_t)l * 3 * 256 + c;
    const float4 w0 = *(const float4*)(wp), w1 = *(const float4*)(wp + 256), w2 = *(const float4*)(wp + 512);
    const float4 bb = *(const float4*)(p.in[I_CDWB] + l * 256 + c);
#pragma unroll 4
    for (int r = 0; r < 16; ++r) {
        const int tok = tile * 64 + w * 16 + r, s = tok & (SEQ - 1);
        float pr[3][4];
#pragma unroll
        for (int j = 0; j < 3; ++j) {
            const int sj = s + j - 1;
            if (sj >= 0 && sj < SEQ) {
                const bf16_t* up = U + (size_t)(tok + j - 1) * UC;
                const u32x2 gc = *(const u32x2*)(up + 2048 + c), xi = *(const u32x2*)(up + 2304 + c);
                pr[j][0] = bflo(gc.x) * bflo(xi.x); pr[j][1] = bfhi(gc.x) * bfhi(xi.x); pr[j][2] = bflo(gc.y) * bflo(xi.y); pr[j][3] = bfhi(gc.y) * bfhi(xi.y);
            } else { pr[j][0] = pr[j][1] = pr[j][2] = pr[j][3] = 0.f; }
        }
        const u32x2 gb = *(const u32x2*)(U + (size_t)tok * UC + 1792 + c);
        const float y0 = bflo(gb.x) * (bb.x + w0.x * pr[0][0] + w1.x * pr[1][0] + w2.x * pr[2][0]);
        const float y1 = bfhi(gb.x) * (bb.y + w0.y * pr[0][1] + w1.y * pr[1][1] + w2.y * pr[2][1]);
        const float y2 = bflo(gb.y) * (bb.z + w0.z * pr[0][2] + w1.z * pr[1][2] + w2.z * pr[2][2]);
        const float y3 = bfhi(gb.y) * (bb.w + w0.w * pr[0][3] + w1.w * pr[1][3] + w2.w * pr[2][3]);
        const float ss = wave_sum(y0 * y0 + y1 * y1 + y2 * y2 + y3 * y3);
        const float rb = __builtin_amdgcn_rsqf(ss * (1.f / 256.f) + EPS);
        u32x2 o; o.x = cvt_pk(y0 * rb, y1 * rb); o.y = cvt_pk(y2 * rb, y3 * rb);
        *(u32x2*)(CAT + (size_t)tok * DM + 768 + c) = o;
    }
}

DI float hgrn_lower(const Params& p, int l, int dir, int ch) {
    const float* g = p.in[I_HGAM] + (size_t)dir * NL * 256 + ch;
    const float g0 = g[0], g1 = g[256], g2 = g[512], g3 = g[768];
    const float mx = fmaxf(fmaxf(g0, g1), fmaxf(g2, g3));
    const float e0 = __expf(g0 - mx), e1 = __expf(g1 - mx), e2 = __expf(g2 - mx), e3 = __expf(g3 - mx);
    const float inv = 1.f / (e0 + e1 + e2 + e3);
    float lb = 0.f;
    if (l >= 1) lb += e1; if (l >= 2) lb += e2; if (l >= 3) lb += e3;
    return lb * inv;
}

DI void hgrn_local_tile(const Params& p, int l, int item, unsigned char* smem) {
    const bf16_t* U = (const bf16_t*)(p.ws + OFF_U);
    float* HST = (float*)(p.ws + OFF_HST);
    float* HDEC = (float*)(p.ws + OFF_HDEC);
    const int dir = item >> 9, b = (item >> 6) & 7, c = item & 63;
    const int h = tidx() >> 6, lane = tidx() & 63, l15 = lane & 15, quad = lane >> 4;
    bf16_t* kT = (bf16_t*)(smem + h * 18432);
    bf16_t* vT = kT + 64 * 72;
    const float lb = hgrn_lower(p, l, dir, h * 64 + lane);
    const int tokbase = b * SEQ + c * 64;
    const bf16_t* zp = U + (size_t)tokbase * UC + 768 + dir * 256 + h * 64 + lane;
    const bf16_t* vp = U + (size_t)tokbase * UC + 1280 + h * 64 + lane;
    float suf = 0.f;
    {
        const int step = dir ? UC : -UC, di = dir ? 1 : -1;
        int i = dir ? 0 : 63;
        zp += (size_t)i * UC; vp += (size_t)i * UC;
        bf16_t* kw = kT + lane * 72 + i; bf16_t* vw = vT + lane * 72 + i;
        {
            bf16_t zz[64], vv[64];
#pragma unroll
            for (int ii = 0; ii < 64; ++ii) { zz[ii] = zp[(ptrdiff_t)ii * step]; vv[ii] = vp[(ptrdiff_t)ii * step]; }
#pragma unroll
            for (int ii = 0; ii < 64; ++ii) {
                const float z = bf2f(zz[ii]);
                const float sg = sigmoidf_(z), f = sg + lb * (1.f - sg), kk = (1.f - lb) * (1.f - sg);
                kw[ii * di] = f2bf(kk * __expf(suf));
                vw[ii * di] = vv[ii];
                suf += __logf(f);
            }
        }
    }
    const int seq = (dir * 8 + b) * 4 + h, cs = dir ? 63 - c : c;
    HDEC[((size_t)seq * 64 + cs) * 64 + lane] = __expf(suf);
    __syncthreads();
    f32x4 acc[4][4];
#pragma unroll
    for (int et = 0; et < 4; ++et)
#pragma unroll
        for (int dt = 0; dt < 4; ++dt) acc[et][dt] = (f32x4){0.f, 0.f, 0.f, 0.f};
#pragma unroll
    for (int ks = 0; ks < 2; ++ks) {
        bf16x8 av[4], bk[4];
#pragma unroll
        for (int t = 0; t < 4; ++t) {
            av[t] = *(const bf16x8*)(vT + (t * 16 + l15) * 72 + ks * 32 + quad * 8);
            bk[t] = *(const bf16x8*)(kT + (t * 16 + l15) * 72 + ks * 32 + quad * 8);
        }
#pragma unroll
        for (int et = 0; et < 4; ++et)
#pragma unroll
            for (int dt = 0; dt < 4; ++dt) acc[et][dt] = MFMA16(av[et], bk[dt], acc[et][dt]);
    }
    float* sp = HST + ((size_t)seq * 64 + cs) * 4096;
#pragma unroll
    for (int et = 0; et < 4; ++et)
#pragma unroll
        for (int dt = 0; dt < 4; ++dt)
#pragma unroll
            for (int r = 0; r < 4; ++r) sp[(et * 16 + quad * 4 + r) * 64 + dt * 16 + l15] = acc[et][dt][r];
    __syncthreads();
}

DI void hgrn_scan_item(const Params& p, int item) {
    float* HST = (float*)(p.ws + OFF_HST);
    const float* HDEC = (const float*)(p.ws + OFF_HDEC);
    const int gid = item * 256 + tidx(), seq = gid >> 12, ed = gid & 4095, d = ed & 63;
    float* sp = HST + (size_t)seq * 64 * 4096 + ed;
    const float* dp = HDEC + (size_t)seq * 64 * 64 + d;
    float s = 0.f;
    for (int c0 = 0; c0 < 64; c0 += 8) {
        float loc[8], dec[8];
#pragma unroll
        for (int j = 0; j < 8; ++j) { loc[j] = sp[(size_t)(c0 + j) * 4096]; dec[j] = dp[(c0 + j) * 64]; }
#pragma unroll
        for (int j = 0; j < 8; ++j) { sp[(size_t)(c0 + j) * 4096] = s; s = dec[j] * s + loc[j]; }
    }
}

DI void hgrn_scan_dummy(const Params& p, int item) {
    float* HST = (float*)(p.ws + OFF_HST);
    const float* HDEC = (const float*)(p.ws + OFF_HDEC);
    const int gid = item * 256 + tidx(), seq = gid >> 12, ed = gid & 4095, d = ed & 63;
    float* sp = HST + (size_t)seq * 64 * 4096 + ed;
    const float* dp = HDEC + (size_t)seq * 64 * 64 + d;
    float s = 0.f;
    for (int c0 = 0; c0 < 64; c0 += 8) {
        float loc[8], dec[8];
#pragma unroll
        for (int j = 0; j < 8; ++j) { loc[j] = sp[(size_t)(c0 + j) * 4096]; dec[j] = dp[(c0 + j) * 64]; }
#pragma unroll
        for (int j = 0; j < 8; ++j) { s = dec[j] * s + loc[j]; sp[(size_t)(c0 + j) * 4096] = (s == 12345.678f) ? s : loc[j]; }
    }
}
DI bf16x8 hg_frag(const bf16_t* qk, const float* bc, const float* ref, bool qside) {
    const uint4 x = *(const uint4*)qk;
    const float4 b0 = *(const float4*)bc, b1 = *(const float4*)(bc + 4);
    float4 r0 = {0.f, 0.f, 0.f, 0.f}, r1 = {0.f, 0.f, 0.f, 0.f};
    if (ref) { r0 = *(const float4*)ref; r1 = *(const float4*)(ref + 4); }
    float e[8] = {b0.x - r0.x, b0.y - r0.y, b0.z - r0.z, b0.w - r0.w, b1.x - r1.x, b1.y - r1.y, b1.z - r1.z, b1.w - r1.w};
    if (!qside) {
#pragma unroll
        for (int j = 0; j < 8; ++j) e[j] = -e[j];
    }
    u32x4 o;
    o.x = cvt_pk(bflo(x.x) * __expf(e[0]), bfhi(x.x) * __expf(e[1]));
    o.y = cvt_pk(bflo(x.y) * __expf(e[2]), bfhi(x.y) * __expf(e[3]));
    o.z = cvt_pk(bflo(x.z) * __expf(e[4]), bfhi(x.z) * __expf(e[5]));
    o.w = cvt_pk(bflo(x.w) * __expf(e[6]), bfhi(x.w) * __expf(e[7]));
    return __builtin_bit_cast(bf16x8, o);
}

DI void hgrn_out_tile(const Params& p, int l, int item, unsigned char* smem) {
    const bf16_t* U = (const bf16_t*)(p.ws + OFF_U);
    const float* HST = (const float*)(p.ws + OFF_HST);
    bf16_t* CAT = (bf16_t*)(p.ws + OFF_CAT);
    float* SSQB = (float*)(p.ws + OFF_SSQB);
    const int h = item & 3, c = (item >> 2) & 63, b = item >> 8;
    const int w = tidx() >> 6, lane = tidx() & 63, l15 = lane & 15, quad = lane >> 4;
    float* bc = (float*)smem;
    bf16_t* kk = (bf16_t*)(smem + 34816);
    bf16_t* qq = (bf16_t*)(smem + 34816 + 18432);
    bf16_t* vT = (bf16_t*)(smem + 34816 + 18432 + 9216);
    const int tokbase = b * SEQ + c * 64;
    u32x4 sfr[2][4];
    {
        const int dirp = w & 1;
        const int seqp = (dirp * 8 + b) * 4 + h, csp = dirp ? 63 - c : c;
        const float* sinp = HST + ((size_t)seqp * 64 + csp) * 4096;
#pragma unroll
        for (int ks = 0; ks < 2; ++ks)
#pragma unroll
            for (int et = 0; et < 4; ++et) {
                const float* sp = sinp + (et * 16 + l15) * 64 + ks * 32 + quad * 8;
                const float4 s0 = *(const float4*)sp, s1 = *(const float4*)(sp + 4);
                sfr[ks][et].x = cvt_pk(s0.x, s0.y); sfr[ks][et].y = cvt_pk(s0.z, s0.w); sfr[ks][et].z = cvt_pk(s1.x, s1.y); sfr[ks][et].w = cvt_pk(s1.z, s1.w);
            }
    }
    if (w < 2) {
        const int dir = w;
        const float lb = hgrn_lower(p, l, dir, h * 64 + lane);
        const bf16_t* zp = U + (size_t)tokbase * UC + 768 + dir * 256 + h * 64 + lane;
        float run = 0.f;
        const int step = dir ? -UC : UC, di = dir ? -1 : 1;
        int i = dir ? 63 : 0;
        zp += (size_t)i * UC;
        float* bw = bc + (dir * 64 + i) * 68 + lane; bf16_t* kw = kk + (dir * 64 + i) * 72 + lane;
        {
            bf16_t zz[64];
#pragma unroll
            for (int ii = 0; ii < 64; ++ii) zz[ii] = zp[(ptrdiff_t)ii * step];
#pragma unroll
            for (int ii = 0; ii < 64; ++ii) {
                const float z = bf2f(zz[ii]);
                const float sg = sigmoidf_(z), f = sg + lb * (1.f - sg);
                run += __logf(f);
                bw[ii * di * 68] = run; kw[ii * di * 72] = f2bf((1.f - lb) * (1.f - sg));
            }
        }
    } else if (w == 2) {
        const bf16_t* qp = U + (size_t)tokbase * UC + 512 + h * 64 + lane;
        {
            bf16_t t[64];
#pragma unroll
            for (int i = 0; i < 64; ++i) t[i] = qp[(size_t)i * UC];
#pragma unroll
            for (int i = 0; i < 64; ++i) qq[i * 72 + lane] = t[i];
        }
    } else {
        const bf16_t* vp = U + (size_t)tokbase * UC + 1280 + h * 64 + lane;
        {
            bf16_t t[64];
#pragma unroll
            for (int i = 0; i < 64; ++i) t[i] = vp[(size_t)i * UC];
#pragma unroll
            for (int i = 0; i < 64; ++i) vT[lane * 72 + i] = t[i];
        }
    }
    __syncthreads();
    const int dir = w & 1, iset = w >> 1;
    const int seq = (dir * 8 + b) * 4 + h, cs = dir ? 63 - c : c;
    const float* bcd = bc + dir * 64 * 68;
    const bf16_t* kkd = kk + dir * 64 * 72;
    f32x4 o[4][2];
#pragma unroll
    for (int et = 0; et < 4; ++et) { o[et][0] = (f32x4){0.f, 0.f, 0.f, 0.f}; o[et][1] = (f32x4){0.f, 0.f, 0.f, 0.f}; }
#pragma unroll
    for (int ii = 0; ii < 2; ++ii) {
        const int I = iset == 0 ? (ii == 0 ? 0 : 3) : (ii == 0 ? 1 : 2);
        const int irow = 16 * I + l15;
#pragma unroll
        for (int ks = 0; ks < 2; ++ks) {
            const int d0 = ks * 32 + quad * 8;
            const bf16x8 bq = hg_frag(qq + irow * 72 + d0, bcd + irow * 68 + d0, nullptr, true);
#pragma unroll
            for (int et = 0; et < 4; ++et) o[et][ii] = MFMA16(__builtin_bit_cast(bf16x8, sfr[ks][et]), bq, o[et][ii]);
        }
#pragma unroll
        for (int kk2 = 0; kk2 < 2; ++kk2) {
            f32x4 at[2];
            bool any = false;
#pragma unroll
            for (int jj = 0; jj < 2; ++jj) {
                const int J = 2 * kk2 + jj;
                at[jj] = (f32x4){0.f, 0.f, 0.f, 0.f};
                const bool active = dir == 0 ? (J <= I) : (J >= I);
                if (active) {
                    any = true;
                    const float* ref = nullptr;
                    if (dir == 0) { if (J > 0) ref = bcd + (16 * J - 1) * 68; } else { if (J < 3) ref = bcd + (16 * J + 16) * 68; }
                    const int srow = 16 * J + l15;
#pragma unroll
                    for (int ks = 0; ks < 2; ++ks) {
                        const int d0 = ks * 32 + quad * 8;
                        const bf16x8 ak = hg_frag(kkd + srow * 72 + d0, bcd + srow * 68 + d0, ref ? ref + d0 : nullptr, false);
                        const bf16x8 bq = hg_frag(qq + irow * 72 + d0, bcd + irow * 68 + d0, ref ? ref + d0 : nullptr, true);
                        at[jj] = MFMA16(ak, bq, at[jj]);
                    }
                    if (J == I) {
#pragma unroll
                        for (int r = 0; r < 4; ++r) {
                            const int sl = quad * 4 + r;
                            const bool keep = dir == 0 ? (sl <= l15) : (sl >= l15);
                            if (!keep) at[jj][r] = 0.f;
                        }
                    }
                }
            }
            if (any) {
                u32x4 pbw; pbw.x = cvt_pk(at[0][0], at[0][1]); pbw.y = cvt_pk(at[0][2], at[0][3]); pbw.z = cvt_pk(at[1][0], at[1][1]); pbw.w = cvt_pk(at[1][2], at[1][3]);
                const bf16x8 pb = __builtin_bit_cast(bf16x8, pbw);
#pragma unroll
                for (int et = 0; et < 4; ++et) {
                    const bf16_t* vp = vT + (et * 16 + l15) * 72 + kk2 * 32 + quad * 4;
                    const u32x2 lo = *(const u32x2*)vp, hi = *(const u32x2*)(vp + 16);
                    u32x4 a; a.x = lo.x; a.y = lo.y; a.z = hi.x; a.w = hi.y;
                    o[et][ii] = MFMA16(__builtin_bit_cast(bf16x8, a), pb, o[et][ii]);
                }
            }
        }
    }
    __syncthreads();
    float* ob = (float*)smem;
    if (dir == 1) {
#pragma unroll
        for (int ii = 0; ii < 2; ++ii) {
            const int I = iset == 0 ? (ii == 0 ? 0 : 3) : (ii == 0 ? 1 : 2);
#pragma unroll
            for (int et = 0; et < 4; ++et) *(f32x4*)(ob + (16 * I + l15) * 68 + et * 16 + quad * 4) = o[et][ii];
        }
    }
    __syncthreads();
    if (dir == 0) {
#pragma unroll
        for (int ii = 0; ii < 2; ++ii) {
            const int I = iset == 0 ? (ii == 0 ? 0 : 3) : (ii == 0 ? 1 : 2);
            const int tok = tokbase + 16 * I + l15;
            float ss = 0.f;
#pragma unroll
            for (int et = 0; et < 4; ++et) {
                o[et][ii] += *(const f32x4*)(ob + (16 * I + l15) * 68 + et * 16 + quad * 4);
                ss += o[et][ii][0] * o[et][ii][0] + o[et][ii][1] * o[et][ii][1] + o[et][ii][2] * o[et][ii][2] + o[et][ii][3] * o[et][ii][3];
            }
            ss += __shfl_xor(ss, 16); ss += __shfl_xor(ss, 32);
            const float rh = __builtin_amdgcn_rsqf(ss * (1.f / 64.f) + EPS);
            float ssy = 0.f;
#pragma unroll
            for (int et = 0; et < 4; ++et) {
                const int e = et * 16 + quad * 4;
                const u32x2 gg = *(const u32x2*)(U + (size_t)tok * UC + 1536 + h * 64 + e);
                const float4 og = *(const float4*)(p.in[I_HONG] + l * 256 + h * 64 + e);
                const float g0 = bflo(gg.x), g1 = bfhi(gg.x), g2 = bflo(gg.y), g3 = bfhi(gg.y);
                const float y0 = o[et][ii][0] * rh * og.x * g0 * sigmoidf_(g0), y1 = o[et][ii][1] * rh * og.y * g1 * sigmoidf_(g1);
                const float y2 = o[et][ii][2] * rh * og.z * g2 * sigmoidf_(g2), y3 = o[et][ii][3] * rh * og.w * g3 * sigmoidf_(g3);
                ssy += y0 * y0 + y1 * y1 + y2 * y2 + y3 * y3;
                u32x2 ov; ov.x = cvt_pk(y0, y1); ov.y = cvt_pk(y2, y3);
                *(u32x2*)(CAT + (size_t)tok * DM + h * 64 + e) = ov;
            }
            ssy += __shfl_xor(ssy, 16); ssy += __shfl_xor(ssy, 32);
            if (quad == 0) SSQB[(size_t)tok * 4 + h] = ssy;
        }
    }
    __syncthreads();
}

DI void mla_finish_tile(const Params& p, int l, int item, unsigned char* smem) {
    const bf16_t* U = (const bf16_t*)(p.ws + OFF_U);
    const bf16_t* QR = (const bf16_t*)(p.ws + OFF_QRAW);
    const bf16_t* KVR = (const bf16_t*)(p.ws + OFF_KVRAW);
    bf16_t* MQ = (bf16_t*)(p.ws + OFF_MQ);
    bf16_t* MK = (bf16_t*)(p.ws + OFF_MK);
    bf16_t* MVT = (bf16_t*)(p.ws + OFF_MVT);
    const float* CS = (const float*)(p.ws + OFF_ROPE);
    const float* SN = CS + (size_t)T_TOK * 16;
    bf16_t* vbuf = (bf16_t*)smem;
    const int w = tidx() >> 6, lane = tidx() & 63, h = lane >> 4, j = lane & 15;
    const float4 qg = *(const float4*)(p.in[I_MQNG] + l * 96 + 4 * j), kg = *(const float4*)(p.in[I_MKNG] + l * 96 + 4 * j);
    const float qg1 = p.in[I_MQNG][l * 96 + 64 + j], qg2 = p.in[I_MQNG][l * 96 + 80 + j];
    const float kg1 = p.in[I_MKNG][l * 96 + 64 + j], kg2 = p.in[I_MKNG][l * 96 + 80 + j];
#pragma unroll 4
    for (int r = 0; r < 16; ++r) {
        const int tl = w * 16 + r, tok = item * 64 + tl;
        const bf16_t* up = U + (size_t)tok * UC;
        float sq, skv;
        { const u32x2 a = *(const u32x2*)(up + 2560 + lane * 4);
          const float a0 = bflo(a.x), a1 = bfhi(a.x), a2 = bflo(a.y), a3 = bfhi(a.y);
          sq = __builtin_amdgcn_rsqf(wave_sum(a0 * a0 + a1 * a1 + a2 * a2 + a3 * a3) * (1.f / 256.f) + EPS);
          const unsigned c = *(const unsigned*)(up + 2816 + lane * 2);
          const float c0 = bflo(c), c1 = bfhi(c);
          skv = __builtin_amdgcn_rsqf(wave_sum(c0 * c0 + c1 * c1) * (1.f / 128.f) + EPS); }
        const float cs = CS[(size_t)tok * 16 + j], sn = SN[(size_t)tok * 16 + j];
        {
            const bf16_t* qp = QR + (size_t)tok * 384 + h * 96;
            const u32x2 a = *(const u32x2*)(qp + 4 * j);
            float q0 = bflo(a.x) * sq, q1 = bfhi(a.x) * sq, q2 = bflo(a.y) * sq, q3 = bfhi(a.y) * sq;
            float x1 = bf2f(qp[64 + j]) * sq, x2 = bf2f(qp[80 + j]) * sq;
            float ss = q0 * q0 + q1 * q1 + q2 * q2 + q3 * q3 + x1 * x1 + x2 * x2;
            ss += __shfl_xor(ss, 1); ss += __shfl_xor(ss, 2); ss += __shfl_xor(ss, 4); ss += __shfl_xor(ss, 8);
            const float rn = __builtin_amdgcn_rsqf(ss * (1.f / 96.f) + EPS);
            q0 *= rn * qg.x; q1 *= rn * qg.y; q2 *= rn * qg.z; q3 *= rn * qg.w; x1 *= rn * qg1; x2 *= rn * qg2;
            bf16_t* op = MQ + (size_t)tok * 384 + h * 96;
            u32x2 ov; ov.x = cvt_pk(q0, q1); ov.y = cvt_pk(q2, q3);
            *(u32x2*)(op + 4 * j) = ov;
            op[64 + j] = f2bf(x1 * cs - x2 * sn); op[80 + j] = f2bf(x2 * cs + x1 * sn);
        }
        {
            const bf16_t* kp = KVR + (size_t)tok * 512 + h * 128;
            const u32x2 a = *(const u32x2*)(kp + 4 * j);
            float k0 = bflo(a.x) * skv, k1 = bfhi(a.x) * skv, k2 = bflo(a.y) * skv, k3 = bfhi(a.y) * skv;
            float x1 = bf2f(up[2944 + j]), x2 = bf2f(up[2960 + j]);
            float ss = k0 * k0 + k1 * k1 + k2 * k2 + k3 * k3 + x1 * x1 + x2 * x2;
            ss += __shfl_xor(ss, 1); ss += __shfl_xor(ss, 2); ss += __shfl_xor(ss, 4); ss += __shfl_xor(ss, 8);
            const float rn = __builtin_amdgcn_rsqf(ss * (1.f / 96.f) + EPS);
            k0 *= rn * kg.x; k1 *= rn * kg.y; k2 *= rn * kg.z; k3 *= rn * kg.w; x1 *= rn * kg1; x2 *= rn * kg2;
            bf16_t* op = MK + (size_t)tok * 384 + h * 96;
            u32x2 ov; ov.x = cvt_pk(k0, k1); ov.y = cvt_pk(k2, k3);
            *(u32x2*)(op + 4 * j) = ov;
            op[64 + j] = f2bf(x1 * cs - x2 * sn); op[80 + j] = f2bf(x2 * cs + x1 * sn);
            const u32x2 vv = *(const u32x2*)(kp + 64 + 4 * j);
            u32x2 vo; vo.x = cvt_pk(bflo(vv.x) * skv, bfhi(vv.x) * skv); vo.y = cvt_pk(bflo(vv.y) * skv, bfhi(vv.y) * skv);
            *(u32x2*)(vbuf + tl * 256 + h * 64 + 4 * j) = vo;
        }
    }
    __syncthreads();
    {
        const int tid = tidx(), b = (item * 64) / SEQ, s0 = (item * 64) % SEQ, hh = tid >> 6, e = tid & 63;
        bf16_t* dst = MVT + ((size_t)(b * 4 + hh) * 64 + e) * SEQ + s0;
#pragma unroll
        for (int c8 = 0; c8 < 8; ++c8) {
            unsigned wds[4];
#pragma unroll
            for (int k = 0; k < 4; ++k) wds[k] = (unsigned)vbuf[(c8 * 8 + 2 * k) * 256 + tid] | ((unsigned)vbuf[(c8 * 8 + 2 * k + 1) * 256 + tid] << 16);
            uint4 o; o.x = wds[0]; o.y = wds[1]; o.z = wds[2]; o.w = wds[3];
            *(uint4*)(dst + c8 * 8) = o;
        }
    }
    __syncthreads();
}

DI void memkv_finish_tile(const Params& p, int item, unsigned char* smem) {
    const bf16_t* KVM = (const bf16_t*)(p.ws + OFF_KVMEM);
    bf16_t* XK = (bf16_t*)(p.ws + OFF_XK);
    bf16_t* XVT = (bf16_t*)(p.ws + OFF_XVT);
    bf16_t* vbuf = (bf16_t*)smem;
    const int l = item >> 5, b = (item >> 2) & 7, h = item & 3;
    const int w = tidx() >> 6, lane = tidx() & 63;
    const float kg = p.in[I_XKNG][l * 64 + lane];
    for (int r = 0; r < 64; ++r) {
        const int m = w * 64 + r;
        const bf16_t* src = KVM + ((size_t)l * 2048 + b * 256 + m) * 512 + h * 128;
        const float k = bf2f(src[lane]);
        const float rn = __builtin_amdgcn_rsqf(wave_sum(k * k) * (1.f / 64.f) + EPS);
        XK[(((size_t)(l * 8 + b) * 4 + h) * 256 + m) * 64 + lane] = f2bf(k * rn * kg);
        vbuf[m * 64 + lane] = src[64 + lane];
    }
    __syncthreads();
    {
        const int tid = tidx(), e = tid & 63, mq = tid >> 6;
        bf16_t* dst = XVT + (((size_t)(l * 8 + b) * 4 + h) * 64 + e) * 256 + mq * 64;
#pragma unroll
        for (int c8 = 0; c8 < 8; ++c8) {
            unsigned wds[4];
#pragma unroll
            for (int k = 0; k < 4; ++k) wds[k] = (unsigned)vbuf[(mq * 64 + c8 * 8 + 2 * k) * 64 + e] | ((unsigned)vbuf[(mq * 64 + c8 * 8 + 2 * k + 1) * 64 + e] << 16);
            uint4 o; o.x = wds[0]; o.y = wds[1]; o.z = wds[2]; o.w = wds[3];
            *(uint4*)(dst + c8 * 8) = o;
        }
    }
    __syncthreads();
}

template <int DQK, bool QNORM>
DI void attn_tile(const bf16_t* __restrict__ Q, int qs, const bf16_t* __restrict__ Kp, int kstr, const bf16_t* __restrict__ Vt, int vstr, int nkeys,
                  float c2, float mbound, const float* __restrict__ qgain, bf16_t* __restrict__ O, int os, float* __restrict__ ssq, int ssq_stride, unsigned char* smem) {
    constexpr int NKS = DQK / 32, KP = DQK * 2 + 16, KCH = DQK / 8, KB = 64 * KP, VB = 64 * 144, STG = KB + VB, NKL = (64 * KCH) / 256;
    const int tid = tidx(), w = tid >> 6, lane = tid & 63, l15 = lane & 15, quad = lane >> 4;
    bf16x8 bq[2][NKS];
#pragma unroll
    for (int qt = 0; qt < 2; ++qt) {
        const bf16_t* qp = Q + (size_t)(w * 32 + qt * 16 + l15) * qs + quad * 8;
        if (QNORM) {
            float v[NKS][8]; float ss = 0.f;
#pragma unroll
            for (int ks = 0; ks < NKS; ++ks) {
                const uint4 x = *(const uint4*)(qp + ks * 32);
                v[ks][0] = bflo(x.x); v[ks][1] = bfhi(x.x); v[ks][2] = bflo(x.y); v[ks][3] = bfhi(x.y); v[ks][4] = bflo(x.z); v[ks][5] = bfhi(x.z); v[ks][6] = bflo(x.w); v[ks][7] = bfhi(x.w);
#pragma unroll
                for (int j = 0; j < 8; ++j) ss += v[ks][j] * v[ks][j];
            }
            ss += __shfl_xor(ss, 16); ss += __shfl_xor(ss, 32);
            const float rn = __builtin_amdgcn_rsqf(ss * (1.f / DQK) + EPS);
#pragma unroll
            for (int ks = 0; ks < NKS; ++ks) {
                const float* gp = qgain + ks * 32 + quad * 8;
                u32x4 o;
                o.x = cvt_pk(v[ks][0] * rn * gp[0], v[ks][1] * rn * gp[1]); o.y = cvt_pk(v[ks][2] * rn * gp[2], v[ks][3] * rn * gp[3]);
                o.z = cvt_pk(v[ks][4] * rn * gp[4], v[ks][5] * rn * gp[5]); o.w = cvt_pk(v[ks][6] * rn * gp[6], v[ks][7] * rn * gp[7]);
                bq[qt][ks] = __builtin_bit_cast(bf16x8, o);
            }
        } else {
#pragma unroll
            for (int ks = 0; ks < NKS; ++ks) bq[qt][ks] = *(const bf16x8*)(qp + ks * 32);
        }
    }
    f32x4 o[4][2];
    float lrun[2];
#pragma unroll
    for (int qt = 0; qt < 2; ++qt) {
        lrun[qt] = 0.f;
#pragma unroll
        for (int et = 0; et < 4; ++et) o[et][qt] = (f32x4){0.f, 0.f, 0.f, 0.f};
    }
    uint4 ak0, ak1, ak2, av0, av1, bk0, bk1, bk2, bv0, bv1;
    ak2 = make_uint4(0u, 0u, 0u, 0u); bk2 = ak2;
    const int kr0 = tid / KCH, kc0 = tid % KCH, kr1 = (tid + 256) / KCH, kc1 = (tid + 256) % KCH, kr2 = (tid + 512) / KCH, kc2 = (tid + 512) % KCH;
    const int vr0 = tid >> 3, vc0 = tid & 7, vr1 = vr0 + 32;
#define A_LOAD(S, key0) do { S##k0 = *(const uint4*)(Kp + (size_t)((key0) + kr0) * kstr + kc0 * 8); S##k1 = *(const uint4*)(Kp + (size_t)((key0) + kr1) * kstr + kc1 * 8); \
                          if (NKL > 2) S##k2 = *(const uint4*)(Kp + (size_t)((key0) + kr2) * kstr + kc2 * 8); \
                          S##v0 = *(const uint4*)(Vt + (size_t)vr0 * vstr + (key0) + vc0 * 8); S##v1 = *(const uint4*)(Vt + (size_t)vr1 * vstr + (key0) + vc0 * 8); } while (0)
#define A_STORE(S, buf) do { unsigned char* kb_ = smem + (buf) * STG; unsigned char* vb_ = kb_ + KB; \
                          *(uint4*)(kb_ + kr0 * KP + kc0 * 16) = S##k0; *(uint4*)(kb_ + kr1 * KP + kc1 * 16) = S##k1; if (NKL > 2) *(uint4*)(kb_ + kr2 * KP + kc2 * 16) = S##k2; \
                          *(uint4*)(vb_ + vr0 * 144 + vc0 * 16) = S##v0; *(uint4*)(vb_ + vr1 * 144 + vc0 * 16) = S##v1; } while (0)
    const int nkb = nkeys >> 6;
    A_LOAD(a, 0); A_STORE(a, 0);
    A_LOAD(b, 64);
    if (2 < nkb) A_LOAD(a, 128);
    __syncthreads();
#define A_COMPUTE(cur) do { \
        const unsigned char* kb = smem + cur * STG; const unsigned char* vb = kb + KB; \
        f32x4 s[4][2]; \
_Pragma("unroll")         for (int kt = 0; kt < 4; ++kt) { s[kt][0] = (f32x4){0.f, 0.f, 0.f, 0.f}; s[kt][1] = (f32x4){0.f, 0.f, 0.f, 0.f}; } \
_Pragma("unroll")         for (int ks = 0; ks < NKS; ++ks) { \
            bf16x8 ak[4]; \
_Pragma("unroll")             for (int kt = 0; kt < 4; ++kt) ak[kt] = *(const bf16x8*)(kb + (kt * 16 + l15) * KP + ks * 64 + quad * 16); \
_Pragma("unroll")             for (int kt = 0; kt < 4; ++kt) { s[kt][0] = MFMA16(ak[kt], bq[0][ks], s[kt][0]); s[kt][1] = MFMA16(ak[kt], bq[1][ks], s[kt][1]); } \
        } \
        bf16x8 pb[2][2]; \
_Pragma("unroll")         for (int qt = 0; qt < 2; ++qt) { \
            float ls = 0.f; \
            float pv[4][4]; \
_Pragma("unroll")             for (int kt = 0; kt < 4; ++kt) \
_Pragma("unroll")                 for (int r = 0; r < 4; ++r) { pv[kt][r] = __builtin_amdgcn_exp2f(s[kt][qt][r] * c2 - mbound); ls += pv[kt][r]; } \
            lrun[qt] += ls; \
_Pragma("unroll")             for (int k2 = 0; k2 < 2; ++k2) { \
                u32x4 pw; pw.x = cvt_pk(pv[2 * k2][0], pv[2 * k2][1]); pw.y = cvt_pk(pv[2 * k2][2], pv[2 * k2][3]); \
                pw.z = cvt_pk(pv[2 * k2 + 1][0], pv[2 * k2 + 1][1]); pw.w = cvt_pk(pv[2 * k2 + 1][2], pv[2 * k2 + 1][3]); \
                pb[qt][k2] = __builtin_bit_cast(bf16x8, pw); \
            } \
        } \
_Pragma("unroll")         for (int k2 = 0; k2 < 2; ++k2) \
_Pragma("unroll")             for (int et = 0; et < 4; ++et) { \
                const unsigned char* vp = vb + (et * 16 + l15) * 144 + k2 * 64 + quad * 8; \
                const u32x2 lo = *(const u32x2*)vp, hi = *(const u32x2*)(vp + 32); \
                u32x4 a; a.x = lo.x; a.y = lo.y; a.z = hi.x; a.w = hi.y; \
                const bf16x8 av = __builtin_bit_cast(bf16x8, a); \
                o[et][0] = MFMA16(av, pb[0][k2], o[et][0]); \
                o[et][1] = MFMA16(av, pb[1][k2], o[et][1]); \
            } \
    } while (0)
#pragma unroll 1
    for (int jb = 0; jb < nkb; jb += 2) {
        A_STORE(b, 1);
        if (jb + 3 < nkb) A_LOAD(b, (jb + 3) * 64);
        __builtin_amdgcn_sched_barrier(0);
        A_COMPUTE(0);
        __syncthreads();
        if (jb + 2 < nkb) A_STORE(a, 0);
        if (jb + 4 < nkb) A_LOAD(a, (jb + 4) * 64);
        __builtin_amdgcn_sched_barrier(0);
        A_COMPUTE(1);
        __syncthreads();
    }
#undef A_COMPUTE
#undef A_LOAD
#undef A_STORE
#pragma unroll
    for (int qt = 0; qt < 2; ++qt) {
        float lt = lrun[qt]; lt += __shfl_xor(lt, 16); lt += __shfl_xor(lt, 32);
        const float inv = 1.f / lt;
        const int q = w * 32 + qt * 16 + l15;
        float ss = 0.f;
#pragma unroll
        for (int et = 0; et < 4; ++et) {
            const float y0 = o[et][qt][0] * inv, y1 = o[et][qt][1] * inv, y2 = o[et][qt][2] * inv, y3 = o[et][qt][3] * inv;
            ss += y0 * y0 + y1 * y1 + y2 * y2 + y3 * y3;
            u32x2 ov; ov.x = cvt_pk(y0, y1); ov.y = cvt_pk(y2, y3);
            *(u32x2*)(O + (size_t)q * os + et * 16 + quad * 4) = ov;
        }
        if (ssq) { ss += __shfl_xor(ss, 16); ss += __shfl_xor(ss, 32); if (quad == 0) ssq[(size_t)q * ssq_stride] = ss; }
    }
}

namespace pg8 {
#define PG8_LAS __attribute__((address_space(3)))
constexpr int BM = 256, BK = 64, HALF = 128, HTB = HALF * BK * 2, STAGE_BYTES = 8 * HTB, NXCD = 8, WGM = 8;
DI int lds_byte(int r, int c) { const int st = (r >> 4) * 2 + (c >> 5), rr = r & 15, cc = c & 31, ob = rr * 64 + cc * 2; return st * 1024 + (ob ^ (((ob >> 9) & 1) << 5)); }
DI void stage_rc(int b, int& R, int& C) { const int st = b / 1024, sb = b % 1024, swz = sb ^ (((sb >> 9) & 1) << 5); R = (st >> 1) * 16 + swz / 64; C = (st & 1) * 32 + (swz % 64) / 2; }
struct Unit { int pm, pn; };
struct Gemm { const bf16_t* A; const bf16_t* Bt; int M, N, K; };
struct StaticOrder {
    int nM, nN, nwg, G, c;
    DI void init(int M, int N, int G_, int c_) { nM = M / BM; nN = N / BM; nwg = nM * nN; G = G_; c = c_; }
    DI bool next(int i, Unit& u) const {
        const long L = (long)i * G + c; if (L >= nwg) return false;
        int wgid = (int)L; { const int q = nwg / NXCD, r = nwg % NXCD, xcd = wgid % NXCD, off = wgid / NXCD; wgid = (xcd < r ? xcd * (q + 1) : r * (q + 1) + (xcd - r) * q) + off; }
        const int nig = WGM * nN, gid = wgid / nig, fm = gid * WGM, gsz = (nM - fm) < WGM ? (nM - fm) : WGM;
        u.pm = fm + ((wgid % nig) % gsz); u.pn = (wgid % nig) / gsz; return true;
    }
};
DI float row_rstd(const float* part, int row) {
    const float4* p4 = (const float4*)(part + (size_t)row * 16);
    const float4 a = p4[0], b = p4[1], c = p4[2], d = p4[3];
    const float s = (a.x + a.y + a.z + a.w) + (b.x + b.y + b.z + b.w) + (c.x + c.y + c.z + c.w) + (d.x + d.y + d.z + d.w);
    return __builtin_amdgcn_rsqf(s * (1.f / DM) + EPS);
}
struct EpiScaled {
    bf16_t* O; int ldo; const float* part;
    DI void operator()(const f32x4 (&acc)[2][2][4][2], const Unit& u, int wr, int wc, int fr, int fq) const {
#pragma unroll
        for (int ai = 0; ai < 2; ++ai)
#pragma unroll
            for (int m = 0; m < 4; ++m) {
                const int row = u.pm * BM + ai * HALF + wr * 64 + m * 16 + fr;
                const float sc = row_rstd(part, row);
                bf16_t* rowp = O + (size_t)row * ldo + u.pn * BM + wc * 32 + fq * 4;
#pragma unroll
                for (int bj = 0; bj < 2; ++bj)
#pragma unroll
                    for (int n = 0; n < 2; ++n) {
                        u32x2 v; v.x = cvt_pk(acc[ai][bj][m][n][0] * sc, acc[ai][bj][m][n][1] * sc); v.y = cvt_pk(acc[ai][bj][m][n][2] * sc, acc[ai][bj][m][n][3] * sc);
                        *(u32x2*)(rowp + bj * HALF + n * 16) = v;
                    }
            }
    }
};
struct EpiSwiglu {
    bf16_t* H; const float* part;
    DI void operator()(const f32x4 (&acc)[2][2][4][2], const Unit& u, int wr, int wc, int fr, int fq) const {
#pragma unroll
        for (int ai = 0; ai < 2; ++ai)
#pragma unroll
            for (int m = 0; m < 4; ++m) {
                const int row = u.pm * BM + ai * HALF + wr * 64 + m * 16 + fr;
                const float sc = row_rstd(part, row);
                bf16_t* rowp = H + (size_t)row * DFF + ((u.pn * BM + wc * 32) >> 1) + fq * 4;
#pragma unroll
                for (int bj = 0; bj < 2; ++bj) {
                    float h[4];
#pragma unroll
                    for (int j = 0; j < 4; ++j) { const float a1 = acc[ai][bj][m][0][j] * sc, a3 = acc[ai][bj][m][1][j] * sc; h[j] = a1 * sigmoidf_(a1) * a3; }
                    u32x2 v; v.x = cvt_pk(h[0], h[1]); v.y = cvt_pk(h[2], h[3]);
                    *(u32x2*)(rowp + bj * (HALF / 2)) = v;
                }
            }
    }
};
struct EpiResid {
    float* X; bf16_t* XB; float* rowsq;
    DI void operator()(const f32x4 (&acc)[2][2][4][2], const Unit& u, int wr, int wc, int fr, int fq) const {
#pragma unroll
        for (int ai = 0; ai < 2; ++ai)
#pragma unroll
            for (int m = 0; m < 4; ++m) {
                const int row = u.pm * BM + ai * HALF + wr * 64 + m * 16 + fr;
                float ss = 0.f;
#pragma unroll
                for (int bj = 0; bj < 2; ++bj)
#pragma unroll
                    for (int n = 0; n < 2; ++n) {
                        const int col = u.pn * BM + bj * HALF + wc * 32 + n * 16 + fq * 4;
                        float4* xp = (float4*)(X + (size_t)row * DM + col);
                        float4 xv = *xp;
                        xv.x += acc[ai][bj][m][n][0]; xv.y += acc[ai][bj][m][n][1]; xv.z += acc[ai][bj][m][n][2]; xv.w += acc[ai][bj][m][n][3];
                        *xp = xv;
                        u32x2 v; v.x = cvt_pk(xv.x, xv.y); v.y = cvt_pk(xv.z, xv.w);
                        *(u32x2*)(XB + (size_t)row * DM + col) = v;
                        ss += xv.x * xv.x + xv.y * xv.y + xv.z * xv.z + xv.w * xv.w;
                    }
                ss += __shfl_xor(ss, 16); ss += __shfl_xor(ss, 32);
                if (fq == 0) rowsq[(size_t)row * 16 + u.pn * 4 + wc] = ss;
            }
    }
};

template <class Epi, bool SCALED = false>
DI void gemm_phase(PG8_LAS unsigned char* lds, const Gemm g, const StaticOrder& S, const Epi& E, const float* ssq0 = nullptr, const float* ssq1 = nullptr) {
    int tid = threadIdx.x; asm volatile("" : "+v"(tid));
    const int wid = __builtin_amdgcn_readfirstlane(tid >> 6), lane = tid & 63, wr = wid >> 2, wc = wid & 3, fr = lane & 15, fq = lane >> 4;
    const int K = g.K, nt = K / BK;
    unsigned voffA[2];
#pragma unroll
    for (int i = 0; i < 2; ++i) { int R, C; stage_rc(tid * 16 + i * 8192, R, C); voffA[i] = (unsigned)(R * K + C) * 2u; }
    const size_t kstep = (size_t)(BK * 2);
    const size_t hstep = (size_t)HALF * K * 2;
    const size_t tstep = 2 * hstep;
    const unsigned ldsw = (unsigned)wid * 1024u;
    const int aoff = lds_byte(wr * 64 + fr, fq * 8), boff = lds_byte(wc * 32 + fr, fq * 8);
#define PG8_SA(b, h) (((b) * 2 + (h)) * HTB)
#define PG8_SB(b, h) ((4 + (b) * 2 + (h)) * HTB)
#define PG8_STAGE(bufoff, gbase) do { _Pragma("unroll") for (int _i = 0; _i < 2; ++_i) \
        __builtin_amdgcn_global_load_lds((const unsigned*)((const char*)(gbase) + voffA[_i]), (PG8_LAS unsigned*)(lds + (bufoff) + ldsw + _i * 8192), 16, 0, 0); } while (0)
#define PG8_LDA(dst, b, h) do { _Pragma("unroll") for (int m = 0; m < 4; ++m) _Pragma("unroll") for (int k = 0; k < 2; ++k) dst[m][k] = *(const PG8_LAS bf16x8*)(lds + PG8_SA(b, h) + aoff + m * 2048 + k * 1024); } while (0)
#define PG8_LDB(dst, b, h) do { _Pragma("unroll") for (int n = 0; n < 2; ++n) _Pragma("unroll") for (int k = 0; k < 2; ++k) dst[n][k] = *(const PG8_LAS bf16x8*)(lds + PG8_SB(b, h) + boff + n * 2048 + k * 1024); } while (0)
#define PG8_MMA(ai, bj, At, Bt) do { __builtin_amdgcn_s_setprio(1); _Pragma("unroll") for (int m = 0; m < 4; ++m) _Pragma("unroll") for (int n = 0; n < 2; ++n) _Pragma("unroll") for (int k = 0; k < 2; ++k) \
        acc[ai][bj][m][n] = __builtin_amdgcn_mfma_f32_16x16x32_bf16(Bt[n][k], At[m][k], acc[ai][bj][m][n], 0, 0, 0); __builtin_amdgcn_s_setprio(0); } while (0)
#define PG8_WAIT_V(n) asm volatile("s_waitcnt vmcnt(" #n ")" ::: "memory")
#define PG8_WAIT_L(n) asm volatile("s_waitcnt lgkmcnt(" #n ")" ::: "memory")
#define PG8_BAR __builtin_amdgcn_s_barrier()
#define PG8_SCHED __builtin_amdgcn_sched_barrier(0)
    Unit cur, nxt; int ui = 0;
    if (!S.next(0, cur)) return;
    f32x4 acc[2][2][4][2];
#pragma unroll
    for (int a = 0; a < 2; ++a)
#pragma unroll
        for (int b = 0; b < 2; ++b)
#pragma unroll
            for (int m = 0; m < 4; ++m)
#pragma unroll
                for (int n = 0; n < 2; ++n) acc[a][b][m][n] = (f32x4){0.f, 0.f, 0.f, 0.f};
    bf16x8 At[4][2], B0[2][2], B1[2][2];
    const char* cA = (const char*)g.A + (size_t)cur.pm * tstep; const char* cB = (const char*)g.Bt + (size_t)cur.pn * tstep;
#define PG8_FTAB(unit) do { if (SCALED && tid < 256) { const int row_ = (unit).pm * BM + tid; \
        const float4 sb_ = *(const float4*)(ssq0 + (size_t)row_ * 4), sd_ = *(const float4*)(ssq1 + (size_t)row_ * 4); \
        const float rB_ = __builtin_amdgcn_rsqf((sb_.x + sb_.y + sb_.z + sb_.w) * (1.f / 256.f) + EPS), rD_ = __builtin_amdgcn_rsqf((sd_.x + sd_.y + sd_.z + sd_.w) * (1.f / 256.f) + EPS); \
        PG8_LAS float* ft_ = (PG8_LAS float*)(lds + STAGE_BYTES); ft_[tid] = rB_ / rD_; ft_[256 + tid] = rD_; } } while (0)
    PG8_FTAB(cur);
    PG8_STAGE(PG8_SB(0, 0), cB); PG8_STAGE(PG8_SB(0, 1), cB + hstep); PG8_STAGE(PG8_SA(0, 0), cA); PG8_STAGE(PG8_SA(0, 1), cA + hstep);
    if (wr == 1) PG8_BAR;
    PG8_WAIT_V(2); PG8_BAR;
    PG8_STAGE(PG8_SB(1, 0), cB + kstep); PG8_STAGE(PG8_SA(1, 0), cA + kstep); PG8_STAGE(PG8_SB(1, 1), cB + hstep + kstep);
    PG8_WAIT_V(6); PG8_BAR;
    for (;;) {
        const bool has_next = S.next(ui + 1, nxt);
        const char* nA = has_next ? (const char*)g.A + (size_t)nxt.pm * tstep : cA; const char* nB = has_next ? (const char*)g.Bt + (size_t)nxt.pn * tstep : cB;
        for (int t = 0; t < nt; t += 2) {
            const bool last = (t == nt - 2);
            const char* a1 = cA + (size_t)(t + 1) * kstep;
            const char* a2 = last ? nA : cA + (size_t)(t + 2) * kstep; const char* b2 = last ? nB : cB + (size_t)(t + 2) * kstep;
            const char* a3 = a2 + kstep; const char* b3 = b2 + kstep;
            if (SCALED && (t == 4 || t == 8)) {
                const PG8_LAS float* ft = (const PG8_LAS float*)(lds + STAGE_BYTES) + (t == 8 ? 256 : 0);
#pragma unroll
                for (int ai = 0; ai < 2; ++ai)
#pragma unroll
                    for (int m = 0; m < 4; ++m) {
                        const float f = ft[ai * HALF + wr * 64 + m * 16 + fr];
#pragma unroll
                        for (int bj = 0; bj < 2; ++bj)
#pragma unroll
                            for (int n = 0; n < 2; ++n) acc[ai][bj][m][n] *= f;
                    }
            }
            PG8_LDB(B0, 0, 0); PG8_LDB(B1, 0, 1); PG8_SCHED; PG8_LDA(At, 0, 0); PG8_STAGE(PG8_SA(1, 1), a1 + hstep);
            PG8_WAIT_V(8); PG8_WAIT_L(0); PG8_BAR; PG8_MMA(0, 0, At, B0); PG8_MMA(0, 1, At, B1); PG8_BAR; PG8_SCHED;
            PG8_LDA(At, 0, 1); PG8_STAGE(PG8_SB(0, 0), b2); PG8_STAGE(PG8_SB(0, 1), b2 + hstep); PG8_STAGE(PG8_SA(0, 0), a2);
            PG8_WAIT_V(8); PG8_WAIT_L(0); PG8_BAR; PG8_MMA(1, 0, At, B0); PG8_MMA(1, 1, At, B1); PG8_BAR; PG8_SCHED;
            PG8_LDB(B0, 1, 0); PG8_LDB(B1, 1, 1); PG8_SCHED; PG8_LDA(At, 1, 0); PG8_STAGE(PG8_SA(0, 1), a2 + hstep);
            PG8_WAIT_V(8); PG8_WAIT_L(0); PG8_BAR; PG8_MMA(0, 0, At, B0); PG8_MMA(0, 1, At, B1); PG8_BAR; PG8_SCHED;
            PG8_LDA(At, 1, 1); PG8_STAGE(PG8_SB(1, 0), b3); PG8_STAGE(PG8_SB(1, 1), b3 + hstep); PG8_STAGE(PG8_SA(1, 0), a3);
            PG8_WAIT_V(8); PG8_WAIT_L(0); PG8_BAR; PG8_MMA(1, 0, At, B0); PG8_MMA(1, 1, At, B1); PG8_BAR; PG8_SCHED;
        }
        if (wr == 0) PG8_BAR;
        E(acc, cur, wr, wc, fr, fq);
        if (!has_next) break;
#pragma unroll
        for (int a = 0; a < 2; ++a)
#pragma unroll
            for (int b = 0; b < 2; ++b)
#pragma unroll
                for (int m = 0; m < 4; ++m)
#pragma unroll
                    for (int n = 0; n < 2; ++n) acc[a][b][m][n] = (f32x4){0.f, 0.f, 0.f, 0.f};
        cur = nxt; cA = nA; cB = nB; ++ui;
        if (wr == 1) PG8_BAR;
        PG8_FTAB(cur);
    }
    PG8_WAIT_V(0);
    PG8_BAR;
#undef PG8_FTAB
#undef PG8_SA
#undef PG8_SB
#undef PG8_STAGE
#undef PG8_LDA
#undef PG8_LDB
#undef PG8_MMA
#undef PG8_WAIT_V
#undef PG8_WAIT_L
#undef PG8_BAR
#undef PG8_SCHED
}
}

enum { PH_PRO = 0, PH_CONV, PH_P1, PH_P2, PH_P3, PH_P4, PH_P5, PH_P6, PH_P7, PH_P8, PH_P9, PH_P10, PH_COUNT };

DI void gemm_item_bf16(const bf16_t* A, int lda, const bf16_t* Bt, int K, int nM, int nN, int L, bf16_t* O, int ldo, const float* part, int npart, float inv_n, unsigned char* smem) {
    int pm, pn; tile_order(L, nM, nN, pm, pn);
    if (part) fill_rs(smem, part, npart, pm * 128, inv_n);
    f32x4 acc[4][4];
    gemm_mainloop<false>(A, lda, Bt, K, pm * 128, pn * 128, smem, acc);
    epi_bf16(acc, O, ldo, pm * 128, pn * 128, part ? (const float*)(smem + 65536) : nullptr);
    __syncthreads();
}
template <bool ASC>
DI void gemm_item_resid(const Params& p, const bf16_t* A, int lda, const bf16_t* Bt, int K, int L, unsigned char* smem) {
    int pm, pn; tile_order(L, 256, 8, pm, pn);
    if (ASC) {
        float* asc = (float*)(smem + 66048);
        const float* sb = (const float*)(p.ws + OFF_SSQB); const float* sd = (const float*)(p.ws + OFF_SSQD);
        const int tid = tidx();
        if (tid < 128) {
            const float4 a = *(const float4*)(sb + (size_t)(pm * 128 + tid) * 4), d = *(const float4*)(sd + (size_t)(pm * 128 + tid) * 4);
            asc[tid * 2] = __builtin_amdgcn_rsqf((a.x + a.y + a.z + a.w) * (1.f / 256.f) + EPS);
            asc[tid * 2 + 1] = __builtin_amdgcn_rsqf((d.x + d.y + d.z + d.w) * (1.f / 256.f) + EPS);
        }
    }
    f32x4 acc[4][4];
    gemm_mainloop<ASC>(A, lda, Bt, K, pm * 128, pn * 128, smem, acc);
    epi_resid(acc, p.out, (bf16_t*)(p.ws + OFF_XB), (float*)(p.ws + OFF_ROWSQ), pm * 128, pn * 128);
    __syncthreads();
}

DI void run_phase(const Params& p, int ph, int l, unsigned char* smem0) {
    const int vb = __builtin_amdgcn_readfirstlane((int)(threadIdx.x >> 8));
    unsigned char* smem = smem0 + vb * LDS_BYTES;
    const int G = gridDim.x * 2, bid = blockIdx.x * 2 + vb;
    const bf16_t* W = (const bf16_t*)(p.ws + OFF_W);
    const bf16_t* XB = (const bf16_t*)(p.ws + OFF_XB);
    bf16_t* U = (bf16_t*)(p.ws + OFF_U);
    const float* ROWSQ = (const float*)(p.ws + OFF_ROWSQ);
#ifdef ONLY_PH
    if (ph != ONLY_PH) return;
#endif
    switch (ph) {
    case PH_PRO: {
        for (int i = bid; i < 2048; i += G) pro_rows(p.in[I_X], p.out, (bf16_t*)(p.ws + OFF_XB), (float*)(p.ws + OFF_ROWSQ), 16, i);
        for (int i = bid; i < 128; i += G) pro_rows(p.in[I_MEM], nullptr, (bf16_t*)(p.ws + OFF_MEMB), (float*)(p.ws + OFF_MEMSQ), 1, i);
        for (int i = bid; i < 128; i += G) pro_rope(p, i);
        for (int i = bid; i < 512; i += G) { const int ll = i >> 7; conv_tile(p.in[I_XWKV] + (size_t)ll * DM * 512, DM, 512, 512, p.in[I_GMEM] + ll * DM, 0, (bf16_t*)(p.ws + OFF_XWKV) + (size_t)ll * 512 * DM, i & 127, smem); }
        for (int i = bid; i < CONV_TILES; i += G) conv_layer_item(p, 0, i, smem);
    } break;
    case PH_CONV: {
        for (int it = bid; it < CONV_TILES; it += G) conv_layer_item(p, l, it, smem);
    } break;
    case PH_P1: {
        { pg8::Gemm g{XB, W + W_IN, T_TOK, UC, DM}; pg8::StaticOrder S; S.init(T_TOK, UC, gridDim.x, blockIdx.x);
          pg8::EpiScaled E{U, UC, ROWSQ};
          pg8::gemm_phase<pg8::EpiScaled>((PG8_LAS unsigned char*)smem0, g, S, E); }
        if (l == 0) {
            for (int i = bid; i < 256; i += G) {
                const int ll = i >> 6;
                gemm_item_bf16((const bf16_t*)(p.ws + OFF_MEMB), DM, (const bf16_t*)(p.ws + OFF_XWKV) + (size_t)ll * 512 * DM, DM, 16, 4, i & 63,
                               (bf16_t*)(p.ws + OFF_KVMEM) + (size_t)ll * 2048 * 512, 512, (const float*)(p.ws + OFF_MEMSQ), 1, 1.f / DM, smem);
            }
        }
    } break;
    case PH_P2: {
        for (int i = bid; i < 1024; i += G) hgrn_local_tile(p, l, i, smem);
#ifdef RP2_HL
        for (int i = bid; i < 1024; i += G) hgrn_local_tile(p, l, i, smem);
#endif
        for (int i = bid; i < 1024; i += G) conformer_tile(p, l, i, smem);
#ifdef RP2_CF
        for (int i = bid; i < 1024; i += G) conformer_tile(p, l, i, smem);
#endif
#ifdef RP2_G
        for (int i = bid; i < 768; i += G) gemm_item_bf16(U + 2560, UC, W + W_UQ, 256, 256, 3, i, (bf16_t*)(p.ws + OFF_QRAW), 384, nullptr, 0, 0.f, smem);
        for (int i = bid; i < 1024; i += G) gemm_item_bf16(U + 2816, UC, W + W_UKV, 128, 256, 4, i, (bf16_t*)(p.ws + OFF_KVRAW), 512, nullptr, 0, 0.f, smem);
#endif
#ifdef RP2_SC
        for (int i = bid; i < 512; i += G) shortconv_tile(p, l, i);
#endif
        for (int i = bid; i < 768; i += G) gemm_item_bf16(U + 2560, UC, W + W_UQ, 256, 256, 3, i, (bf16_t*)(p.ws + OFF_QRAW), 384, nullptr, 0, 0.f, smem);
        for (int i = bid; i < 1024; i += G) gemm_item_bf16(U + 2816, UC, W + W_UKV, 128, 256, 4, i, (bf16_t*)(p.ws + OFF_KVRAW), 512, nullptr, 0, 0.f, smem);
        for (int i = bid; i < 512; i += G) shortconv_tile(p, l, i);
        if (l == 0) { for (int i = bid; i < 128; i += G) memkv_finish_tile(p, i, smem); }
    } break;
    case PH_P3: {
        for (int i = bid; i < 1024; i += G) hgrn_scan_item(p, i);
        for (int i = bid; i < 512; i += G) mla_finish_tile(p, l, i, smem);
#ifdef RP3_MF
        for (int i = bid; i < 512; i += G) mla_finish_tile(p, l, i, smem);
#endif
#ifdef RP3_SC
        for (int i = bid; i < 1024; i += G) hgrn_scan_dummy(p, i);
#endif
    } break;
    case PH_P4: {
        const float c2 = 0.10206207261596575f * 1.4426950408889634f;
        float mb;
        {
            const int ln = tidx() & 63;
            float gq = fmaxf(fabsf(p.in[I_MQNG][l * 96 + ln]), ln < 32 ? fabsf(p.in[I_MQNG][l * 96 + 64 + ln]) : 0.f);
            float gk = fmaxf(fabsf(p.in[I_MKNG][l * 96 + ln]), ln < 32 ? fabsf(p.in[I_MKNG][l * 96 + 64 + ln]) : 0.f);
#pragma unroll
            for (int o = 32; o > 0; o >>= 1) { gq = fmaxf(gq, __shfl_xor(gq, o)); gk = fmaxf(gk, __shfl_xor(gk, o)); }
            mb = 96.f * gq * gk * c2;
        }
        for (int it0 = bid; it0 < 1024; it0 += G) {
            const int xcd = blockIdx.x & 7, jx = ((blockIdx.x >> 3) << 1) + vb, loc = (it0 / G) * 64 + jx;
            const int it = (G == 512) ? (xcd * 128 + loc) : it0;
            const int bh = it >> 5, qt = it & 31, b = bh >> 2, h = bh & 3;
            const size_t tok0 = (size_t)b * SEQ + qt * 128;
            attn_tile<96, false>((const bf16_t*)(p.ws + OFF_MQ) + tok0 * 384 + h * 96, 384, (const bf16_t*)(p.ws + OFF_MK) + (size_t)b * SEQ * 384 + h * 96, 384,
                                 (const bf16_t*)(p.ws + OFF_MVT) + (size_t)bh * 64 * SEQ, SEQ, SEQ, c2, mb, nullptr,
                                 (bf16_t*)(p.ws + OFF_CAT) + tok0 * DM + 256 + h * 64, DM, (float*)(p.ws + OFF_SSQD) + tok0 * 4 + h, 4, smem);
        }
        for (int i = bid; i < 2048; i += G) hgrn_out_tile(p, l, i, smem);
#ifdef REPEAT_HGOUT
        for (int i = bid; i < 2048; i += G) hgrn_out_tile(p, l, i, smem);
#endif
    } break;
    case PH_P5: {
        pg8::Gemm g{(const bf16_t*)(p.ws + OFF_CAT), W + W_OUT, T_TOK, DM, DM}; pg8::StaticOrder S; S.init(T_TOK, DM, gridDim.x, blockIdx.x);
        pg8::EpiResid E{p.out, (bf16_t*)(p.ws + OFF_XB), (float*)(p.ws + OFF_ROWSQ)};
        pg8::gemm_phase<pg8::EpiResid, true>((PG8_LAS unsigned char*)smem0, g, S, E, (const float*)(p.ws + OFF_SSQB), (const float*)(p.ws + OFF_SSQD));
    } break;
    case PH_P6: {
        for (int it = bid; it < 512; it += G) gemm_item_bf16(XB, DM, W + W_XQ, DM, 256, 2, it, (bf16_t*)(p.ws + OFF_XQ), 256, ROWSQ, 16, 1.f / DM, smem);
    } break;
    case PH_P7: {
        const float c2 = 0.125f * 1.4426950408889634f;
        float mb;
        {
            const int ln = tidx() & 63;
            float gq = fabsf(p.in[I_XQNG][l * 64 + ln]), gk = fabsf(p.in[I_XKNG][l * 64 + ln]);
#pragma unroll
            for (int o = 32; o > 0; o >>= 1) { gq = fmaxf(gq, __shfl_xor(gq, o)); gk = fmaxf(gk, __shfl_xor(gk, o)); }
            mb = 64.f * gq * gk * c2;
        }
        for (int it0 = bid; it0 < 1024; it0 += G) {
            const int xcd = blockIdx.x & 7, jx = ((blockIdx.x >> 3) << 1) + vb, loc = (it0 / G) * 64 + jx;
            const int it = (G == 512) ? (xcd * 128 + loc) : it0;
            const int bh = it >> 5, qt = it & 31, b = bh >> 2, h = bh & 3;
            const size_t tok0 = (size_t)b * SEQ + qt * 128;
            attn_tile<64, true>((const bf16_t*)(p.ws + OFF_XQ) + tok0 * 256 + h * 64, 256, (const bf16_t*)(p.ws + OFF_XK) + ((size_t)(l * 8 + b) * 4 + h) * 256 * 64, 64,
                                (const bf16_t*)(p.ws + OFF_XVT) + ((size_t)(l * 8 + b) * 4 + h) * 64 * 256, 256, 256, c2, mb, p.in[I_XQNG] + l * 64,
                                (bf16_t*)(p.ws + OFF_XO) + tok0 * 256 + h * 64, 256, nullptr, 0, smem);
        }
    } break;
    case PH_P8: {
        pg8::Gemm g{(const bf16_t*)(p.ws + OFF_XO), W + W_XO, T_TOK, DM, 256}; pg8::StaticOrder S; S.init(T_TOK, DM, gridDim.x, blockIdx.x);
        pg8::EpiResid E{p.out, (bf16_t*)(p.ws + OFF_XB), (float*)(p.ws + OFF_ROWSQ)};
        pg8::gemm_phase<pg8::EpiResid>((PG8_LAS unsigned char*)smem0, g, S, E);
    } break;
    case PH_P9: {
        pg8::Gemm g{XB, W + W_13, T_TOK, 2 * DFF, DM}; pg8::StaticOrder S; S.init(T_TOK, 2 * DFF, gridDim.x, blockIdx.x);
        pg8::EpiSwiglu E{(bf16_t*)(p.ws + OFF_HFF), ROWSQ};
        pg8::gemm_phase<pg8::EpiSwiglu>((PG8_LAS unsigned char*)smem0, g, S, E);
    } break;
    case PH_P10: {
        pg8::Gemm g{(const bf16_t*)(p.ws + OFF_HFF), W + W_2, T_TOK, DM, DFF}; pg8::StaticOrder S; S.init(T_TOK, DM, gridDim.x, blockIdx.x);
        pg8::EpiResid E{p.out, (bf16_t*)(p.ws + OFF_XB), (float*)(p.ws + OFF_ROWSQ)};
        pg8::gemm_phase<pg8::EpiResid>((PG8_LAS unsigned char*)smem0, g, S, E);
    } break;
    }
}

#define XB_TMO      128
#define XB_XCNT(j)  (256  + 64 * (j))
#define XB_XSUB(j)  (1280 + 64 * (j))
#define XB_XGEN(j)  (2304 + 64 * (j))
#define XB_TOP      3328
#define XB_TOPGEN   3392
#define XCD_BAR_WORDS 3456
#define XB_SPIN_CAP (1u << 22)
#define LAS __attribute__((address_space(3)))
DI unsigned xb_ld(unsigned* p)              { return __hip_atomic_load(p, __ATOMIC_RELAXED, __HIP_MEMORY_SCOPE_AGENT); }
DI unsigned xb_add(unsigned* p, unsigned v) { return __hip_atomic_fetch_add(p, v, __ATOMIC_RELAXED, __HIP_MEMORY_SCOPE_AGENT); }
DI unsigned xb_xcc_id() { return (unsigned)__builtin_amdgcn_s_getreg((3 << 11) | 20) & 0xFu; }
#define XB_SPIN(cond, bar) do { unsigned _sp = 0; while (cond) { __builtin_amdgcn_s_sleep(1); \
    if ((++_sp & 255u) == 0u) { if (xb_ld(&(bar)[XB_TMO])) break; if (_sp > XB_SPIN_CAP) { atomicAdd(&(bar)[XB_TMO], 1u); break; } } } } while (0)
struct XcdBarrier { unsigned* bar; unsigned x; volatile LAS unsigned* st; };
DI XcdBarrier xcd_barrier_post(unsigned* bar, volatile LAS unsigned* st) {
    XcdBarrier b; b.bar = bar; b.x = xb_xcc_id(); b.st = st;
    if (threadIdx.x == 0) (void)xb_add(&bar[XB_XCNT(b.x)], 1u);
    return b;
}
DI void xcd_barrier_complete(unsigned* bar, unsigned x, unsigned& nloc, unsigned& nx) {
    const unsigned G = gridDim.x * gridDim.y * gridDim.z;
    unsigned sum, cnt, mine, sp = 0u;
    for (;;) {
        sum = 0u; cnt = 0u; mine = 0u;
#pragma unroll
        for (unsigned j = 0; j < 16; ++j) { const unsigned c = xb_ld(&bar[XB_XCNT(j)]); sum += c; cnt += (c > 0u) ? 1u : 0u; mine = (j == x) ? c : mine; }
        if (sum == G) break;
        __builtin_amdgcn_s_sleep(1);
        if ((++sp & 255u) == 0u) { if (xb_ld(&bar[XB_TMO])) break; if (sp > XB_SPIN_CAP) { atomicAdd(&bar[XB_TMO], 1u); break; } }
    }
    nloc = mine > 0u ? mine : 1u; nx = cnt > 0u ? cnt : 1u;
}
DI void xcd_barrier(const XcdBarrier& b) {
    asm volatile("s_waitcnt vmcnt(0)" ::: "memory");
    __syncthreads();
    if (threadIdx.x == 0) {
        unsigned* bar = b.bar;
        __builtin_amdgcn_s_waitcnt(0);
        unsigned nloc = b.st[0], nx = b.st[1];
        if (nloc == 0u) { xcd_barrier_complete(bar, b.x, nloc, nx); b.st[0] = nloc; b.st[1] = nx; }
        const unsigned old = xb_add(&bar[XB_XSUB(b.x)], 1u);
        const unsigned gen = old / nloc;
        if (old + 1u == (gen + 1u) * nloc) {
            __builtin_amdgcn_fence(__ATOMIC_RELEASE, "agent");
            asm volatile("s_waitcnt vmcnt(0)" ::: "memory");
            const unsigned og = xb_add(&bar[XB_TOP], 1u);
            const unsigned tg = og / nx;
            if (og + 1u == (tg + 1u) * nx) xb_add(&bar[XB_TOPGEN], 1u);
            else XB_SPIN(xb_ld(&bar[XB_TOPGEN]) == tg, bar);
            __builtin_amdgcn_fence(__ATOMIC_ACQUIRE, "agent");
            xb_add(&bar[XB_XGEN(b.x)], 1u);
            asm volatile("s_waitcnt vmcnt(0)" ::: "memory");
        } else {
            XB_SPIN(xb_ld(&bar[XB_XGEN(b.x)]) == gen, bar);
            __builtin_amdgcn_fence(__ATOMIC_ACQUIRE, "agent");
            asm volatile("s_waitcnt vmcnt(0)" ::: "memory");
        }
    }
    __syncthreads();
}

extern __shared__ __attribute__((aligned(16))) unsigned char dyn_smem[];

__global__ void __launch_bounds__(512, 2) mega_kernel(Params p) {
    cg::grid_group grid = cg::this_grid();
    volatile LAS unsigned* st = (volatile LAS unsigned*)(dyn_smem + 2 * LDS_BYTES);
    if (threadIdx.x == 0) { st[0] = 0u; st[1] = 0u; st[2] = 0u; st[3] = 0u; }
    __syncthreads();
    XcdBarrier xb = xcd_barrier_post((unsigned*)(p.ws + WS_BAR), st);
    const int nsteps = p.ph_hi;
    const bool single = (p.ph_hi - p.ph_lo) == 1;
    for (int step = p.ph_lo; step < nsteps; ++step) {
        int ph, l;
        if (step == 0) { ph = PH_PRO; l = 0; }
        else { l = (step - 1) / 11; ph = PH_CONV + (step - 1) % 11; }
        if (ph == PH_CONV && l == 0) continue;
        run_phase(p, ph, l, dyn_smem);
#ifdef REPEAT_PH
        if (ph == REPEAT_PH) { xcd_barrier(xb); run_phase(p, ph, l, dyn_smem); }
#endif
        if (single) break;
        if (step == 0) grid.sync();
        else if (step + 1 < nsteps) xcd_barrier(xb);
    }
}

extern "C" void kernel_launch(void* const* d_in, const int* in_sizes, int n_in, void* d_out, int out_size, void* d_ws, size_t ws_size, hipStream_t stream) {
    static int grid = 0;
    if (grid == 0) {
        if (n_in != N_IN || ws_size < WS_END + 256 || out_size != T_TOK * DM) { fprintf(stderr, "kernel_launch: unexpected sizes n_in %d ws %zu (need %zu) out %d\n", n_in, ws_size, (size_t)WS_END, out_size); grid = -1; return; }
        int dev = 0, cus = 0, per_cu = 0;
        (void)hipGetDevice(&dev);
        (void)hipDeviceGetAttribute(&cus, hipDeviceAttributeMultiprocessorCount, dev);
        (void)hipFuncSetAttribute((const void*)mega_kernel, hipFuncAttributeMaxDynamicSharedMemorySize, LDS_ALLOC);
        (void)hipOccupancyMaxActiveBlocksPerMultiprocessor(&per_cu, (const void*)mega_kernel, 512, LDS_ALLOC);
        if (per_cu < 1) fprintf(stderr, "kernel_launch: occupancy query says %d blocks per CU\n", per_cu);
        grid = cus;
        (void)hipGetLastError();
    }
    if (grid < 0) return;
    Params p{};
    for (int i = 0; i < N_IN; ++i) p.in[i] = (const float*)d_in[i];
    p.out = (float*)d_out; p.ws = (unsigned char*)d_ws;
    (void)hipMemsetAsync((unsigned char*)d_ws + WS_BAR, 0, XCD_BAR_WORDS * 4, stream);
    p.ph_lo = 0; p.ph_hi = 1 + NL * 11;
    void* args[] = {&p};
    hipError_t e = hipLaunchCooperativeKernel((const void*)mega_kernel, dim3(grid), dim3(512), args, LDS_ALLOC, stream);
    if (e != hipSuccess) fprintf(stderr, "cooperative launch failed: %s (grid %d)\n", hipGetErrorString(e), grid);
}
```

```cpp
#include <hip/hip_runtime.h>
#include <hip/hip_cooperative_groups.h>
#include <cstdio>
#include <cstdint>
namespace cg = cooperative_groups;

#ifndef MEGA
#define MEGA 1
#endif

typedef unsigned short bf16_t;
typedef short bf16x8 __attribute__((ext_vector_type(8)));
typedef float f32x4 __attribute__((ext_vector_type(4)));
typedef unsigned u32x4 __attribute__((ext_vector_type(4)));
typedef unsigned u32x2 __attribute__((ext_vector_type(2)));

#define DI __device__ __forceinline__
#define MFMA16(a, b, c) __builtin_amdgcn_mfma_f32_16x16x32_bf16((a), (b), (c), 0, 0, 0)

constexpr int T_TOK = 32768, SEQ = 4096, NB = 8, DM = 1024, NL = 4;
constexpr int UC = 3072;
constexpr int INC = 2976;
constexpr int DFF = 2816;
constexpr float EPS = 1e-6f;
constexpr int LDS_BYTES = 73728;
constexpr int LDS_ALLOC = 2 * LDS_BYTES + 16;

constexpr size_t SZ_W = 13533184ull * 2;
constexpr size_t OFF_W = 0;
constexpr size_t OFF_XWKV = OFF_W + SZ_W;
constexpr size_t OFF_XB = OFF_XWKV + 4ull * 512 * 1024 * 2;
constexpr size_t OFF_MEMB = OFF_XB + (size_t)T_TOK * 1024 * 2;
constexpr size_t OFF_U = OFF_MEMB + 2048ull * 1024 * 2;
constexpr size_t OFF_CAT = OFF_U + (size_t)T_TOK * UC * 2;
constexpr size_t OFF_MQ = OFF_CAT + (size_t)T_TOK * 1024 * 2;
constexpr size_t OFF_MK = OFF_MQ + (size_t)T_TOK * 384 * 2;
constexpr size_t OFF_MVT = OFF_MK + (size_t)T_TOK * 384 * 2;
constexpr size_t OFF_HST = OFF_MVT + (size_t)T_TOK * 256 * 2;
constexpr size_t OFF_HDEC = OFF_HST + 64ull * 64 * 4096 * 4;
constexpr size_t OFF_XK = OFF_HDEC + 64ull * 64 * 64 * 4;
constexpr size_t OFF_XVT = OFF_XK + 4ull * 8 * 4 * 256 * 64 * 2;
constexpr size_t OFF_ROPE = OFF_XVT + 4ull * 8 * 4 * 256 * 64 * 2;
constexpr size_t OFF_ROWSQ = OFF_ROPE + (size_t)T_TOK * 16 * 2 * 4;
constexpr size_t OFF_MEMSQ = OFF_ROWSQ + (size_t)T_TOK * 16 * 4;
constexpr size_t OFF_SSQB = OFF_MEMSQ + 2048 * 4;
constexpr size_t OFF_SSQD = OFF_SSQB + (size_t)T_TOK * 4 * 4;
constexpr size_t WS_BAR = OFF_SSQD + (size_t)T_TOK * 4 * 4;
constexpr size_t WS_END = WS_BAR + 16384;
constexpr size_t OFF_QRAW = OFF_XB;
constexpr size_t OFF_KVRAW = OFF_XB + (size_t)T_TOK * 384 * 2;
constexpr size_t OFF_KVMEM = OFF_MQ;
constexpr size_t OFF_XQ = OFF_U;
constexpr size_t OFF_XO = OFF_U + (size_t)T_TOK * 256 * 2;
constexpr size_t OFF_HFF = OFF_U;
constexpr size_t W_IN = 0, W_OUT = 3145728, W_UQ = 4194304, W_UKV = 4292608, W_XQ = 4358144, W_XO = 4620288, W_13 = 4882432, W_2 = 10649600;

enum { I_X = 0, I_MEM, I_POS, I_GMIX, I_WIN, I_ADWW, I_ADWB, I_ALNG, I_ALNB, I_HGAM, I_HONG, I_CDWW, I_CDWB, I_MQAG, I_MWUQ, I_MKVAG,
       I_MWUKV, I_MQNG, I_MKNG, I_GBR, I_WOUT, I_GXQ, I_GMEM, I_XWQ, I_XWKV, I_XQNG, I_XKNG, I_XWO, I_GFFN, I_W13, I_W2, N_IN };

struct Params {
    const float* in[N_IN];
    float* out;
    unsigned char* ws;
    int ph_lo, ph_hi;
    int layer, pad;
};

typedef __bf16 bf2_t __attribute__((ext_vector_type(2)));
typedef float f2_t __attribute__((ext_vector_type(2)));
DI unsigned cvt_pk(float lo, float hi) { f2_t v = {lo, hi}; bf2_t b = __builtin_convertvector(v, bf2_t); return __builtin_bit_cast(unsigned, b); }
DI bf16_t f2bf(float x) { return (bf16_t)(cvt_pk(x, 0.f) & 0xffffu); }
DI float bf2f(bf16_t h) { return __uint_as_float(((unsigned)h) << 16); }
DI float bflo(unsigned w) { return __uint_as_float(w << 16); }
DI float bfhi(unsigned w) { return __uint_as_float(w & 0xffff0000u); }
DI float sigmoidf_(float x) { return __builtin_amdgcn_rcpf(1.f + __expf(-x)); }
DI int tidx() { int t = threadIdx.x & 255; asm volatile("" : "+v"(t)); return t; }
DI float wave_sum(float v) {
#pragma unroll
    for (int o = 32; o > 0; o >>= 1) v += __shfl_xor(v, o);
    return v;
}

DI int sw_off(int row, int chunk) { return row * 128 + ((chunk ^ ((row >> 1) & 7)) << 4); }

DI void scale_chunk(uint4& v, float s) {
    v.x = cvt_pk(bflo(v.x) * s, bfhi(v.x) * s); v.y = cvt_pk(bflo(v.y) * s, bfhi(v.y) * s);
    v.z = cvt_pk(bflo(v.z) * s, bfhi(v.z) * s); v.w = cvt_pk(bflo(v.w) * s, bfhi(v.w) * s);
}

template <bool ASC>
DI void gemm_mainloop(const bf16_t* __restrict__ A, int lda, const bf16_t* __restrict__ Bt, int K, int row0, int col0,
                      unsigned char* smem, f32x4 (&acc)[4][4]) {
    const int tid = tidx(), lane = tid & 63, w = tid >> 6, wr = w >> 1, wc = w & 1, l15 = lane & 15, quad = lane >> 4;
    const int lr = tid >> 3, lc = tid & 7;
    const bf16_t* Ap = A + (size_t)(row0 + lr) * lda + lc * 8;
    const bf16_t* Bp = Bt + (size_t)(col0 + lr) * K + lc * 8;
    const size_t as1 = (size_t)32 * lda, bs1 = (size_t)32 * K;
    const float* asc = (const float*)(smem + 66048);
    uint4 ra0, ra1, ra2, ra3, rb0, rb1, rb2, rb3;
#define G_LOAD(ko) do { ra0 = *(const uint4*)(Ap + (ko)); ra1 = *(const uint4*)(Ap + as1 + (ko)); ra2 = *(const uint4*)(Ap + 2 * as1 + (ko)); ra3 = *(const uint4*)(Ap + 3 * as1 + (ko)); \
                        rb0 = *(const uint4*)(Bp + (ko)); rb1 = *(const uint4*)(Bp + bs1 + (ko)); rb2 = *(const uint4*)(Bp + 2 * bs1 + (ko)); rb3 = *(const uint4*)(Bp + 3 * bs1 + (ko)); } while (0)
#define G_STORE(buf) do { unsigned char* Ad_ = smem + (buf) * 16384; unsigned char* Bd_ = smem + 32768 + (buf) * 16384; const int o_ = sw_off(lr, lc); \
                          *(uint4*)(Ad_ + o_) = ra0; *(uint4*)(Ad_ + o_ + 4096) = ra1; *(uint4*)(Ad_ + o_ + 8192) = ra2; *(uint4*)(Ad_ + o_ + 12288) = ra3; \
                          *(uint4*)(Bd_ + o_) = rb0; *(uint4*)(Bd_ + o_ + 4096) = rb1; *(uint4*)(Bd_ + o_ + 8192) = rb2; *(uint4*)(Bd_ + o_ + 12288) = rb3; } while (0)
    const int plc = (tid & 7) ^ ((tid >> 4) & 7);
    const bf16_t* Adp = A + (size_t)(row0 + lr) * lda + plc * 8;
    const bf16_t* Bdp = Bt + (size_t)(col0 + lr) * K + plc * 8;
#define D_STAGE(buf, ko) do { _Pragma("unroll") for (int i_ = 0; i_ < 4; ++i_) { \
        __builtin_amdgcn_global_load_lds((const unsigned*)(Adp + i_ * as1 + (ko)), (unsigned*)(smem + (buf) * 16384 + i_ * 4096 + tid * 16), 16, 0, 0); \
        __builtin_amdgcn_global_load_lds((const unsigned*)(Bdp + i_ * bs1 + (ko)), (unsigned*)(smem + 32768 + (buf) * 16384 + i_ * 4096 + tid * 16), 16, 0, 0); } } while (0)
    if (ASC) { G_LOAD(0); } else { D_STAGE(0, 0); }
#pragma unroll
    for (int m = 0; m < 4; ++m)
#pragma unroll
        for (int n = 0; n < 4; ++n) acc[m][n] = (f32x4){0.f, 0.f, 0.f, 0.f};
    if (ASC) { G_STORE(0); }
    __syncthreads();
    const int nk = K >> 6;
    for (int kt = 0; kt < nk; ++kt) {
        const int cur = kt & 1;
        const bool more = (kt + 1 < nk);
        if (more) { const int ko = (kt + 1) * 64; if (ASC) { G_LOAD(ko); } else { D_STAGE(cur ^ 1, ko); } }
        __builtin_amdgcn_sched_barrier(0);
        const unsigned char* As = smem + cur * 16384;
        const unsigned char* Bs = smem + 32768 + cur * 16384;
#pragma unroll
        for (int ks = 0; ks < 2; ++ks) {
            bf16x8 af[4], bfv[4];
#pragma unroll
            for (int m = 0; m < 4; ++m) af[m] = *(const bf16x8*)(As + sw_off(wr * 64 + m * 16 + l15, ks * 4 + quad));
#pragma unroll
            for (int n = 0; n < 4; ++n) bfv[n] = *(const bf16x8*)(Bs + sw_off(wc * 64 + n * 16 + l15, ks * 4 + quad));
#pragma unroll
            for (int m = 0; m < 4; ++m)
#pragma unroll
                for (int n = 0; n < 4; ++n) acc[m][n] = MFMA16(bfv[n], af[m], acc[m][n]);
        }
        __builtin_amdgcn_sched_barrier(0);
        if (ASC && more) {
            const int grp = ((kt + 1) * 64) >> 8;
            if (grp & 1) {
                const int which = grp >> 1;
                scale_chunk(ra0, asc[lr * 2 + which]); scale_chunk(ra1, asc[(lr + 32) * 2 + which]);
                scale_chunk(ra2, asc[(lr + 64) * 2 + which]); scale_chunk(ra3, asc[(lr + 96) * 2 + which]);
            }
            G_STORE(cur ^ 1);
        }
        __syncthreads();
    }
#undef G_LOAD
#undef G_STORE
#undef D_STAGE
}

DI void tile_order(int L, int nM, int nN, int& pm, int& pn) {
    const int nwg = nM * nN;
    int wgid = L;
    { const int q = nwg / 8, r = nwg % 8, xcd = wgid % 8, off = wgid / 8; wgid = (xcd < r ? xcd * (q + 1) : r * (q + 1) + (xcd - r) * q) + off; }
    const int WGM = 8;
    const int nig = WGM * nN, gid = wgid / nig, fm = gid * WGM, gsz = (nM - fm) < WGM ? (nM - fm) : WGM;
    pm = fm + ((wgid % nig) % gsz); pn = (wgid % nig) / gsz;
}

DI void fill_rs(unsigned char* smem, const float* part, int npart, int row0, float inv_n) {
    float* rs = (float*)(smem + 65536);
    const int tid = tidx();
    if (tid < 128) {
        float s = 0.f;
        for (int i = 0; i < npart; ++i) s += part[(size_t)(row0 + tid) * npart + i];
        rs[tid] = __builtin_amdgcn_rsqf(s * inv_n + EPS);
    }
}

DI void epi_bf16(const f32x4 (&acc)[4][4], bf16_t* O, int ldo, int row0, int col0, const float* rs) {
    const int lane = tidx() & 63, w = tidx() >> 6, wr = w >> 1, wc = w & 1, l15 = lane & 15, quad = lane >> 4;
#pragma unroll
    for (int m = 0; m < 4; ++m) {
        const int rl = wr * 64 + m * 16 + l15;
        const float sc = rs ? rs[rl] : 1.f;
        bf16_t* rowp = O + (size_t)(row0 + rl) * ldo + col0 + wc * 64 + quad * 4;
#pragma unroll
        for (int n = 0; n < 4; ++n) {
            u32x2 v; v.x = cvt_pk(acc[m][n][0] * sc, acc[m][n][1] * sc); v.y = cvt_pk(acc[m][n][2] * sc, acc[m][n][3] * sc);
            *(u32x2*)(rowp + n * 16) = v;
        }
    }
}
DI void epi_resid(const f32x4 (&acc)[4][4], float* X, bf16_t* XB, float* rowsq, int row0, int col0) {
    const int lane = tidx() & 63, w = tidx() >> 6, wr = w >> 1, wc = w & 1, l15 = lane & 15, quad = lane >> 4;
    const int pn = col0 >> 7;
#pragma unroll
    for (int m = 0; m < 4; ++m) {
        const int row = row0 + wr * 64 + m * 16 + l15;
        float ss = 0.f;
#pragma unroll
        for (int n = 0; n < 4; ++n) {
            const int col = col0 + wc * 64 + n * 16 + quad * 4;
            float4* xp = (float4*)(X + (size_t)row * DM + col);
            float4 xv = *xp;
            xv.x += acc[m][n][0]; xv.y += acc[m][n][1]; xv.z += acc[m][n][2]; xv.w += acc[m][n][3];
            *xp = xv;
            u32x2 v; v.x = cvt_pk(xv.x, xv.y); v.y = cvt_pk(xv.z, xv.w);
            *(u32x2*)(XB + (size_t)row * DM + col) = v;
            ss += xv.x * xv.x + xv.y * xv.y + xv.z * xv.z + xv.w * xv.w;
        }
        ss += __shfl_xor(ss, 16); ss += __shfl_xor(ss, 32);
        if (quad == 0) rowsq[(size_t)row * 16 + pn * 2 + wc] = ss;
    }
}
DI void epi_swiglu(const f32x4 (&acc)[4][4], bf16_t* H, int row0, int col0, const float* rs) {
    const int lane = tidx() & 63, w = tidx() >> 6, wr = w >> 1, wc = w & 1, l15 = lane & 15, quad = lane >> 4;
#pragma unroll
    for (int m = 0; m < 4; ++m) {
        const int rl = wr * 64 + m * 16 + l15;
        const float sc = rs[rl];
        bf16_t* rowp = H + (size_t)(row0 + rl) * DFF + ((col0 + wc * 64) >> 1) + quad * 4;
#pragma unroll
        for (int np = 0; np < 2; ++np) {
            float h[4];
#pragma unroll
            for (int j = 0; j < 4; ++j) { const float a1 = acc[m][2 * np][j] * sc, a3 = acc[m][2 * np + 1][j] * sc; h[j] = a1 * sigmoidf_(a1) * a3; }
            u32x2 v; v.x = cvt_pk(h[0], h[1]); v.y = cvt_pk(h[2], h[3]);
            *(u32x2*)(rowp + np * 16) = v;
        }
    }
}

DI void conv_tile(const float* __restrict__ src, int K, int N, int Npad, const float* __restrict__ gain, int perm, bf16_t* __restrict__ dst, int tile, unsigned char* smem) {
    float* lds = (float*)smem;
    const int nkt = K >> 6, kt = tile % nkt, nt = tile / nkt, k0 = kt * 64, n0 = nt * 64;
    const int tid = tidx(), nl = tid & 63, kq = tid >> 6;
    const int R = n0 + nl;
    int sc = R;
    if (perm == 1) { const int g = R >> 5, j = R & 31; sc = (j < 16) ? (16 * g + j) : (DFF + 16 * g + j - 16); }
    const bool ok = R < N;
#pragma unroll
    for (int i = 0; i < 16; ++i) { const int kl = kq + 4 * i; lds[kl * 65 + nl] = ok ? src[(size_t)(k0 + kl) * N + sc] : 0.f; }
    __syncthreads();
    const int kc = tid & 7, nr = tid >> 3;
    int kd0 = k0;
    if (perm == 2) { const int g = k0 >> 8; const int gm = (g == 0) ? 2 : (g == 1) ? 0 : (g == 2) ? 3 : 1; kd0 = gm * 256 + (k0 & 255); }
    float g8[8];
#pragma unroll
    for (int j = 0; j < 8; ++j) g8[j] = gain ? gain[k0 + kc * 8 + j] : 1.f;
#pragma unroll
    for (int i = 0; i < 2; ++i) {
        const int nl2 = nr + 32 * i;
        float v[8];
#pragma unroll
        for (int j = 0; j < 8; ++j) v[j] = lds[(kc * 8 + j) * 65 + nl2] * g8[j];
        uint4 o; o.x = cvt_pk(v[0], v[1]); o.y = cvt_pk(v[2], v[3]); o.z = cvt_pk(v[4], v[5]); o.w = cvt_pk(v[6], v[7]);
        *(uint4*)(dst + (size_t)(n0 + nl2) * K + kd0 + kc * 8) = o;
    }
    __syncthreads();
}

constexpr int CONV_TILES = 768 + 256 + 24 + 16 + 64 + 64 + 1408 + 704;
DI void conv_layer_item(const Params& p, int l, int it, unsigned char* smem) {
    bf16_t* W = (bf16_t*)(p.ws + OFF_W);
    if (it < 768) { conv_tile(p.in[I_WIN] + (size_t)l * DM * INC, DM, INC, UC, p.in[I_GMIX] + l * DM, 0, W + W_IN, it, smem); return; } it -= 768;
    if (it < 256) { conv_tile(p.in[I_WOUT] + (size_t)l * DM * DM, DM, DM, DM, p.in[I_GBR] + l * DM, 2, W + W_OUT, it, smem); return; } it -= 256;
    if (it < 24) { conv_tile(p.in[I_MWUQ] + (size_t)l * 256 * 384, 256, 384, 384, p.in[I_MQAG] + l * 256, 0, W + W_UQ, it, smem); return; } it -= 24;
    if (it < 16) { conv_tile(p.in[I_MWUKV] + (size_t)l * 128 * 512, 128, 512, 512, p.in[I_MKVAG] + l * 128, 0, W + W_UKV, it, smem); return; } it -= 16;
    if (it < 64) { conv_tile(p.in[I_XWQ] + (size_t)l * DM * 256, DM, 256, 256, p.in[I_GXQ] + l * DM, 0, W + W_XQ, it, smem); return; } it -= 64;
    if (it < 64) { conv_tile(p.in[I_XWO] + (size_t)l * 256 * DM, 256, DM, DM, nullptr, 0, W + W_XO, it, smem); return; } it -= 64;
    if (it < 1408) { conv_tile(p.in[I_W13] + (size_t)l * DM * 2 * DFF, DM, 2 * DFF, 2 * DFF, p.in[I_GFFN] + l * DM, 1, W + W_13, it, smem); return; } it -= 1408;
    conv_tile(p.in[I_W2] + (size_t)l * DFF * DM, DFF, DM, DM, nullptr, 0, W + W_2, it, smem);
}

DI void pro_rows(const float* __restrict__ src, float* __restrict__ cpy, bf16_t* __restrict__ dstb, float* __restrict__ sq, int sqstride, int item) {
    const int w = tidx() >> 6, lane = tidx() & 63;
    for (int r = 0; r < 4; ++r) {
        const int row = item * 16 + w * 4 + r;
        const float4* s4 = (const float4*)(src + (size_t)row * DM);
        float s = 0.f;
#pragma unroll
        for (int i = 0; i < 4; ++i) {
            const float4 v = s4[lane + 64 * i];
            if (cpy) ((float4*)(cpy + (size_t)row * DM))[lane + 64 * i] = v;
            u32x2 o; o.x = cvt_pk(v.x, v.y); o.y = cvt_pk(v.z, v.w);
            *(u32x2*)(dstb + (size_t)row * DM + (lane + 64 * i) * 4) = o;
            s += v.x * v.x + v.y * v.y + v.z * v.z + v.w * v.w;
        }
        s = wave_sum(s);
        if (lane < sqstride) sq[(size_t)row * sqstride + lane] = (lane == 0) ? s : 0.f;
    }
}
DI void pro_rope(const Params& p, int item) {
    const int tok = item * 256 + tidx();
    const int* pos = (const int*)p.in[I_POS];
    float* cs = (float*)(p.ws + OFF_ROPE);
    float* sn = cs + (size_t)T_TOK * 16;
    const float pf = (float)pos[tok];
#pragma unroll
    for (int i = 0; i < 16; ++i) {
        const float inv = powf(10000.0f, -(float)(2 * i) / 32.0f);
        const float ang = pf * inv;
        cs[(size_t)tok * 16 + i] = cosf(ang);
        sn[(size_t)tok * 16 + i] = sinf(ang);
    }
}

DI void conformer_tile(const Params& p, int l, int tile, unsigned char* smem) {
    float* hs = (float*)smem;
    const bf16_t* U = (const bf16_t*)(p.ws + OFF_U);
    bf16_t* CAT = (bf16_t*)(p.ws + OFF_CAT);
    const int tid = tidx(), b = tile >> 7, t0 = (tile & 127) * 32;
    {
        const int c2 = (tid & 127) * 2, half = tid >> 7;
        for (int r0 = half; r0 < 62; r0 += 32) {
            unsigned av[16], gv[16];
#pragma unroll
            for (int k = 0; k < 16; ++k) {
                const int r = r0 + 2 * k, t = t0 - 15 + r;
                av[k] = 0u; gv[k] = 0u;
                if (r < 62 && t >= 0 && t < SEQ) {
                    const bf16_t* up = U + (size_t)(b * SEQ + t) * UC;
                    av[k] = *(const unsigned*)(up + c2); gv[k] = *(const unsigned*)(up + 256 + c2);
                }
            }
#pragma unroll
            for (int k = 0; k < 16; ++k) {
                const int r = r0 + 2 * k;
                if (r < 62) {
                    hs[r * 256 + c2] = bflo(av[k]) * sigmoidf_(bflo(gv[k]));
                    hs[r * 256 + c2 + 1] = bfhi(av[k]) * sigmoidf_(bfhi(gv[k]));
                }
            }
        }
    }
    __syncthreads();
    {
        const int c = tid;
        float wv[31];
        const float* wp = p.in[I_ADWW] + (size_t)l * 31 * 256 + c;
#pragma unroll
        for (int j = 0; j < 31; ++j) wv[j] = wp[j * 256];
        const float bias = p.in[I_ADWB][l * 256 + c];
        for (int t = 0; t < 32; ++t) {
            float y = bias;
#pragma unroll
            for (int j = 0; j < 31; ++j) y += wv[j] * hs[(t + j) * 256 + c];
            hs[t * 256 + c] = y;
        }
    }
    __syncthreads();
    {
        const int w = tid >> 6, lane = tid & 63;
        const float4 g4 = *(const float4*)(p.in[I_ALNG] + l * 256 + lane * 4), b4 = *(const float4*)(p.in[I_ALNB] + l * 256 + lane * 4);
        for (int r = 0; r < 8; ++r) {
            const int t = w * 8 + r;
            float4 v = *(const float4*)(hs + t * 256 + lane * 4);
            const float mu = wave_sum(v.x + v.y + v.z + v.w) * (1.f / 256.f);
            v.x -= mu; v.y -= mu; v.z -= mu; v.w -= mu;
            const float var = wave_sum(v.x * v.x + v.y * v.y + v.z * v.z + v.w * v.w) * (1.f / 256.f);
            const float rstd = __builtin_amdgcn_rsqf(var + EPS);
            float y0 = v.x * rstd * g4.x + b4.x, y1 = v.y * rstd * g4.y + b4.y, y2 = v.z * rstd * g4.z + b4.z, y3 = v.w * rstd * g4.w + b4.w;
            y0 *= sigmoidf_(y0); y1 *= sigmoidf_(y1); y2 *= sigmoidf_(y2); y3 *= sigmoidf_(y3);
            const float ss = wave_sum(y0 * y0 + y1 * y1 + y2 * y2 + y3 * y3);
            const float rb = __builtin_amdgcn_rsqf(ss * (1.f / 256.f) + EPS);
            u32x2 o; o.x = cvt_pk(y0 * rb, y1 * rb); o.y = cvt_pk(y2 * rb, y3 * rb);
            *(u32x2*)(CAT + (size_t)(b * SEQ + t0 + t) * DM + 512 + lane * 4) = o;
        }
    }
    __syncthreads();
}

DI void shortconv_tile(const Params& p, int l, int tile) {
    const bf16_t* U = (const bf16_t*)(p.ws + OFF_U);
    bf16_t* CAT = (bf16_t*)(p.ws + OFF_CAT);
    const int w = tidx() >> 6, lane = tidx() & 63, c = lane * 4;
    const float* wp = p.in[I_CDWW] + (size_t)l * 3 * 256 + c;
    const float4 w0 = *(const float4*)(wp), w1 = *(const float4*)(wp + 256), w2 = *(const float4*)(wp + 512);
    const float4 bb = *(const float4*)(p.in[I_CDWB] + l * 256 + c);
#pragma unroll 4
    for (int r = 0; r < 16; ++r) {
        const int tok = tile * 64 + w * 16 + r, s = tok & (SEQ - 1);
        float pr[3][4];
#pragma unroll
        for (int j = 0; j < 3; ++j) {
            const int sj = s + j - 1;
            if (sj >= 0 && sj < SEQ) {
                const bf16_t* up = U + (size_t)(tok + j - 1) * UC;
                const u32x2 gc = *(const u32x2*)(up + 2048 + c), xi = *(const u32x2*)(up + 2304 + c);
                pr[j][0] = bflo(gc.x) * bflo(xi.x); pr[j][1] = bfhi(gc.x) * bfhi(xi.x); pr[j][2] = bflo(gc.y) * bflo(xi.y); pr[j][3] = bfhi(gc.y) * bfhi(xi.y);
            } else { pr[j][0] = pr[j][1] = pr[j][2] = pr[j][3] = 0.f; }
        }
        const u32x2 gb = *(const u32x2*)(U + (size_t)tok * UC + 1792 + c);
        const float y0 = bflo(gb.x) * (bb.x + w0.x * pr[0][0] + w1.x * pr[1][0] + w2.x * pr[2][0]);
        const float y1 = bfhi(gb.x) * (bb.y + w0.y * pr[0][1] + w1.y * pr[1][1] + w2.y * pr[2][1]);
        const float y2 = bflo(gb.y) * (bb.z + w0.z * pr[0][2] + w1.z * pr[1][2] + w2.z * pr[2][2]);
        const float y3 = bfhi(gb.y) * (bb.w + w0.w * pr[0][3] + w1.w * pr[1][3] + w2.w * pr[2][3]);
        const float ss = wave_sum(y0 * y0 + y1 * y1 + y2 * y2 + y3 * y3);
        const float rb = __builtin_amdgcn_rsqf(ss * (1.f / 256.f) + EPS);
        u32x2 o; o.x = cvt_pk(y0 * rb, y1 * rb); o.y = cvt_pk(y2 * rb, y3 * rb);
        *(u32x2*)(CAT + (size_t)tok * DM + 768 + c) = o;
    }
}

DI float hgrn_lower(const Params& p, int l, int dir, int ch) {
    const float* g = p.in[I_HGAM] + (size_t)dir * NL * 256 + ch;
    const float g0 = g[0], g1 = g[256], g2 = g[512], g3 = g[768];
    const float mx = fmaxf(fmaxf(g0, g1), fmaxf(g2, g3));
    const float e0 = __expf(g0 - mx), e1 = __expf(g1 - mx), e2 = __expf(g2 - mx), e3 = __expf(g3 - mx);
    const float inv = 1.f / (e0 + e1 + e2 + e3);
    float lb = 0.f;
    if (l >= 1) lb += e1; if (l >= 2) lb += e2; if (l >= 3) lb += e3;
    return lb * inv;
}

DI void hgrn_local_tile(const Params& p, int l, int item, unsigned char* smem) {
    const bf16_t* U = (const bf16_t*)(p.ws + OFF_U);
    float* HST = (float*)(p.ws + OFF_HST);
    float* HDEC = (float*)(p.ws + OFF_HDEC);
    const int dir = item >> 9, b = (item >> 6) & 7, c = item & 63;
    const int h = tidx() >> 6, lane = tidx() & 63, l15 = lane & 15, quad = lane >> 4;
    bf16_t* kT = (bf16_t*)(smem + h * 18432);
    bf16_t* vT = kT + 64 * 72;
    const float lb = hgrn_lower(p, l, dir, h * 64 + lane);
    const int tokbase = b * SEQ + c * 64;
    const bf16_t* zp = U + (size_t)tokbase * UC + 768 + dir * 256 + h * 64 + lane;
    const bf16_t* vp = U + (size_t)tokbase * UC + 1280 + h * 64 + lane;
    float suf = 0.f;
    {
        const int step = dir ? UC : -UC, di = dir ? 1 : -1;
        int i = dir ? 0 : 63;
        zp += (size_t)i * UC; vp += (size_t)i * UC;
        bf16_t* kw = kT + lane * 72 + i; bf16_t* vw = vT + lane * 72 + i;
        for (int hb = 0; hb < 2; ++hb) {
            bf16_t zz[32], vv[32];
#pragma unroll
            for (int ii = 0; ii < 32; ++ii) { zz[ii] = zp[(ptrdiff_t)ii * step]; vv[ii] = vp[(ptrdiff_t)ii * step]; }
            zp += (ptrdiff_t)32 * step; vp += (ptrdiff_t)32 * step;
#pragma unroll
            for (int ii = 0; ii < 32; ++ii) {
                const float z = bf2f(zz[ii]);
                const float sg = sigmoidf_(z), f = sg + lb * (1.f - sg), kk = (1.f - lb) * (1.f - sg);
                kw[ii * di] = f2bf(kk * __expf(suf));
                vw[ii * di] = vv[ii];
                suf += __logf(f);
            }
            kw += 32 * di; vw += 32 * di;
        }
    }
    const int seq = (dir * 8 + b) * 4 + h, cs = dir ? 63 - c : c;
    HDEC[((size_t)seq * 64 + cs) * 64 + lane] = __expf(suf);
    __syncthreads();
    f32x4 acc[4][4];
#pragma unroll
    for (int et = 0; et < 4; ++et)
#pragma unroll
        for (int dt = 0; dt < 4; ++dt) acc[et][dt] = (f32x4){0.f, 0.f, 0.f, 0.f};
#pragma unroll
    for (int ks = 0; ks < 2; ++ks) {
        bf16x8 av[4], bk[4];
#pragma unroll
        for (int t = 0; t < 4; ++t) {
            av[t] = *(const bf16x8*)(vT + (t * 16 + l15) * 72 + ks * 32 + quad * 8);
            bk[t] = *(const bf16x8*)(kT + (t * 16 + l15) * 72 + ks * 32 + quad * 8);
        }
#pragma unroll
        for (int et = 0; et < 4; ++et)
#pragma unroll
            for (int dt = 0; dt < 4; ++dt) acc[et][dt] = MFMA16(av[et], bk[dt], acc[et][dt]);
    }
    float* sp = HST + ((size_t)seq * 64 + cs) * 4096;
#pragma unroll
    for (int et = 0; et < 4; ++et)
#pragma unroll
        for (int dt = 0; dt < 4; ++dt)
#pragma unroll
            for (int r = 0; r < 4; ++r) sp[(et * 16 + quad * 4 + r) * 64 + dt * 16 + l15] = acc[et][dt][r];
    __syncthreads();
}

DI void hgrn_scan_item(const Params& p, int item) {
    float* HST = (float*)(p.ws + OFF_HST);
    const float* HDEC = (const float*)(p.ws + OFF_HDEC);
    const int gid = item * 256 + tidx(), seq = gid >> 12, ed = gid & 4095, d = ed & 63;
    float* sp = HST + (size_t)seq * 64 * 4096 + ed;
    const float* dp = HDEC + (size_t)seq * 64 * 64 + d;
    float s = 0.f;
    for (int c0 = 0; c0 < 64; c0 += 16) {
        float loc[16], dec[16];
#pragma unroll
        for (int j = 0; j < 16; ++j) { loc[j] = sp[(size_t)(c0 + j) * 4096]; dec[j] = dp[(c0 + j) * 64]; }
#pragma unroll
        for (int j = 0; j < 16; ++j) { sp[(size_t)(c0 + j) * 4096] = s; s = dec[j] * s + loc[j]; }
    }
}

DI void hgrn_scan_dummy(const Params& p, int item) {
    float* HST = (float*)(p.ws + OFF_HST);
    const float* HDEC = (const float*)(p.ws + OFF_HDEC);
    const int gid = item * 256 + tidx(), seq = gid >> 12, ed = gid & 4095, d = ed & 63;
    float* sp = HST + (size_t)seq * 64 * 4096 + ed;
    const float* dp = HDEC + (size_t)seq * 64 * 64 + d;
    float s = 0.f;
    for (int c0 = 0; c0 < 64; c0 += 8) {
        float loc[8], dec[8];
#pragma unroll
        for (int j = 0; j < 8; ++j) { loc[j] = sp[(size_t)(c0 + j) * 4096]; dec[j] = dp[(c0 + j) * 64]; }
#pragma unroll
        for (int j = 0; j < 8; ++j) { s = dec[j] * s + loc[j]; sp[(size_t)(c0 + j) * 4096] = (s == 12345.678f) ? s : loc[j]; }
    }
}
DI bf16x8 hg_frag(const bf16_t* qk, const float* bc, const float* ref, bool qside) {
    const uint4 x = *(const uint4*)qk;
    const float4 b0 = *(const float4*)bc, b1 = *(const float4*)(bc + 4);
    float4 r0 = {0.f, 0.f, 0.f, 0.f}, r1 = {0.f, 0.f, 0.f, 0.f};
    if (ref) { r0 = *(const float4*)ref; r1 = *(const float4*)(ref + 4); }
    float e[8] = {b0.x - r0.x, b0.y - r0.y, b0.z - r0.z, b0.w - r0.w, b1.x - r1.x, b1.y - r1.y, b1.z - r1.z, b1.w - r1.w};
    if (!qside) {
#pragma unroll
        for (int j = 0; j < 8; ++j) e[j] = -e[j];
    }
    u32x4 o;
    o.x = cvt_pk(bflo(x.x) * __expf(e[0]), bfhi(x.x) * __expf(e[1]));
    o.y = cvt_pk(bflo(x.y) * __expf(e[2]), bfhi(x.y) * __expf(e[3]));
    o.z = cvt_pk(bflo(x.z) * __expf(e[4]), bfhi(x.z) * __expf(e[5]));
    o.w = cvt_pk(bflo(x.w) * __expf(e[6]), bfhi(x.w) * __expf(e[7]));
    return __builtin_bit_cast(bf16x8, o);
}

DI void hgrn_out_tile(const Params& p, int l, int item, unsigned char* smem) {
    const bf16_t* U = (const bf16_t*)(p.ws + OFF_U);
    const float* HST = (const float*)(p.ws + OFF_HST);
    bf16_t* CAT = (bf16_t*)(p.ws + OFF_CAT);
    float* SSQB = (float*)(p.ws + OFF_SSQB);
    const int h = item & 3, c = (item >> 2) & 63, b = item >> 8;
    const int w = tidx() >> 6, lane = tidx() & 63, l15 = lane & 15, quad = lane >> 4;
    float* bc = (float*)smem;
    bf16_t* kk = (bf16_t*)(smem + 34816);
    bf16_t* qq = (bf16_t*)(smem + 34816 + 18432);
    bf16_t* vT = (bf16_t*)(smem + 34816 + 18432 + 9216);
    const int tokbase = b * SEQ + c * 64;
    u32x4 sfr[2][4];
    {
        const int dirp = w & 1;
        const int seqp = (dirp * 8 + b) * 4 + h, csp = dirp ? 63 - c : c;
        const float* sinp = HST + ((size_t)seqp * 64 + csp) * 4096;
#pragma unroll
        for (int ks = 0; ks < 2; ++ks)
#pragma unroll
            for (int et = 0; et < 4; ++et) {
                const float* sp = sinp + (et * 16 + l15) * 64 + ks * 32 + quad * 8;
                const float4 s0 = *(const float4*)sp, s1 = *(const float4*)(sp + 4);
                sfr[ks][et].x = cvt_pk(s0.x, s0.y); sfr[ks][et].y = cvt_pk(s0.z, s0.w); sfr[ks][et].z = cvt_pk(s1.x, s1.y); sfr[ks][et].w = cvt_pk(s1.z, s1.w);
            }
    }
    if (w < 2) {
        const int dir = w;
        const float lb = hgrn_lower(p, l, dir, h * 64 + lane);
        const bf16_t* zp = U + (size_t)tokbase * UC + 768 + dir * 256 + h * 64 + lane;
        float run = 0.f;
        const int step = dir ? -UC : UC, di = dir ? -1 : 1;
        int i = dir ? 63 : 0;
        zp += (size_t)i * UC;
        float* bw = bc + (dir * 64 + i) * 68 + lane; bf16_t* kw = kk + (dir * 64 + i) * 72 + lane;
        {
            bf16_t zz[64];
#pragma unroll
            for (int ii = 0; ii < 64; ++ii) zz[ii] = zp[(ptrdiff_t)ii * step];
#pragma unroll
            for (int ii = 0; ii < 64; ++ii) {
                const float z = bf2f(zz[ii]);
                const float sg = sigmoidf_(z), f = sg + lb * (1.f - sg);
                run += __logf(f);
                bw[ii * di * 68] = run; kw[ii * di * 72] = f2bf((1.f - lb) * (1.f - sg));
            }
        }
    } else if (w == 2) {
        const bf16_t* qp = U + (size_t)tokbase * UC + 512 + h * 64 + lane;
        {
            bf16_t t[64];
#pragma unroll
            for (int i = 0; i < 64; ++i) t[i] = qp[(size_t)i * UC];
#pragma unroll
            for (int i = 0; i < 64; ++i) qq[i * 72 + lane] = t[i];
        }
    } else {
        const bf16_t* vp = U + (size_t)tokbase * UC + 1280 + h * 64 + lane;
        {
            bf16_t t[64];
#pragma unroll
            for (int i = 0; i < 64; ++i) t[i] = vp[(size_t)i * UC];
#pragma unroll
            for (int i = 0; i < 64; ++i) vT[lane * 72 + i] = t[i];
        }
    }
    __syncthreads();
    const int dir = w & 1, iset = w >> 1;
    const int seq = (dir * 8 + b) * 4 + h, cs = dir ? 63 - c : c;
    const float* bcd = bc + dir * 64 * 68;
    const bf16_t* kkd = kk + dir * 64 * 72;
    f32x4 o[4][2];
#pragma unroll
    for (int et = 0; et < 4; ++et) { o[et][0] = (f32x4){0.f, 0.f, 0.f, 0.f}; o[et][1] = (f32x4){0.f, 0.f, 0.f, 0.f}; }
#pragma unroll
    for (int ii = 0; ii < 2; ++ii) {
        const int I = iset == 0 ? (ii == 0 ? 0 : 3) : (ii == 0 ? 1 : 2);
        const int irow = 16 * I + l15;
#pragma unroll
        for (int ks = 0; ks < 2; ++ks) {
            const int d0 = ks * 32 + quad * 8;
            const bf16x8 bq = hg_frag(qq + irow * 72 + d0, bcd + irow * 68 + d0, nullptr, true);
#pragma unroll
            for (int et = 0; et < 4; ++et) o[et][ii] = MFMA16(__builtin_bit_cast(bf16x8, sfr[ks][et]), bq, o[et][ii]);
        }
#pragma unroll
        for (int kk2 = 0; kk2 < 2; ++kk2) {
            f32x4 at[2];
            bool any = false;
#pragma unroll
            for (int jj = 0; jj < 2; ++jj) {
                const int J = 2 * kk2 + jj;
                at[jj] = (f32x4){0.f, 0.f, 0.f, 0.f};
                const bool active = dir == 0 ? (J <= I) : (J >= I);
                if (active) {
                    any = true;
                    const float* ref = nullptr;
                    if (dir == 0) { if (J > 0) ref = bcd + (16 * J - 1) * 68; } else { if (J < 3) ref = bcd + (16 * J + 16) * 68; }
                    const int srow = 16 * J + l15;
#pragma unroll
                    for (int ks = 0; ks < 2; ++ks) {
                        const int d0 = ks * 32 + quad * 8;
                        const bf16x8 ak = hg_frag(kkd + srow * 72 + d0, bcd + srow * 68 + d0, ref ? ref + d0 : nullptr, false);
                        const bf16x8 bq = hg_frag(qq + irow * 72 + d0, bcd + irow * 68 + d0, ref ? ref + d0 : nullptr, true);
                        at[jj] = MFMA16(ak, bq, at[jj]);
                    }
                    if (J == I) {
#pragma unroll
                        for (int r = 0; r < 4; ++r) {
                            const int sl = quad * 4 + r;
                            const bool keep = dir == 0 ? (sl <= l15) : (sl >= l15);
                            if (!keep) at[jj][r] = 0.f;
                        }
                    }
                }
            }
            if (any) {
                u32x4 pbw; pbw.x = cvt_pk(at[0][0], at[0][1]); pbw.y = cvt_pk(at[0][2], at[0][3]); pbw.z = cvt_pk(at[1][0], at[1][1]); pbw.w = cvt_pk(at[1][2], at[1][3]);
                const bf16x8 pb = __builtin_bit_cast(bf16x8, pbw);
#pragma unroll
                for (int et = 0; et < 4; ++et) {
                    const bf16_t* vp = vT + (et * 16 + l15) * 72 + kk2 * 32 + quad * 4;
                    const u32x2 lo = *(const u32x2*)vp, hi = *(const u32x2*)(vp + 16);
                    u32x4 a; a.x = lo.x; a.y = lo.y; a.z = hi.x; a.w = hi.y;
                    o[et][ii] = MFMA16(__builtin_bit_cast(bf16x8, a), pb, o[et][ii]);
                }
            }
        }
    }
    __syncthreads();
    float* ob = (float*)smem;
    if (dir == 1) {
#pragma unroll
        for (int ii = 0; ii < 2; ++ii) {
            const int I = iset == 0 ? (ii == 0 ? 0 : 3) : (ii == 0 ? 1 : 2);
#pragma unroll
            for (int et = 0; et < 4; ++et) *(f32x4*)(ob + (16 * I + l15) * 68 + et * 16 + quad * 4) = o[et][ii];
        }
    }
    __syncthreads();
    if (dir == 0) {
#pragma unroll
        for (int ii = 0; ii < 2; ++ii) {
            const int I = iset == 0 ? (ii == 0 ? 0 : 3) : (ii == 0 ? 1 : 2);
            const int tok = tokbase + 16 * I + l15;
            float ss = 0.f;
#pragma unroll
            for (int et = 0; et < 4; ++et) {
                o[et][ii] += *(const f32x4*)(ob + (16 * I + l15) * 68 + et * 16 + quad * 4);
                ss += o[et][ii][0] * o[et][ii][0] + o[et][ii][1] * o[et][ii][1] + o[et][ii][2] * o[et][ii][2] + o[et][ii][3] * o[et][ii][3];
            }
            ss += __shfl_xor(ss, 16); ss += __shfl_xor(ss, 32);
            const float rh = __builtin_amdgcn_rsqf(ss * (1.f / 64.f) + EPS);
            float ssy = 0.f;
#pragma unroll
            for (int et = 0; et < 4; ++et) {
                const int e = et * 16 + quad * 4;
                const u32x2 gg = *(const u32x2*)(U + (size_t)tok * UC + 1536 + h * 64 + e);
                const float4 og = *(const float4*)(p.in[I_HONG] + l * 256 + h * 64 + e);
                const float g0 = bflo(gg.x), g1 = bfhi(gg.x), g2 = bflo(gg.y), g3 = bfhi(gg.y);
                const float y0 = o[et][ii][0] * rh * og.x * g0 * sigmoidf_(g0), y1 = o[et][ii][1] * rh * og.y * g1 * sigmoidf_(g1);
                const float y2 = o[et][ii][2] * rh * og.z * g2 * sigmoidf_(g2), y3 = o[et][ii][3] * rh * og.w * g3 * sigmoidf_(g3);
                ssy += y0 * y0 + y1 * y1 + y2 * y2 + y3 * y3;
                u32x2 ov; ov.x = cvt_pk(y0, y1); ov.y = cvt_pk(y2, y3);
                *(u32x2*)(CAT + (size_t)tok * DM + h * 64 + e) = ov;
            }
            ssy += __shfl_xor(ssy, 16); ssy += __shfl_xor(ssy, 32);
            if (quad == 0) SSQB[(size_t)tok * 4 + h] = ssy;
        }
    }
    __syncthreads();
}

DI void mla_finish_tile(const Params& p, int l, int item, unsigned char* smem) {
    const bf16_t* U = (const bf16_t*)(p.ws + OFF_U);
    const bf16_t* QR = (const bf16_t*)(p.ws + OFF_QRAW);
    const bf16_t* KVR = (const bf16_t*)(p.ws + OFF_KVRAW);
    bf16_t* MQ = (bf16_t*)(p.ws + OFF_MQ);
    bf16_t* MK = (bf16_t*)(p.ws + OFF_MK);
    bf16_t* MVT = (bf16_t*)(p.ws + OFF_MVT);
    const float* CS = (const float*)(p.ws + OFF_ROPE);
    const float* SN = CS + (size_t)T_TOK * 16;
    bf16_t* vbuf = (bf16_t*)smem;
    const int w = tidx() >> 6, lane = tidx() & 63, h = lane >> 4, j = lane & 15;
    const float4 qg = *(const float4*)(p.in[I_MQNG] + l * 96 + 4 * j), kg = *(const float4*)(p.in[I_MKNG] + l * 96 + 4 * j);
    const float qg1 = p.in[I_MQNG][l * 96 + 64 + j], qg2 = p.in[I_MQNG][l * 96 + 80 + j];
    const float kg1 = p.in[I_MKNG][l * 96 + 64 + j], kg2 = p.in[I_MKNG][l * 96 + 80 + j];
#pragma unroll 4
    for (int r = 0; r < 16; ++r) {
        const int tl = w * 16 + r, tok = item * 64 + tl;
        const bf16_t* up = U + (size_t)tok * UC;
        float sq, skv;
        { const u32x2 a = *(const u32x2*)(up + 2560 + lane * 4);
          const float a0 = bflo(a.x), a1 = bfhi(a.x), a2 = bflo(a.y), a3 = bfhi(a.y);
          sq = __builtin_amdgcn_rsqf(wave_sum(a0 * a0 + a1 * a1 + a2 * a2 + a3 * a3) * (1.f / 256.f) + EPS);
          const unsigned c = *(const unsigned*)(up + 2816 + lane * 2);
          const float c0 = bflo(c), c1 = bfhi(c);
          skv = __builtin_amdgcn_rsqf(wave_sum(c0 * c0 + c1 * c1) * (1.f / 128.f) + EPS); }
        const float cs = CS[(size_t)tok * 16 + j], sn = SN[(size_t)tok * 16 + j];
        {
            const bf16_t* qp = QR + (size_t)tok * 384 + h * 96;
            const u32x2 a = *(const u32x2*)(qp + 4 * j);
            float q0 = bflo(a.x) * sq, q1 = bfhi(a.x) * sq, q2 = bflo(a.y) * sq, q3 = bfhi(a.y) * sq;
            float x1 = bf2f(qp[64 + j]) * sq, x2 = bf2f(qp[80 + j]) * sq;
            float ss = q0 * q0 + q1 * q1 + q2 * q2 + q3 * q3 + x1 * x1 + x2 * x2;
            ss += __shfl_xor(ss, 1); ss += __shfl_xor(ss, 2); ss += __shfl_xor(ss, 4); ss += __shfl_xor(ss, 8);
            const float rn = __builtin_amdgcn_rsqf(ss * (1.f / 96.f) + EPS);
            q0 *= rn * qg.x; q1 *= rn * qg.y; q2 *= rn * qg.z; q3 *= rn * qg.w; x1 *= rn * qg1; x2 *= rn * qg2;
            bf16_t* op = MQ + (size_t)tok * 384 + h * 96;
            u32x2 ov; ov.x = cvt_pk(q0, q1); ov.y = cvt_pk(q2, q3);
            *(u32x2*)(op + 4 * j) = ov;
            op[64 + j] = f2bf(x1 * cs - x2 * sn); op[80 + j] = f2bf(x2 * cs + x1 * sn);
        }
        {
            const bf16_t* kp = KVR + (size_t)tok * 512 + h * 128;
            const u32x2 a = *(const u32x2*)(kp + 4 * j);
            float k0 = bflo(a.x) * skv, k1 = bfhi(a.x) * skv, k2 = bflo(a.y) * skv, k3 = bfhi(a.y) * skv;
            float x1 = bf2f(up[2944 + j]), x2 = bf2f(up[2960 + j]);
            float ss = k0 * k0 + k1 * k1 + k2 * k2 + k3 * k3 + x1 * x1 + x2 * x2;
            ss += __shfl_xor(ss, 1); ss += __shfl_xor(ss, 2); ss += __shfl_xor(ss, 4); ss += __shfl_xor(ss, 8);
            const float rn = __builtin_amdgcn_rsqf(ss * (1.f / 96.f) + EPS);
            k0 *= rn * kg.x; k1 *= rn * kg.y; k2 *= rn * kg.z; k3 *= rn * kg.w; x1 *= rn * kg1; x2 *= rn * kg2;
            bf16_t* op = MK + (size_t)tok * 384 + h * 96;
            u32x2 ov; ov.x = cvt_pk(k0, k1); ov.y = cvt_pk(k2, k3);
            *(u32x2*)(op + 4 * j) = ov;
            op[64 + j] = f2bf(x1 * cs - x2 * sn); op[80 + j] = f2bf(x2 * cs + x1 * sn);
            const u32x2 vv = *(const u32x2*)(kp + 64 + 4 * j);
            u32x2 vo; vo.x = cvt_pk(bflo(vv.x) * skv, bfhi(vv.x) * skv); vo.y = cvt_pk(bflo(vv.y) * skv, bfhi(vv.y) * skv);
            *(u32x2*)(vbuf + tl * 256 + h * 64 + 4 * j) = vo;
        }
    }
    __syncthreads();
    {
        const int tid = tidx(), b = (item * 64) / SEQ, s0 = (item * 64) % SEQ, hh = tid >> 6, e = tid & 63;
        bf16_t* dst = MVT + ((size_t)(b * 4 + hh) * 64 + e) * SEQ + s0;
#pragma unroll
        for (int c8 = 0; c8 < 8; ++c8) {
            unsigned wds[4];
#pragma unroll
            for (int k = 0; k < 4; ++k) wds[k] = (unsigned)vbuf[(c8 * 8 + 2 * k) * 256 + tid] | ((unsigned)vbuf[(c8 * 8 + 2 * k + 1) * 256 + tid] << 16);
            uint4 o; o.x = wds[0]; o.y = wds[1]; o.z = wds[2]; o.w = wds[3];
            *(uint4*)(dst + c8 * 8) = o;
        }
    }
    __syncthreads();
}

DI void memkv_finish_tile(const Params& p, int item, unsigned char* smem) {
    const bf16_t* KVM = (const bf16_t*)(p.ws + OFF_KVMEM);
    bf16_t* XK = (bf16_t*)(p.ws + OFF_XK);
    bf16_t* XVT = (bf16_t*)(p.ws + OFF_XVT);
    bf16_t* vbuf = (bf16_t*)smem;
    const int l = item >> 5, b = (item >> 2) & 7, h = item & 3;
    const int w = tidx() >> 6, lane = tidx() & 63;
    const float kg = p.in[I_XKNG][l * 64 + lane];
    for (int r = 0; r < 64; ++r) {
        const int m = w * 64 + r;
        const bf16_t* src = KVM + ((size_t)l * 2048 + b * 256 + m) * 512 + h * 128;
        const float k = bf2f(src[lane]);
        const float rn = __builtin_amdgcn_rsqf(wave_sum(k * k) * (1.f / 64.f) + EPS);
        XK[(((size_t)(l * 8 + b) * 4 + h) * 256 + m) * 64 + lane] = f2bf(k * rn * kg);
        vbuf[m * 64 + lane] = src[64 + lane];
    }
    __syncthreads();
    {
        const int tid = tidx(), e = tid & 63, mq = tid >> 6;
        bf16_t* dst = XVT + (((size_t)(l * 8 + b) * 4 + h) * 64 + e) * 256 + mq * 64;
#pragma unroll
        for (int c8 = 0; c8 < 8; ++c8) {
            unsigned wds[4];
#pragma unroll
            for (int k = 0; k < 4; ++k) wds[k] = (unsigned)vbuf[(mq * 64 + c8 * 8 + 2 * k) * 64 + e] | ((unsigned)vbuf[(mq * 64 + c8 * 8 + 2 * k + 1) * 64 + e] << 16);
            uint4 o; o.x = wds[0]; o.y = wds[1]; o.z = wds[2]; o.w = wds[3];
            *(uint4*)(dst + c8 * 8) = o;
        }
    }
    __syncthreads();
}

template <int DQK, bool QNORM>
DI void attn_tile(const bf16_t* __restrict__ Q, int qs, const bf16_t* __restrict__ Kp, int kstr, const bf16_t* __restrict__ Vt, int vstr, int nkeys,
                  float c2, float mbound, const float* __restrict__ qgain, bf16_t* __restrict__ O, int os, float* __restrict__ ssq, int ssq_stride, unsigned char* smem) {
    constexpr int NKS = DQK / 32, KP = DQK * 2 + 16, KCH = DQK / 8, KB = 64 * KP, VB = 64 * 144, STG = KB + VB, NKL = (64 * KCH) / 256;
    const int tid = tidx(), w = tid >> 6, lane = tid & 63, l15 = lane & 15, quad = lane >> 4;
    bf16x8 bq[2][NKS];
#pragma unroll
    for (int qt = 0; qt < 2; ++qt) {
        const bf16_t* qp = Q + (size_t)(w * 32 + qt * 16 + l15) * qs + quad * 8;
        if (QNORM) {
            float v[NKS][8]; float ss = 0.f;
#pragma unroll
            for (int ks = 0; ks < NKS; ++ks) {
                const uint4 x = *(const uint4*)(qp + ks * 32);
                v[ks][0] = bflo(x.x); v[ks][1] = bfhi(x.x); v[ks][2] = bflo(x.y); v[ks][3] = bfhi(x.y); v[ks][4] = bflo(x.z); v[ks][5] = bfhi(x.z); v[ks][6] = bflo(x.w); v[ks][7] = bfhi(x.w);
#pragma unroll
                for (int j = 0; j < 8; ++j) ss += v[ks][j] * v[ks][j];
            }
            ss += __shfl_xor(ss, 16); ss += __shfl_xor(ss, 32);
            const float rn = __builtin_amdgcn_rsqf(ss * (1.f / DQK) + EPS);
#pragma unroll
            for (int ks = 0; ks < NKS; ++ks) {
                const float* gp = qgain + ks * 32 + quad * 8;
                u32x4 o;
                o.x = cvt_pk(v[ks][0] * rn * gp[0], v[ks][1] * rn * gp[1]); o.y = cvt_pk(v[ks][2] * rn * gp[2], v[ks][3] * rn * gp[3]);
                o.z = cvt_pk(v[ks][4] * rn * gp[4], v[ks][5] * rn * gp[5]); o.w = cvt_pk(v[ks][6] * rn * gp[6], v[ks][7] * rn * gp[7]);
                bq[qt][ks] = __builtin_bit_cast(bf16x8, o);
            }
        } else {
#pragma unroll
            for (int ks = 0; ks < NKS; ++ks) bq[qt][ks] = *(const bf16x8*)(qp + ks * 32);
        }
    }
    f32x4 o[4][2];
    float lrun[2];
#pragma unroll
    for (int qt = 0; qt < 2; ++qt) {
        lrun[qt] = 0.f;
#pragma unroll
        for (int et = 0; et < 4; ++et) o[et][qt] = (f32x4){0.f, 0.f, 0.f, 0.f};
    }
    uint4 ak0, ak1, ak2, av0, av1, bk0, bk1, bk2, bv0, bv1;
    ak2 = make_uint4(0u, 0u, 0u, 0u); bk2 = ak2;
    const int kr0 = tid / KCH, kc0 = tid % KCH, kr1 = (tid + 256) / KCH, kc1 = (tid + 256) % KCH, kr2 = (tid + 512) / KCH, kc2 = (tid + 512) % KCH;
    const int vr0 = tid >> 3, vc0 = tid & 7, vr1 = vr0 + 32;
#define A_LOAD(S, key0) do { S##k0 = *(const uint4*)(Kp + (size_t)((key0) + kr0) * kstr + kc0 * 8); S##k1 = *(const uint4*)(Kp + (size_t)((key0) + kr1) * kstr + kc1 * 8); \
                          if (NKL > 2) S##k2 = *(const uint4*)(Kp + (size_t)((key0) + kr2) * kstr + kc2 * 8); \
                          S##v0 = *(const uint4*)(Vt + (size_t)vr0 * vstr + (key0) + vc0 * 8); S##v1 = *(const uint4*)(Vt + (size_t)vr1 * vstr + (key0) + vc0 * 8); } while (0)
#define A_STORE(S, buf) do { unsigned char* kb_ = smem + (buf) * STG; unsigned char* vb_ = kb_ + KB; \
                          *(uint4*)(kb_ + kr0 * KP + kc0 * 16) = S##k0; *(uint4*)(kb_ + kr1 * KP + kc1 * 16) = S##k1; if (NKL > 2) *(uint4*)(kb_ + kr2 * KP + kc2 * 16) = S##k2; \
                          *(uint4*)(vb_ + vr0 * 144 + vc0 * 16) = S##v0; *(uint4*)(vb_ + vr1 * 144 + vc0 * 16) = S##v1; } while (0)
    const int nkb = nkeys >> 6;
    A_LOAD(a, 0); A_STORE(a, 0);
    A_LOAD(b, 64);
    if (2 < nkb) A_LOAD(a, 128);
    __syncthreads();
#define A_COMPUTE(cur) do { \
        const unsigned char* kb = smem + cur * STG; const unsigned char* vb = kb + KB; \
        f32x4 s[4][2]; \
_Pragma("unroll")         for (int kt = 0; kt < 4; ++kt) { s[kt][0] = (f32x4){0.f, 0.f, 0.f, 0.f}; s[kt][1] = (f32x4){0.f, 0.f, 0.f, 0.f}; } \
_Pragma("unroll")         for (int ks = 0; ks < NKS; ++ks) { \
            bf16x8 ak[4]; \
_Pragma("unroll")             for (int kt = 0; kt < 4; ++kt) ak[kt] = *(const bf16x8*)(kb + (kt * 16 + l15) * KP + ks * 64 + quad * 16); \
_Pragma("unroll")             for (int kt = 0; kt < 4; ++kt) { s[kt][0] = MFMA16(ak[kt], bq[0][ks], s[kt][0]); s[kt][1] = MFMA16(ak[kt], bq[1][ks], s[kt][1]); } \
        } \
        bf16x8 pb[2][2]; \
_Pragma("unroll")         for (int qt = 0; qt < 2; ++qt) { \
            float ls = 0.f; \
            float pv[4][4]; \
_Pragma("unroll")             for (int kt = 0; kt < 4; ++kt) \
_Pragma("unroll")                 for (int r = 0; r < 4; ++r) { pv[kt][r] = __builtin_amdgcn_exp2f(s[kt][qt][r] * c2 - mbound); ls += pv[kt][r]; } \
            lrun[qt] += ls; \
_Pragma("unroll")             for (int k2 = 0; k2 < 2; ++k2) { \
                u32x4 pw; pw.x = cvt_pk(pv[2 * k2][0], pv[2 * k2][1]); pw.y = cvt_pk(pv[2 * k2][2], pv[2 * k2][3]); \
                pw.z = cvt_pk(pv[2 * k2 + 1][0], pv[2 * k2 + 1][1]); pw.w = cvt_pk(pv[2 * k2 + 1][2], pv[2 * k2 + 1][3]); \
                pb[qt][k2] = __builtin_bit_cast(bf16x8, pw); \
            } \
        } \
_Pragma("unroll")         for (int k2 = 0; k2 < 2; ++k2) \
_Pragma("unroll")             for (int et = 0; et < 4; ++et) { \
                const unsigned char* vp = vb + (et * 16 + l15) * 144 + k2 * 64 + quad * 8; \
                const u32x2 lo = *(const u32x2*)vp, hi = *(const u32x2*)(vp + 32); \
                u32x4 a; a.x = lo.x; a.y = lo.y; a.z = hi.x; a.w = hi.y; \
                const bf16x8 av = __builtin_bit_cast(bf16x8, a); \
                o[et][0] = MFMA16(av, pb[0][k2], o[et][0]); \
                o[et][1] = MFMA16(av, pb[1][k2], o[et][1]); \
            } \
    } while (0)
#pragma unroll 1
    for (int jb = 0; jb < nkb; jb += 2) {
        A_STORE(b, 1);
        if (jb + 3 < nkb) A_LOAD(b, (jb + 3) * 64);
        __builtin_amdgcn_sched_barrier(0);
        A_COMPUTE(0);
        __syncthreads();
        if (jb + 2 < nkb) A_STORE(a, 0);
        if (jb + 4 < nkb) A_LOAD(a, (jb + 4) * 64);
        __builtin_amdgcn_sched_barrier(0);
        A_COMPUTE(1);
        __syncthreads();
    }
#undef A_COMPUTE
#undef A_LOAD
#undef A_STORE
#pragma unroll
    for (int qt = 0; qt < 2; ++qt) {
        float lt = lrun[qt]; lt += __shfl_xor(lt, 16); lt += __shfl_xor(lt, 32);
        const float inv = 1.f / lt;
        const int q = w * 32 + qt * 16 + l15;
        float ss = 0.f;
#pragma unroll
        for (int et = 0; et < 4; ++et) {
            const float y0 = o[et][qt][0] * inv, y1 = o[et][qt][1] * inv, y2 = o[et][qt][2] * inv, y3 = o[et][qt][3] * inv;
            ss += y0 * y0 + y1 * y1 + y2 * y2 + y3 * y3;
            u32x2 ov; ov.x = cvt_pk(y0, y1); ov.y = cvt_pk(y2, y3);
            *(u32x2*)(O + (size_t)q * os + et * 16 + quad * 4) = ov;
        }
        if (ssq) { ss += __shfl_xor(ss, 16); ss += __shfl_xor(ss, 32); if (quad == 0) ssq[(size_t)q * ssq_stride] = ss; }
    }
}

namespace pg8 {
#define PG8_LAS __attribute__((address_space(3)))
constexpr int BM = 256, BK = 64, HALF = 128, HTB = HALF * BK * 2, STAGE_BYTES = 8 * HTB, NXCD = 8, WGM = 8;
DI int lds_byte(int r, int c) { const int st = (r >> 4) * 2 + (c >> 5), rr = r & 15, cc = c & 31, ob = rr * 64 + cc * 2; return st * 1024 + (ob ^ (((ob >> 9) & 1) << 5)); }
DI void stage_rc(int b, int& R, int& C) { const int st = b / 1024, sb = b % 1024, swz = sb ^ (((sb >> 9) & 1) << 5); R = (st >> 1) * 16 + swz / 64; C = (st & 1) * 32 + (swz % 64) / 2; }
struct Unit { int pm, pn; };
struct Gemm { const bf16_t* A; const bf16_t* Bt; int M, N, K; };
struct StaticOrder {
    int nM, nN, nwg, G, c;
    DI void init(int M, int N, int G_, int c_) { nM = M / BM; nN = N / BM; nwg = nM * nN; G = G_; c = c_; }
    DI bool next(int i, Unit& u) const {
        const long L = (long)i * G + c; if (L >= nwg) return false;
        int wgid = (int)L; { const int q = nwg / NXCD, r = nwg % NXCD, xcd = wgid % NXCD, off = wgid / NXCD; wgid = (xcd < r ? xcd * (q + 1) : r * (q + 1) + (xcd - r) * q) + off; }
        const int nig = WGM * nN, gid = wgid / nig, fm = gid * WGM, gsz = (nM - fm) < WGM ? (nM - fm) : WGM;
        u.pm = fm + ((wgid % nig) % gsz); u.pn = (wgid % nig) / gsz; return true;
    }
};
DI float row_rstd(const float* part, int row) {
    const float4* p4 = (const float4*)(part + (size_t)row * 16);
    const float4 a = p4[0], b = p4[1], c = p4[2], d = p4[3];
    const float s = (a.x + a.y + a.z + a.w) + (b.x + b.y + b.z + b.w) + (c.x + c.y + c.z + c.w) + (d.x + d.y + d.z + d.w);
    return __builtin_amdgcn_rsqf(s * (1.f / DM) + EPS);
}
struct EpiScaled {
    bf16_t* O; int ldo; const float* part;
    DI void operator()(const f32x4 (&acc)[2][2][4][2], const Unit& u, int wr, int wc, int fr, int fq) const {
#pragma unroll
        for (int ai = 0; ai < 2; ++ai)
#pragma unroll
            for (int m = 0; m < 4; ++m) {
                const int row = u.pm * BM + ai * HALF + wr * 64 + m * 16 + fr;
                const float sc = row_rstd(part, row);
                bf16_t* rowp = O + (size_t)row * ldo + u.pn * BM + wc * 32 + fq * 4;
#pragma unroll
                for (int bj = 0; bj < 2; ++bj)
#pragma unroll
                    for (int n = 0; n < 2; ++n) {
                        u32x2 v; v.x = cvt_pk(acc[ai][bj][m][n][0] * sc, acc[ai][bj][m][n][1] * sc); v.y = cvt_pk(acc[ai][bj][m][n][2] * sc, acc[ai][bj][m][n][3] * sc);
                        *(u32x2*)(rowp + bj * HALF + n * 16) = v;
                    }
            }
    }
};
struct EpiSwiglu {
    bf16_t* H; const float* part;
    DI void operator()(const f32x4 (&acc)[2][2][4][2], const Unit& u, int wr, int wc, int fr, int fq) const {
#pragma unroll
        for (int ai = 0; ai < 2; ++ai)
#pragma unroll
            for (int m = 0; m < 4; ++m) {
                const int row = u.pm * BM + ai * HALF + wr * 64 + m * 16 + fr;
                const float sc = row_rstd(part, row);
                bf16_t* rowp = H + (size_t)row * DFF + ((u.pn * BM + wc * 32) >> 1) + fq * 4;
#pragma unroll
                for (int bj = 0; bj < 2; ++bj) {
                    float h[4];
#pragma unroll
                    for (int j = 0; j < 4; ++j) { const float a1 = acc[ai][bj][m][0][j] * sc, a3 = acc[ai][bj][m][1][j] * sc; h[j] = a1 * sigmoidf_(a1) * a3; }
                    u32x2 v; v.x = cvt_pk(h[0], h[1]); v.y = cvt_pk(h[2], h[3]);
                    *(u32x2*)(rowp + bj * (HALF / 2)) = v;
                }
            }
    }
};
struct EpiResid {
    float* X; bf16_t* XB; float* rowsq;
    DI void operator()(const f32x4 (&acc)[2][2][4][2], const Unit& u, int wr, int wc, int fr, int fq) const {
#pragma unroll
        for (int ai = 0; ai < 2; ++ai)
#pragma unroll
            for (int m = 0; m < 4; ++m) {
                const int row = u.pm * BM + ai * HALF + wr * 64 + m * 16 + fr;
                float ss = 0.f;
#pragma unroll
                for (int bj = 0; bj < 2; ++bj)
#pragma unroll
                    for (int n = 0; n < 2; ++n) {
                        const int col = u.pn * BM + bj * HALF + wc * 32 + n * 16 + fq * 4;
                        float4* xp = (float4*)(X + (size_t)row * DM + col);
                        float4 xv = *xp;
                        xv.x += acc[ai][bj][m][n][0]; xv.y += acc[ai][bj][m][n][1]; xv.z += acc[ai][bj][m][n][2]; xv.w += acc[ai][bj][m][n][3];
                        *xp = xv;
                        u32x2 v; v.x = cvt_pk(xv.x, xv.y); v.y = cvt_pk(xv.z, xv.w);
                        *(u32x2*)(XB + (size_t)row * DM + col) = v;
                        ss += xv.x * xv.x + xv.y * xv.y + xv.z * xv.z + xv.w * xv.w;
                    }
                ss += __shfl_xor(ss, 16); ss += __shfl_xor(ss, 32);
                if (fq == 0) rowsq[(size_t)row * 16 + u.pn * 4 + wc] = ss;
            }
    }
};

template <class Epi, bool SCALED = false>
DI void gemm_phase(PG8_LAS unsigned char* lds, const Gemm g, const StaticOrder& S, const Epi& E, const float* ssq0 = nullptr, const float* ssq1 = nullptr) {
    int tid = threadIdx.x; asm volatile("" : "+v"(tid));
    const int wid = __builtin_amdgcn_readfirstlane(tid >> 6), lane = tid & 63, wr = wid >> 2, wc = wid & 3, fr = lane & 15, fq = lane >> 4;
    const int K = g.K, nt = K / BK;
    unsigned voffA[2];
#pragma unroll
    for (int i = 0; i < 2; ++i) { int R, C; stage_rc(tid * 16 + i * 8192, R, C); voffA[i] = (unsigned)(R * K + C) * 2u; }
    const size_t kstep = (size_t)(BK * 2);
    const size_t hstep = (size_t)HALF * K * 2;
    const size_t tstep = 2 * hstep;
    const unsigned ldsw = (unsigned)wid * 1024u;
    const int aoff = lds_byte(wr * 64 + fr, fq * 8), boff = lds_byte(wc * 32 + fr, fq * 8);
#define PG8_SA(b, h) (((b) * 2 + (h)) * HTB)
#define PG8_SB(b, h) ((4 + (b) * 2 + (h)) * HTB)
#define PG8_STAGE(bufoff, gbase) do { _Pragma("unroll") for (int _i = 0; _i < 2; ++_i) \
        __builtin_amdgcn_global_load_lds((const unsigned*)((const char*)(gbase) + voffA[_i]), (PG8_LAS unsigned*)(lds + (bufoff) + ldsw + _i * 8192), 16, 0, 0); } while (0)
#define PG8_LDA(dst, b, h) do { _Pragma("unroll") for (int m = 0; m < 4; ++m) _Pragma("unroll") for (int k = 0; k < 2; ++k) dst[m][k] = *(const PG8_LAS bf16x8*)(lds + PG8_SA(b, h) + aoff + m * 2048 + k * 1024); } while (0)
#define PG8_LDB(dst, b, h) do { _Pragma("unroll") for (int n = 0; n < 2; ++n) _Pragma("unroll") for (int k = 0; k < 2; ++k) dst[n][k] = *(const PG8_LAS bf16x8*)(lds + PG8_SB(b, h) + boff + n * 2048 + k * 1024); } while (0)
#define PG8_MMA(ai, bj, At, Bt) do { __builtin_amdgcn_s_setprio(1); _Pragma("unroll") for (int m = 0; m < 4; ++m) _Pragma("unroll") for (int n = 0; n < 2; ++n) _Pragma("unroll") for (int k = 0; k < 2; ++k) \
        acc[ai][bj][m][n] = __builtin_amdgcn_mfma_f32_16x16x32_bf16(Bt[n][k], At[m][k], acc[ai][bj][m][n], 0, 0, 0); __builtin_amdgcn_s_setprio(0); } while (0)
#define PG8_WAIT_V(n) asm volatile("s_waitcnt vmcnt(" #n ")" ::: "memory")
#define PG8_WAIT_L(n) asm volatile("s_waitcnt lgkmcnt(" #n ")" ::: "memory")
#define PG8_BAR __builtin_amdgcn_s_barrier()
#define PG8_SCHED __builtin_amdgcn_sched_barrier(0)
    Unit cur, nxt; int ui = 0;
    if (!S.next(0, cur)) return;
    f32x4 acc[2][2][4][2];
#pragma unroll
    for (int a = 0; a < 2; ++a)
#pragma unroll
        for (int b = 0; b < 2; ++b)
#pragma unroll
            for (int m = 0; m < 4; ++m)
#pragma unroll
                for (int n = 0; n < 2; ++n) acc[a][b][m][n] = (f32x4){0.f, 0.f, 0.f, 0.f};
    bf16x8 At[4][2], B0[2][2], B1[2][2];
    const char* cA = (const char*)g.A + (size_t)cur.pm * tstep; const char* cB = (const char*)g.Bt + (size_t)cur.pn * tstep;
#define PG8_FTAB(unit) do { if (SCALED && tid < 256) { const int row_ = (unit).pm * BM + tid; \
        const float4 sb_ = *(const float4*)(ssq0 + (size_t)row_ * 4), sd_ = *(const float4*)(ssq1 + (size_t)row_ * 4); \
        const float rB_ = __builtin_amdgcn_rsqf((sb_.x + sb_.y + sb_.z + sb_.w) * (1.f / 256.f) + EPS), rD_ = __builtin_amdgcn_rsqf((sd_.x + sd_.y + sd_.z + sd_.w) * (1.f / 256.f) + EPS); \
        PG8_LAS float* ft_ = (PG8_LAS float*)(lds + STAGE_BYTES); ft_[tid] = rB_ / rD_; ft_[256 + tid] = rD_; } } while (0)
    PG8_FTAB(cur);
    PG8_STAGE(PG8_SB(0, 0), cB); PG8_STAGE(PG8_SB(0, 1), cB + hstep); PG8_STAGE(PG8_SA(0, 0), cA); PG8_STAGE(PG8_SA(0, 1), cA + hstep);
    if (wr == 1) PG8_BAR;
    PG8_WAIT_V(2); PG8_BAR;
    PG8_STAGE(PG8_SB(1, 0), cB + kstep); PG8_STAGE(PG8_SA(1, 0), cA + kstep); PG8_STAGE(PG8_SB(1, 1), cB + hstep + kstep);
    PG8_WAIT_V(6); PG8_BAR;
    for (;;) {
        const bool has_next = S.next(ui + 1, nxt);
        const char* nA = has_next ? (const char*)g.A + (size_t)nxt.pm * tstep : cA; const char* nB = has_next ? (const char*)g.Bt + (size_t)nxt.pn * tstep : cB;
        for (int t = 0; t < nt; t += 2) {
            const bool last = (t == nt - 2);
            const char* a1 = cA + (size_t)(t + 1) * kstep;
            const char* a2 = last ? nA : cA + (size_t)(t + 2) * kstep; const char* b2 = last ? nB : cB + (size_t)(t + 2) * kstep;
            const char* a3 = a2 + kstep; const char* b3 = b2 + kstep;
            if (SCALED && (t == 4 || t == 8)) {
                const PG8_LAS float* ft = (const PG8_LAS float*)(lds + STAGE_BYTES) + (t == 8 ? 256 : 0);
#pragma unroll
                for (int ai = 0; ai < 2; ++ai)
#pragma unroll
                    for (int m = 0; m < 4; ++m) {
                        const float f = ft[ai * HALF + wr * 64 + m * 16 + fr];
#pragma unroll
                        for (int bj = 0; bj < 2; ++bj)
#pragma unroll
                            for (int n = 0; n < 2; ++n) acc[ai][bj][m][n] *= f;
                    }
            }
            PG8_LDB(B0, 0, 0); PG8_LDB(B1, 0, 1); PG8_SCHED; PG8_LDA(At, 0, 0); PG8_STAGE(PG8_SA(1, 1), a1 + hstep);
            PG8_WAIT_V(8); PG8_WAIT_L(0); PG8_BAR; PG8_MMA(0, 0, At, B0); PG8_MMA(0, 1, At, B1); PG8_BAR; PG8_SCHED;
            PG8_LDA(At, 0, 1); PG8_STAGE(PG8_SB(0, 0), b2); PG8_STAGE(PG8_SB(0, 1), b2 + hstep); PG8_STAGE(PG8_SA(0, 0), a2);
            PG8_WAIT_V(8); PG8_WAIT_L(0); PG8_BAR; PG8_MMA(1, 0, At, B0); PG8_MMA(1, 1, At, B1); PG8_BAR; PG8_SCHED;
            PG8_LDB(B0, 1, 0); PG8_LDB(B1, 1, 1); PG8_SCHED; PG8_LDA(At, 1, 0); PG8_STAGE(PG8_SA(0, 1), a2 + hstep);
            PG8_WAIT_V(8); PG8_WAIT_L(0); PG8_BAR; PG8_MMA(0, 0, At, B0); PG8_MMA(0, 1, At, B1); PG8_BAR; PG8_SCHED;
            PG8_LDA(At, 1, 1); PG8_STAGE(PG8_SB(1, 0), b3); PG8_STAGE(PG8_SB(1, 1), b3 + hstep); PG8_STAGE(PG8_SA(1, 0), a3);
            PG8_WAIT_V(8); PG8_WAIT_L(0); PG8_BAR; PG8_MMA(1, 0, At, B0); PG8_MMA(1, 1, At, B1); PG8_BAR; PG8_SCHED;
        }
        if (wr == 0) PG8_BAR;
        E(acc, cur, wr, wc, fr, fq);
        if (!has_next) break;
#pragma unroll
        for (int a = 0; a < 2; ++a)
#pragma unroll
            for (int b = 0; b < 2; ++b)
#pragma unroll
                for (int m = 0; m < 4; ++m)
#pragma unroll
                    for (int n = 0; n < 2; ++n) acc[a][b][m][n] = (f32x4){0.f, 0.f, 0.f, 0.f};
        cur = nxt; cA = nA; cB = nB; ++ui;
        if (wr == 1) PG8_BAR;
        PG8_FTAB(cur);
    }
    PG8_WAIT_V(0);
    PG8_BAR;
#undef PG8_FTAB
#undef PG8_SA
#undef PG8_SB
#undef PG8_STAGE
#undef PG8_LDA
#undef PG8_LDB
#undef PG8_MMA
#undef PG8_WAIT_V
#undef PG8_WAIT_L
#undef PG8_BAR
#undef PG8_SCHED
}
}

enum { PH_PRO = 0, PH_CONV, PH_P1, PH_P2, PH_P3, PH_P4, PH_P5, PH_P6, PH_P7, PH_P8, PH_P9, PH_P10, PH_COUNT };

DI void gemm_item_bf16(const bf16_t* A, int lda, const bf16_t* Bt, int K, int nM, int nN, int L, bf16_t* O, int ldo, const float* part, int npart, float inv_n, unsigned char* smem) {
    int pm, pn; tile_order(L, nM, nN, pm, pn);
    if (part) fill_rs(smem, part, npart, pm * 128, inv_n);
    f32x4 acc[4][4];
    gemm_mainloop<false>(A, lda, Bt, K, pm * 128, pn * 128, smem, acc);
    epi_bf16(acc, O, ldo, pm * 128, pn * 128, part ? (const float*)(smem + 65536) : nullptr);
    __syncthreads();
}
template <bool ASC>
DI void gemm_item_resid(const Params& p, const bf16_t* A, int lda, const bf16_t* Bt, int K, int L, unsigned char* smem) {
    int pm, pn; tile_order(L, 256, 8, pm, pn);
    if (ASC) {
        float* asc = (float*)(smem + 66048);
        const float* sb = (const float*)(p.ws + OFF_SSQB); const float* sd = (const float*)(p.ws + OFF_SSQD);
        const int tid = tidx();
        if (tid < 128) {
            const float4 a = *(const float4*)(sb + (size_t)(pm * 128 + tid) * 4), d = *(const float4*)(sd + (size_t)(pm * 128 + tid) * 4);
            asc[tid * 2] = __builtin_amdgcn_rsqf((a.x + a.y + a.z + a.w) * (1.f / 256.f) + EPS);
            asc[tid * 2 + 1] = __builtin_amdgcn_rsqf((d.x + d.y + d.z + d.w) * (1.f / 256.f) + EPS);
        }
    }
    f32x4 acc[4][4];
    gemm_mainloop<ASC>(A, lda, Bt, K, pm * 128, pn * 128, smem, acc);
    epi_resid(acc, p.out, (bf16_t*)(p.ws + OFF_XB), (float*)(p.ws + OFF_ROWSQ), pm * 128, pn * 128);
    __syncthreads();
}

DI void run_phase(const Params& p, int ph, int l, unsigned char* smem0) {
    const int vb = __builtin_amdgcn_readfirstlane((int)(threadIdx.x >> 8));
    unsigned char* smem = smem0 + vb * LDS_BYTES;
    const int G = gridDim.x * 2, bid = blockIdx.x * 2 + vb;
    const bf16_t* W = (const bf16_t*)(p.ws + OFF_W);
    const bf16_t* XB = (const bf16_t*)(p.ws + OFF_XB);
    bf16_t* U = (bf16_t*)(p.ws + OFF_U);
    const float* ROWSQ = (const float*)(p.ws + OFF_ROWSQ);
#ifdef ONLY_PH
    if (ph != ONLY_PH) return;
#endif
    switch (ph) {
    case PH_PRO: {
        for (int i = bid; i < 2048; i += G) pro_rows(p.in[I_X], p.out, (bf16_t*)(p.ws + OFF_XB), (float*)(p.ws + OFF_ROWSQ), 16, i);
        for (int i = bid; i < 128; i += G) pro_rows(p.in[I_MEM], nullptr, (bf16_t*)(p.ws + OFF_MEMB), (float*)(p.ws + OFF_MEMSQ), 1, i);
        for (int i = bid; i < 128; i += G) pro_rope(p, i);
        for (int i = bid; i < 512; i += G) { const int ll = i >> 7; conv_tile(p.in[I_XWKV] + (size_t)ll * DM * 512, DM, 512, 512, p.in[I_GMEM] + ll * DM, 0, (bf16_t*)(p.ws + OFF_XWKV) + (size_t)ll * 512 * DM, i & 127, smem); }
        for (int i = bid; i < CONV_TILES; i += G) conv_layer_item(p, 0, i, smem);
    } break;
    case PH_CONV: {
        for (int it = bid; it < CONV_TILES; it += G) conv_layer_item(p, l, it, smem);
    } break;
    case PH_P1: {
        { pg8::Gemm g{XB, W + W_IN, T_TOK, UC, DM}; pg8::StaticOrder S; S.init(T_TOK, UC, gridDim.x, blockIdx.x);
          pg8::EpiScaled E{U, UC, ROWSQ};
          pg8::gemm_phase<pg8::EpiScaled>((PG8_LAS unsigned char*)smem0, g, S, E); }
        if (l == 0) {
            for (int i = bid; i < 256; i += G) {
                const int ll = i >> 6;
                gemm_item_bf16((const bf16_t*)(p.ws + OFF_MEMB), DM, (const bf16_t*)(p.ws + OFF_XWKV) + (size_t)ll * 512 * DM, DM, 16, 4, i & 63,
                               (bf16_t*)(p.ws + OFF_KVMEM) + (size_t)ll * 2048 * 512, 512, (const float*)(p.ws + OFF_MEMSQ), 1, 1.f / DM, smem);
            }
        }
    } break;
    case PH_P2: {
        for (int i = bid; i < 1024; i += G) hgrn_local_tile(p, l, i, smem);
#ifdef RP2_HL
        for (int i = bid; i < 1024; i += G) hgrn_local_tile(p, l, i, smem);
#endif
        for (int i = bid; i < 1024; i += G) conformer_tile(p, l, i, smem);
#ifdef RP2_CF
        for (int i = bid; i < 1024; i += G) conformer_tile(p, l, i, smem);
#endif
#ifdef RP2_G
        for (int i = bid; i < 768; i += G) gemm_item_bf16(U + 2560, UC, W + W_UQ, 256, 256, 3, i, (bf16_t*)(p.ws + OFF_QRAW), 384, nullptr, 0, 0.f, smem);
        for (int i = bid; i < 1024; i += G) gemm_item_bf16(U + 2816, UC, W + W_UKV, 128, 256, 4, i, (bf16_t*)(p.ws + OFF_KVRAW), 512, nullptr, 0, 0.f, smem);
#endif
#ifdef RP2_SC
        for (int i = bid; i < 512; i += G) shortconv_tile(p, l, i);
#endif
        for (int i = bid; i < 768; i += G) gemm_item_bf16(U + 2560, UC, W + W_UQ, 256, 256, 3, i, (bf16_t*)(p.ws + OFF_QRAW), 384, nullptr, 0, 0.f, smem);
        for (int i = bid; i < 1024; i += G) gemm_item_bf16(U + 2816, UC, W + W_UKV, 128, 256, 4, i, (bf16_t*)(p.ws + OFF_KVRAW), 512, nullptr, 0, 0.f, smem);
        for (int i = bid; i < 512; i += G) shortconv_tile(p, l, i);
        if (l == 0) { for (int i = bid; i < 128; i += G) memkv_finish_tile(p, i, smem); }
    } break;
    case PH_P3: {
        for (int i = bid; i < 1024; i += G) hgrn_scan_item(p, i);
        for (int i = bid; i < 512; i += G) mla_finish_tile(p, l, i, smem);
#ifdef RP3_MF
        for (int i = bid; i < 512; i += G) mla_finish_tile(p, l, i, smem);
#endif
#ifdef RP3_SC
        for (int i = bid; i < 1024; i += G) hgrn_scan_dummy(p, i);
#endif
    } break;
    case PH_P4: {
        const float c2 = 0.10206207261596575f * 1.4426950408889634f;
        float mb;
        {
            const int ln = tidx() & 63;
            float gq = fmaxf(fabsf(p.in[I_MQNG][l * 96 + ln]), ln < 32 ? fabsf(p.in[I_MQNG][l * 96 + 64 + ln]) : 0.f);
            float gk = fmaxf(fabsf(p.in[I_MKNG][l * 96 + ln]), ln < 32 ? fabsf(p.in[I_MKNG][l * 96 + 64 + ln]) : 0.f);
#pragma unroll
            for (int o = 32; o > 0; o >>= 1) { gq = fmaxf(gq, __shfl_xor(gq, o)); gk = fmaxf(gk, __shfl_xor(gk, o)); }
            mb = 96.f * gq * gk * c2;
        }
        for (int it0 = bid; it0 < 1024; it0 += G) {
            const int xcd = blockIdx.x & 7, jx = ((blockIdx.x >> 3) << 1) + vb, loc = (it0 / G) * 64 + jx;
            const int it = (G == 512) ? (xcd * 128 + loc) : it0;
            const int bh = it >> 5, qt = it & 31, b = bh >> 2, h = bh & 3;
            const size_t tok0 = (size_t)b * SEQ + qt * 128;
            attn_tile<96, false>((const bf16_t*)(p.ws + OFF_MQ) + tok0 * 384 + h * 96, 384, (const bf16_t*)(p.ws + OFF_MK) + (size_t)b * SEQ * 384 + h * 96, 384,
                                 (const bf16_t*)(p.ws + OFF_MVT) + (size_t)bh * 64 * SEQ, SEQ, SEQ, c2, mb, nullptr,
                                 (bf16_t*)(p.ws + OFF_CAT) + tok0 * DM + 256 + h * 64, DM, (float*)(p.ws + OFF_SSQD) + tok0 * 4 + h, 4, smem);
        }
        for (int i = bid; i < 2048; i += G) hgrn_out_tile(p, l, i, smem);
#ifdef REPEAT_HGOUT
        for (int i = bid; i < 2048; i += G) hgrn_out_tile(p, l, i, smem);
#endif
    } break;
    case PH_P5: {
        pg8::Gemm g{(const bf16_t*)(p.ws + OFF_CAT), W + W_OUT, T_TOK, DM, DM}; pg8::StaticOrder S; S.init(T_TOK, DM, gridDim.x, blockIdx.x);
        pg8::EpiResid E{p.out, (bf16_t*)(p.ws + OFF_XB), (float*)(p.ws + OFF_ROWSQ)};
        pg8::gemm_phase<pg8::EpiResid, true>((PG8_LAS unsigned char*)smem0, g, S, E, (const float*)(p.ws + OFF_SSQB), (const float*)(p.ws + OFF_SSQD));
    } break;
    case PH_P6: {
        for (int it = bid; it < 512; it += G) gemm_item_bf16(XB, DM, W + W_XQ, DM, 256, 2, it, (bf16_t*)(p.ws + OFF_XQ), 256, ROWSQ, 16, 1.f / DM, smem);
    } break;
    case PH_P7: {
        const float c2 = 0.125f * 1.4426950408889634f;
        float mb;
        {
            const int ln = tidx() & 63;
            float gq = fabsf(p.in[I_XQNG][l * 64 + ln]), gk = fabsf(p.in[I_XKNG][l * 64 + ln]);
#pragma unroll
            for (int o = 32; o > 0; o >>= 1) { gq = fmaxf(gq, __shfl_xor(gq, o)); gk = fmaxf(gk, __shfl_xor(gk, o)); }
            mb = 64.f * gq * gk * c2;
        }
        for (int it0 = bid; it0 < 1024; it0 += G) {
            const int xcd = blockIdx.x & 7, jx = ((blockIdx.x >> 3) << 1) + vb, loc = (it0 / G) * 64 + jx;
            const int it = (G == 512) ? (xcd * 128 + loc) : it0;
            const int bh = it >> 5, qt = it & 31, b = bh >> 2, h = bh & 3;
            const size_t tok0 = (size_t)b * SEQ + qt * 128;
            attn_tile<64, true>((const bf16_t*)(p.ws + OFF_XQ) + tok0 * 256 + h * 64, 256, (const bf16_t*)(p.ws + OFF_XK) + ((size_t)(l * 8 + b) * 4 + h) * 256 * 64, 64,
                                (const bf16_t*)(p.ws + OFF_XVT) + ((size_t)(l * 8 + b) * 4 + h) * 64 * 256, 256, 256, c2, mb, p.in[I_XQNG] + l * 64,
                                (bf16_t*)(p.ws + OFF_XO) + tok0 * 256 + h * 64, 256, nullptr, 0, smem);
        }
    } break;
    case PH_P8: {
        pg8::Gemm g{(const bf16_t*)(p.ws + OFF_XO), W + W_XO, T_TOK, DM, 256}; pg8::StaticOrder S; S.init(T_TOK, DM, gridDim.x, blockIdx.x);
        pg8::EpiResid E{p.out, (bf16_t*)(p.ws + OFF_XB), (float*)(p.ws + OFF_ROWSQ)};
        pg8::gemm_phase<pg8::EpiResid>((PG8_LAS unsigned char*)smem0, g, S, E);
    } break;
    case PH_P9: {
        pg8::Gemm g{XB, W + W_13, T_TOK, 2 * DFF, DM}; pg8::StaticOrder S; S.init(T_TOK, 2 * DFF, gridDim.x, blockIdx.x);
        pg8::EpiSwiglu E{(bf16_t*)(p.ws + OFF_HFF), ROWSQ};
        pg8::gemm_phase<pg8::EpiSwiglu>((PG8_LAS unsigned char*)smem0, g, S, E);
    } break;
    case PH_P10: {
        pg8::Gemm g{(const bf16_t*)(p.ws + OFF_HFF), W + W_2, T_TOK, DM, DFF}; pg8::StaticOrder S; S.init(T_TOK, DM, gridDim.x, blockIdx.x);
        pg8::EpiResid E{p.out, (bf16_t*)(p.ws + OFF_XB), (float*)(p.ws + OFF_ROWSQ)};
        pg8::gemm_phase<pg8::EpiResid>((PG8_LAS unsigned char*)smem0, g, S, E);
    } break;
    }
}

#define XB_TMO      128
#define XB_XCNT(j)  (256  + 64 * (j))
#define XB_XSUB(j)  (1280 + 64 * (j))
#define XB_XGEN(j)  (2304 + 64 * (j))
#define XB_TOP      3328
#define XB_TOPGEN   3392
#define XCD_BAR_WORDS 3456
#define XB_SPIN_CAP (1u << 22)
#define LAS __attribute__((address_space(3)))
DI unsigned xb_ld(unsigned* p)              { return __hip_atomic_load(p, __ATOMIC_RELAXED, __HIP_MEMORY_SCOPE_AGENT); }
DI unsigned xb_add(unsigned* p, unsigned v) { return __hip_atomic_fetch_add(p, v, __ATOMIC_RELAXED, __HIP_MEMORY_SCOPE_AGENT); }
DI unsigned xb_xcc_id() { return (unsigned)__builtin_amdgcn_s_getreg((3 << 11) | 20) & 0xFu; }
#define XB_SPIN(cond, bar) do { unsigned _sp = 0; while (cond) { __builtin_amdgcn_s_sleep(1); \
    if ((++_sp & 255u) == 0u) { if (xb_ld(&(bar)[XB_TMO])) break; if (_sp > XB_SPIN_CAP) { atomicAdd(&(bar)[XB_TMO], 1u); break; } } } } while (0)
struct XcdBarrier { unsigned* bar; unsigned x; volatile LAS unsigned* st; };
DI XcdBarrier xcd_barrier_post(unsigned* bar, volatile LAS unsigned* st) {
    XcdBarrier b; b.bar = bar; b.x = xb_xcc_id(); b.st = st;
    if (threadIdx.x == 0) (void)xb_add(&bar[XB_XCNT(b.x)], 1u);
    return b;
}
DI void xcd_barrier_complete(unsigned* bar, unsigned x, unsigned& nloc, unsigned& nx) {
    const unsigned G = gridDim.x * gridDim.y * gridDim.z;
    unsigned sum, cnt, mine, sp = 0u;
    for (;;) {
        sum = 0u; cnt = 0u; mine = 0u;
#pragma unroll
        for (unsigned j = 0; j < 16; ++j) { const unsigned c = xb_ld(&bar[XB_XCNT(j)]); sum += c; cnt += (c > 0u) ? 1u : 0u; mine = (j == x) ? c : mine; }
        if (sum == G) break;
        __builtin_amdgcn_s_sleep(1);
        if ((++sp & 255u) == 0u) { if (xb_ld(&bar[XB_TMO])) break; if (sp > XB_SPIN_CAP) { atomicAdd(&bar[XB_TMO], 1u); break; } }
    }
    nloc = mine > 0u ? mine : 1u; nx = cnt > 0u ? cnt : 1u;
}
DI void xcd_barrier(const XcdBarrier& b) {
    asm volatile("s_waitcnt vmcnt(0)" ::: "memory");
    __syncthreads();
    if (threadIdx.x == 0) {
        unsigned* bar = b.bar;
        __builtin_amdgcn_s_waitcnt(0);
        unsigned nloc = b.st[0], nx = b.st[1];
        if (nloc == 0u) { xcd_barrier_complete(bar, b.x, nloc, nx); b.st[0] = nloc; b.st[1] = nx; }
        const unsigned old = xb_add(&bar[XB_XSUB(b.x)], 1u);
        const unsigned gen = old / nloc;
        if (old + 1u == (gen + 1u) * nloc) {
            __builtin_amdgcn_fence(__ATOMIC_RELEASE, "agent");
            asm volatile("s_waitcnt vmcnt(0)" ::: "memory");
            const unsigned og = xb_add(&bar[XB_TOP], 1u);
            const unsigned tg = og / nx;
            if (og + 1u == (tg + 1u) * nx) xb_add(&bar[XB_TOPGEN], 1u);
            else XB_SPIN(xb_ld(&bar[XB_TOPGEN]) == tg, bar);
            __builtin_amdgcn_fence(__ATOMIC_ACQUIRE, "agent");
            xb_add(&bar[XB_XGEN(b.x)], 1u);
            asm volatile("s_waitcnt vmcnt(0)" ::: "memory");
        } else {
            XB_SPIN(xb_ld(&bar[XB_XGEN(b.x)]) == gen, bar);
            __builtin_amdgcn_fence(__ATOMIC_ACQUIRE, "agent");
            asm volatile("s_waitcnt vmcnt(0)" ::: "memory");
        }
    }
    __syncthreads();
}

extern __shared__ __attribute__((aligned(16))) unsigned char dyn_smem[];

__global__ void __launch_bounds__(512, 2) mega_kernel(Params p) {
    cg::grid_group grid = cg::this_grid();
    volatile LAS unsigned* st = (volatile LAS unsigned*)(dyn_smem + 2 * LDS_BYTES);
    if (threadIdx.x == 0) { st[0] = 0u; st[1] = 0u; st[2] = 0u; st[3] = 0u; }
    __syncthreads();
    XcdBarrier xb = xcd_barrier_post((unsigned*)(p.ws + WS_BAR), st);
    const int nsteps = p.ph_hi;
    const bool single = (p.ph_hi - p.ph_lo) == 1;
    for (int step = p.ph_lo; step < nsteps; ++step) {
        int ph, l;
        if (step == 0) { ph = PH_PRO; l = 0; }
        else { l = (step - 1) / 11; ph = PH_CONV + (step - 1) % 11; }
        if (ph == PH_CONV && l == 0) continue;
        run_phase(p, ph, l, dyn_smem);
#ifdef REPEAT_PH
        if (ph == REPEAT_PH) { xcd_barrier(xb); run_phase(p, ph, l, dyn_smem); }
#endif
        if (single) break;
        if (step == 0) grid.sync();
        else if (step + 1 < nsteps) xcd_barrier(xb);
    }
}

extern "C" void kernel_launch(void* const* d_in, const int* in_sizes, int n_in, void* d_out, int out_size, void* d_ws, size_t ws_size, hipStream_t stream) {
    static int grid = 0;
    if (grid == 0) {
        if (n_in != N_IN || ws_size < WS_END + 256 || out_size != T_TOK * DM) { fprintf(stderr, "kernel_launch: unexpected sizes n_in %d ws %zu (need %zu) out %d\n", n_in, ws_size, (size_t)WS_END, out_size); grid = -1; return; }
        int dev = 0, cus = 0, per_cu = 0;
        (void)hipGetDevice(&dev);
        (void)hipDeviceGetAttribute(&cus, hipDeviceAttributeMultiprocessorCount, dev);
        (void)hipFuncSetAttribute((const void*)mega_kernel, hipFuncAttributeMaxDynamicSharedMemorySize, LDS_ALLOC);
        (void)hipOccupancyMaxActiveBlocksPerMultiprocessor(&per_cu, (const void*)mega_kernel, 512, LDS_ALLOC);
        if (per_cu < 1) fprintf(stderr, "kernel_launch: occupancy query says %d blocks per CU\n", per_cu);
        grid = cus;
        (void)hipGetLastError();
    }
    if (grid < 0) return;
    Params p{};
    for (int i = 0; i < N_IN; ++i) p.in[i] = (const float*)d_in[i];
    p.out = (float*)d_out; p.ws = (unsigned char*)d_ws;
    (void)hipMemsetAsync((unsigned char*)d_ws + WS_BAR, 0, XCD_BAR_WORDS * 4, stream);
    p.ph_lo = 0; p.ph_hi = 1 + NL * 11;
    void* args[] = {&p};
    hipError_t e = hipLaunchCooperativeKernel((const void*)mega_kernel, dim3(grid), dim3(512), args, LDS_ALLOC, stream);
    if (e != hipSuccess) fprintf(stderr, "cooperative launch failed: %s (grid %d)\n", hipGetErrorString(e), grid);
}
```

```cpp
#include <hip/hip_runtime.h>
#include <hip/hip_cooperative_groups.h>
#include <cstdio>
#include <cstdint>
namespace cg = cooperative_groups;

#ifndef MEGA
#define MEGA 1
#endif

typedef unsigned short bf16_t;
typedef short bf16x8 __attribute__((ext_vector_type(8)));
typedef float f32x4 __attribute__((ext_vector_type(4)));
typedef unsigned u32x4 __attribute__((ext_vector_type(4)));
typedef unsigned u32x2 __attribute__((ext_vector_type(2)));

#define DI __device__ __forceinline__
#define MFMA16(a, b, c) __builtin_amdgcn_mfma_f32_16x16x32_bf16((a), (b), (c), 0, 0, 0)

constexpr int T_TOK = 32768, SEQ = 4096, NB = 8, DM = 1024, NL = 4;
constexpr int UC = 3072;
constexpr int INC = 2976;
constexpr int DFF = 2816;
constexpr float EPS = 1e-6f;
constexpr int LDS_BYTES = 73728;
constexpr int LDS_ALLOC = 2 * LDS_BYTES + 16;

constexpr size_t SZ_W = 13533184ull * 2;
constexpr size_t OFF_W = 0;
constexpr size_t OFF_XWKV = OFF_W + SZ_W;
constexpr size_t OFF_XB = OFF_XWKV + 4ull * 512 * 1024 * 2;
constexpr size_t OFF_MEMB = OFF_XB + (size_t)T_TOK * 1024 * 2;
constexpr size_t OFF_U = OFF_MEMB + 2048ull * 1024 * 2;
constexpr size_t OFF_CAT = OFF_U + (size_t)T_TOK * UC * 2;
constexpr size_t OFF_MQ = OFF_CAT + (size_t)T_TOK * 1024 * 2;
constexpr size_t OFF_MK = OFF_MQ + (size_t)T_TOK * 384 * 2;
constexpr size_t OFF_MVT = OFF_MK + (size_t)T_TOK * 384 * 2;
constexpr size_t OFF_HST = OFF_MVT + (size_t)T_TOK * 256 * 2;
constexpr size_t OFF_HDEC = OFF_HST + 64ull * 64 * 4096 * 4;
constexpr size_t OFF_XK = OFF_HDEC + 64ull * 64 * 64 * 4;
constexpr size_t OFF_XVT = OFF_XK + 4ull * 8 * 4 * 256 * 64 * 2;
constexpr size_t OFF_ROPE = OFF_XVT + 4ull * 8 * 4 * 256 * 64 * 2;
constexpr size_t OFF_ROWSQ = OFF_ROPE + (size_t)T_TOK * 16 * 2 * 4;
constexpr size_t OFF_MEMSQ = OFF_ROWSQ + (size_t)T_TOK * 16 * 4;
constexpr size_t OFF_SSQB = OFF_MEMSQ + 2048 * 4;
constexpr size_t OFF_SSQD = OFF_SSQB + (size_t)T_TOK * 4 * 4;
constexpr size_t WS_BAR = OFF_SSQD + (size_t)T_TOK * 4 * 4;
constexpr size_t WS_END = WS_BAR + 16384;
constexpr size_t OFF_QRAW = OFF_XB;
constexpr size_t OFF_KVRAW = OFF_XB + (size_t)T_TOK * 384 * 2;
constexpr size_t OFF_KVMEM = OFF_MQ;
constexpr size_t OFF_XQ = OFF_U;
constexpr size_t OFF_XO = OFF_U + (size_t)T_TOK * 256 * 2;
constexpr size_t OFF_HFF = OFF_U;
constexpr size_t W_IN = 0, W_OUT = 3145728, W_UQ = 4194304, W_UKV = 4292608, W_XQ = 4358144, W_XO = 4620288, W_13 = 4882432, W_2 = 10649600;

enum { I_X = 0, I_MEM, I_POS, I_GMIX, I_WIN, I_ADWW, I_ADWB, I_ALNG, I_ALNB, I_HGAM, I_HONG, I_CDWW, I_CDWB, I_MQAG, I_MWUQ, I_MKVAG,
       I_MWUKV, I_MQNG, I_MKNG, I_GBR, I_WOUT, I_GXQ, I_GMEM, I_XWQ, I_XWKV, I_XQNG, I_XKNG, I_XWO, I_GFFN, I_W13, I_W2, N_IN };

struct Params {
    const float* in[N_IN];
    float* out;
    unsigned char* ws;
    int ph_lo, ph_hi;
    int layer, pad;
};

typedef __bf16 bf2_t __attribute__((ext_vector_type(2)));
typedef float f2_t __attribute__((ext_vector_type(2)));
DI unsigned cvt_pk(float lo, float hi) { f2_t v = {lo, hi}; bf2_t b = __builtin_convertvector(v, bf2_t); return __builtin_bit_cast(unsigned, b); }
DI bf16_t f2bf(float x) { return (bf16_t)(cvt_pk(x, 0.f) & 0xffffu); }
DI float bf2f(bf16_t h) { return __uint_as_float(((unsigned)h) << 16); }
DI float bflo(unsigned w) { return __uint_as_float(w << 16); }
DI float bfhi(unsigned w) { return __uint_as_float(w & 0xffff0000u); }
DI float sigmoidf_(float x) { return __builtin_amdgcn_rcpf(1.f + __expf(-x)); }
DI int tidx() { int t = threadIdx.x & 255; asm volatile("" : "+v"(t)); return t; }
DI float wave_sum(float v) {
#pragma unroll
    for (int o = 32; o > 0; o >>= 1) v += __shfl_xor(v, o);
    return v;
}

DI int sw_off(int row, int chunk) { return row * 128 + ((chunk ^ ((row >> 1) & 7)) << 4); }

DI void scale_chunk(uint4& v, float s) {
    v.x = cvt_pk(bflo(v.x) * s, bfhi(v.x) * s); v.y = cvt_pk(bflo(v.y) * s, bfhi(v.y) * s);
    v.z = cvt_pk(bflo(v.z) * s, bfhi(v.z) * s); v.w = cvt_pk(bflo(v.w) * s, bfhi(v.w) * s);
}

template <bool ASC>
DI void gemm_mainloop(const bf16_t* __restrict__ A, int lda, const bf16_t* __restrict__ Bt, int K, int row0, int col0,
                      unsigned char* smem, f32x4 (&acc)[4][4]) {
    const int tid = tidx(), lane = tid & 63, w = tid >> 6, wr = w >> 1, wc = w & 1, l15 = lane & 15, quad = lane >> 4;
    const int lr = tid >> 3, lc = tid & 7;
    const bf16_t* Ap = A + (size_t)(row0 + lr) * lda + lc * 8;
    const bf16_t* Bp = Bt + (size_t)(col0 + lr) * K + lc * 8;
    const size_t as1 = (size_t)32 * lda, bs1 = (size_t)32 * K;
    const float* asc = (const float*)(smem + 66048);
    uint4 ra0, ra1, ra2, ra3, rb0, rb1, rb2, rb3;
#define G_LOAD(ko) do { ra0 = *(const uint4*)(Ap + (ko)); ra1 = *(const uint4*)(Ap + as1 + (ko)); ra2 = *(const uint4*)(Ap + 2 * as1 + (ko)); ra3 = *(const uint4*)(Ap + 3 * as1 + (ko)); \
                        rb0 = *(const uint4*)(Bp + (ko)); rb1 = *(const uint4*)(Bp + bs1 + (ko)); rb2 = *(const uint4*)(Bp + 2 * bs1 + (ko)); rb3 = *(const uint4*)(Bp + 3 * bs1 + (ko)); } while (0)
#define G_STORE(buf) do { unsigned char* Ad_ = smem + (buf) * 16384; unsigned char* Bd_ = smem + 32768 + (buf) * 16384; const int o_ = sw_off(lr, lc); \
                          *(uint4*)(Ad_ + o_) = ra0; *(uint4*)(Ad_ + o_ + 4096) = ra1; *(uint4*)(Ad_ + o_ + 8192) = ra2; *(uint4*)(Ad_ + o_ + 12288) = ra3; \
                          *(uint4*)(Bd_ + o_) = rb0; *(uint4*)(Bd_ + o_ + 4096) = rb1; *(uint4*)(Bd_ + o_ + 8192) = rb2; *(uint4*)(Bd_ + o_ + 12288) = rb3; } while (0)
    const int plc = (tid & 7) ^ ((tid >> 4) & 7);
    const bf16_t* Adp = A + (size_t)(row0 + lr) * lda + plc * 8;
    const bf16_t* Bdp = Bt + (size_t)(col0 + lr) * K + plc * 8;
#define D_STAGE(buf, ko) do { _Pragma("unroll") for (int i_ = 0; i_ < 4; ++i_) { \
        __builtin_amdgcn_global_load_lds((const unsigned*)(Adp + i_ * as1 + (ko)), (unsigned*)(smem + (buf) * 16384 + i_ * 4096 + tid * 16), 16, 0, 0); \
        __builtin_amdgcn_global_load_lds((const unsigned*)(Bdp + i_ * bs1 + (ko)), (unsigned*)(smem + 32768 + (buf) * 16384 + i_ * 4096 + tid * 16), 16, 0, 0); } } while (0)
    if (ASC) { G_LOAD(0); } else { D_STAGE(0, 0); }
#pragma unroll
    for (int m = 0; m < 4; ++m)
#pragma unroll
        for (int n = 0; n < 4; ++n) acc[m][n] = (f32x4){0.f, 0.f, 0.f, 0.f};
    if (ASC) { G_STORE(0); }
    __syncthreads();
    const int nk = K >> 6;
    for (int kt = 0; kt < nk; ++kt) {
        const int cur = kt & 1;
        const bool more = (kt + 1 < nk);
        if (more) { const int ko = (kt + 1) * 64; if (ASC) { G_LOAD(ko); } else { D_STAGE(cur ^ 1, ko); } }
        __builtin_amdgcn_sched_barrier(0);
        const unsigned char* As = smem + cur * 16384;
        const unsigned char* Bs = smem + 32768 + cur * 16384;
#pragma unroll
        for (int ks = 0; ks < 2; ++ks) {
            bf16x8 af[4], bfv[4];
#pragma unroll
            for (int m = 0; m < 4; ++m) af[m] = *(const bf16x8*)(As + sw_off(wr * 64 + m * 16 + l15, ks * 4 + quad));
#pragma unroll
            for (int n = 0; n < 4; ++n) bfv[n] = *(const bf16x8*)(Bs + sw_off(wc * 64 + n * 16 + l15, ks * 4 + quad));
#pragma unroll
            for (int m = 0; m < 4; ++m)
#pragma unroll
                for (int n = 0; n < 4; ++n) acc[m][n] = MFMA16(bfv[n], af[m], acc[m][n]);
        }
        __builtin_amdgcn_sched_barrier(0);
        if (ASC && more) {
            const int grp = ((kt + 1) * 64) >> 8;
            if (grp & 1) {
                const int which = grp >> 1;
                scale_chunk(ra0, asc[lr * 2 + which]); scale_chunk(ra1, asc[(lr + 32) * 2 + which]);
                scale_chunk(ra2, asc[(lr + 64) * 2 + which]); scale_chunk(ra3, asc[(lr + 96) * 2 + which]);
            }
            G_STORE(cur ^ 1);
        }
        __syncthreads();
    }
#undef G_LOAD
#undef G_STORE
#undef D_STAGE
}

DI void tile_order(int L, int nM, int nN, int& pm, int& pn) {
    const int nwg = nM * nN;
    int wgid = L;
    { const int q = nwg / 8, r = nwg % 8, xcd = wgid % 8, off = wgid / 8; wgid = (xcd < r ? xcd * (q + 1) : r * (q + 1) + (xcd - r) * q) + off; }
    const int WGM = 8;
    const int nig = WGM * nN, gid = wgid / nig, fm = gid * WGM, gsz = (nM - fm) < WGM ? (nM - fm) : WGM;
    pm = fm + ((wgid % nig) % gsz); pn = (wgid % nig) / gsz;
}

DI void fill_rs(unsigned char* smem, const float* part, int npart, int row0, float inv_n) {
    float* rs = (float*)(smem + 65536);
    const int tid = tidx();
    if (tid < 128) {
        float s = 0.f;
        for (int i = 0; i < npart; ++i) s += part[(size_t)(row0 + tid) * npart + i];
        rs[tid] = __builtin_amdgcn_rsqf(s * inv_n + EPS);
    }
}

DI void epi_bf16(const f32x4 (&acc)[4][4], bf16_t* O, int ldo, int row0, int col0, const float* rs) {
    const int lane = tidx() & 63, w = tidx() >> 6, wr = w >> 1, wc = w & 1, l15 = lane & 15, quad = lane >> 4;
#pragma unroll
    for (int m = 0; m < 4; ++m) {
        const int rl = wr * 64 + m * 16 + l15;
        const float sc = rs ? rs[rl] : 1.f;
        bf16_t* rowp = O + (size_t)(row0 + rl) * ldo + col0 + wc * 64 + quad * 4;
#pragma unroll
        for (int n = 0; n < 4; ++n) {
            u32x2 v; v.x = cvt_pk(acc[m][n][0] * sc, acc[m][n][1] * sc); v.y = cvt_pk(acc[m][n][2] * sc, acc[m][n][3] * sc);
            *(u32x2*)(rowp + n * 16) = v;
        }
    }
}
DI void epi_resid(const f32x4 (&acc)[4][4], float* X, bf16_t* XB, float* rowsq, int row0, int col0) {
    const int lane = tidx() & 63, w = tidx() >> 6, wr = w >> 1, wc = w & 1, l15 = lane & 15, quad = lane >> 4;
    const int pn = col0 >> 7;
#pragma unroll
    for (int m = 0; m < 4; ++m) {
        const int row = row0 + wr * 64 + m * 16 + l15;
        float ss = 0.f;
#pragma unroll
        for (int n = 0; n < 4; ++n) {
            const int col = col0 + wc * 64 + n * 16 + quad * 4;
            float4* xp = (float4*)(X + (size_t)row * DM + col);
            float4 xv = *xp;
            xv.x += acc[m][n][0]; xv.y += acc[m][n][1]; xv.z += acc[m][n][2]; xv.w += acc[m][n][3];
            *xp = xv;
            u32x2 v; v.x = cvt_pk(xv.x, xv.y); v.y = cvt_pk(xv.z, xv.w);
            *(u32x2*)(XB + (size_t)row * DM + col) = v;
            ss += xv.x * xv.x + xv.y * xv.y + xv.z * xv.z + xv.w * xv.w;
        }
        ss += __shfl_xor(ss, 16); ss += __shfl_xor(ss, 32);
        if (quad == 0) rowsq[(size_t)row * 16 + pn * 2 + wc] = ss;
    }
}
DI void epi_swiglu(const f32x4 (&acc)[4][4], bf16_t* H, int row0, int col0, const float* rs) {
    const int lane = tidx() & 63, w = tidx() >> 6, wr = w >> 1, wc = w & 1, l15 = lane & 15, quad = lane >> 4;
#pragma unroll
    for (int m = 0; m < 4; ++m) {
        const int rl = wr * 64 + m * 16 + l15;
        const float sc = rs[rl];
        bf16_t* rowp = H + (size_t)(row0 + rl) * DFF + ((col0 + wc * 64) >> 1) + quad * 4;
#pragma unroll
        for (int np = 0; np < 2; ++np) {
            float h[4];
#pragma unroll
            for (int j = 0; j < 4; ++j) { const float a1 = acc[m][2 * np][j] * sc, a3 = acc[m][2 * np + 1][j] * sc; h[j] = a1 * sigmoidf_(a1) * a3; }
            u32x2 v; v.x = cvt_pk(h[0], h[1]); v.y = cvt_pk(h[2], h[3]);
            *(u32x2*)(rowp + np * 16) = v;
        }
    }
}

DI void conv_tile(const float* __restrict__ src, int K, int N, int Npad, const float* __restrict__ gain, int perm, bf16_t* __restrict__ dst, int tile, unsigned char* smem) {
    float* lds = (float*)smem;
    const int nkt = K >> 6, kt = tile % nkt, nt = tile / nkt, k0 = kt * 64, n0 = nt * 64;
    const int tid = tidx(), nl = tid & 63, kq = tid >> 6;
    const int R = n0 + nl;
    int sc = R;
    if (perm == 1) { const int g = R >> 5, j = R & 31; sc = (j < 16) ? (16 * g + j) : (DFF + 16 * g + j - 16); }
    const bool ok = R < N;
#pragma unroll
    for (int i = 0; i < 16; ++i) { const int kl = kq + 4 * i; lds[kl * 65 + nl] = ok ? src[(size_t)(k0 + kl) * N + sc] : 0.f; }
    __syncthreads();
    const int kc = tid & 7, nr = tid >> 3;
    int kd0 = k0;
    if (perm == 2) { const int g = k0 >> 8; const int gm = (g == 0) ? 2 : (g == 1) ? 0 : (g == 2) ? 3 : 1; kd0 = gm * 256 + (k0 & 255); }
    float g8[8];
#pragma unroll
    for (int j = 0; j < 8; ++j) g8[j] = gain ? gain[k0 + kc * 8 + j] : 1.f;
#pragma unroll
    for (int i = 0; i < 2; ++i) {
        const int nl2 = nr + 32 * i;
        float v[8];
#pragma unroll
        for (int j = 0; j < 8; ++j) v[j] = lds[(kc * 8 + j) * 65 + nl2] * g8[j];
        uint4 o; o.x = cvt_pk(v[0], v[1]); o.y = cvt_pk(v[2], v[3]); o.z = cvt_pk(v[4], v[5]); o.w = cvt_pk(v[6], v[7]);
        *(uint4*)(dst + (size_t)(n0 + nl2) * K + kd0 + kc * 8) = o;
    }
    __syncthreads();
}

constexpr int CONV_TILES = 768 + 256 + 24 + 16 + 64 + 64 + 1408 + 704;
DI void conv_layer_item(const Params& p, int l, int it, unsigned char* smem) {
    bf16_t* W = (bf16_t*)(p.ws + OFF_W);
    if (it < 768) { conv_tile(p.in[I_WIN] + (size_t)l * DM * INC, DM, INC, UC, p.in[I_GMIX] + l * DM, 0, W + W_IN, it, smem); return; } it -= 768;
    if (it < 256) { conv_tile(p.in[I_WOUT] + (size_t)l * DM * DM, DM, DM, DM, p.in[I_GBR] + l * DM, 2, W + W_OUT, it, smem); return; } it -= 256;
    if (it < 24) { conv_tile(p.in[I_MWUQ] + (size_t)l * 256 * 384, 256, 384, 384, p.in[I_MQAG] + l * 256, 0, W + W_UQ, it, smem); return; } it -= 24;
    if (it < 16) { conv_tile(p.in[I_MWUKV] + (size_t)l * 128 * 512, 128, 512, 512, p.in[I_MKVAG] + l * 128, 0, W + W_UKV, it, smem); return; } it -= 16;
    if (it < 64) { conv_tile(p.in[I_XWQ] + (size_t)l * DM * 256, DM, 256, 256, p.in[I_GXQ] + l * DM, 0, W + W_XQ, it, smem); return; } it -= 64;
    if (it < 64) { conv_tile(p.in[I_XWO] + (size_t)l * 256 * DM, 256, DM, DM, nullptr, 0, W + W_XO, it, smem); return; } it -= 64;
    if (it < 1408) { conv_tile(p.in[I_W13] + (size_t)l * DM * 2 * DFF, DM, 2 * DFF, 2 * DFF, p.in[I_GFFN] + l * DM, 1, W + W_13, it, smem); return; } it -= 1408;
    conv_tile(p.in[I_W2] + (size_t)l * DFF * DM, DFF, DM, DM, nullptr, 0, W + W_2, it, smem);
}

DI void pro_rows(const float* __restrict__ src, float* __restrict__ cpy, bf16_t* __restrict__ dstb, float* __restrict__ sq, int sqstride, int item) {
    const int w = tidx() >> 6, lane = tidx() & 63;
    for (int r = 0; r < 4; ++r) {
        const int row = item * 16 + w * 4 + r;
        const float4* s4 = (const float4*)(src + (size_t)row * DM);
        float s = 0.f;
#pragma unroll
        for (int i = 0; i < 4; ++i) {
            const float4 v = s4[lane + 64 * i];
            if (cpy) ((float4*)(cpy + (size_t)row * DM))[lane + 64 * i] = v;
            u32x2 o; o.x = cvt_pk(v.x, v.y); o.y = cvt_pk(v.z, v.w);
            *(u32x2*)(dstb + (size_t)row * DM + (lane + 64 * i) * 4) = o;
            s += v.x * v.x + v.y * v.y + v.z * v.z + v.w * v.w;
        }
        s = wave_sum(s);
        if (lane < sqstride) sq[(size_t)row * sqstride + lane] = (lane == 0) ? s : 0.f;
    }
}
DI void pro_rope(const Params& p, int item) {
    const int tok = item * 256 + tidx();
    const int* pos = (const int*)p.in[I_POS];
    float* cs = (float*)(p.ws + OFF_ROPE);
    float* sn = cs + (size_t)T_TOK * 16;
    const float pf = (float)pos[tok];
#pragma unroll
    for (int i = 0; i < 16; ++i) {
        const float inv = powf(10000.0f, -(float)(2 * i) / 32.0f);
        const float ang = pf * inv;
        cs[(size_t)tok * 16 + i] = cosf(ang);
        sn[(size_t)tok * 16 + i] = sinf(ang);
    }
}

DI void conformer_tile(const Params& p, int l, int tile, unsigned char* smem) {
    float* hs = (float*)smem;
    const bf16_t* U = (const bf16_t*)(p.ws + OFF_U);
    bf16_t* CAT = (bf16_t*)(p.ws + OFF_CAT);
    const int tid = tidx(), b = tile >> 7, t0 = (tile & 127) * 32;
    {
        const int c2 = (tid & 127) * 2, half = tid >> 7;
        for (int r0 = half; r0 < 62; r0 += 32) {
            unsigned av[16], gv[16];
#pragma unroll
            for (int k = 0; k < 16; ++k) {
                const int r = r0 + 2 * k, t = t0 - 15 + r;
                av[k] = 0u; gv[k] = 0u;
                if (r < 62 && t >= 0 && t < SEQ) {
                    const bf16_t* up = U + (size_t)(b * SEQ + t) * UC;
                    av[k] = *(const unsigned*)(up + c2); gv[k] = *(const unsigned*)(up + 256 + c2);
                }
            }
#pragma unroll
            for (int k = 0; k < 16; ++k) {
                const int r = r0 + 2 * k;
                if (r < 62) {
                    hs[r * 256 + c2] = bflo(av[k]) * sigmoidf_(bflo(gv[k]));
                    hs[r * 256 + c2 + 1] = bfhi(av[k]) * sigmoidf_(bfhi(gv[k]));
                }
            }
        }
    }
    __syncthreads();
    {
        const int c = tid;
        float wv[31];
        const float* wp = p.in[I_ADWW] + (size_t)l * 31 * 256 + c;
#pragma unroll
        for (int j = 0; j < 31; ++j) wv[j] = wp[j * 256];
        const float bias = p.in[I_ADWB][l * 256 + c];
        for (int t = 0; t < 32; ++t) {
            float y = bias;
#pragma unroll
            for (int j = 0; j < 31; ++j) y += wv[j] * hs[(t + j) * 256 + c];
            hs[t * 256 + c] = y;
        }
    }
    __syncthreads();
    {
        const int w = tid >> 6, lane = tid & 63;
        const float4 g4 = *(const float4*)(p.in[I_ALNG] + l * 256 + lane * 4), b4 = *(const float4*)(p.in[I_ALNB] + l * 256 + lane * 4);
        for (int r = 0; r < 8; ++r) {
            const int t = w * 8 + r;
            float4 v = *(const float4*)(hs + t * 256 + lane * 4);
            const float mu = wave_sum(v.x + v.y + v.z + v.w) * (1.f / 256.f);
            v.x -= mu; v.y -= mu; v.z -= mu; v.w -= mu;
            const float var = wave_sum(v.x * v.x + v.y * v.y + v.z * v.z + v.w * v.w) * (1.f / 256.f);
            const float rstd = __builtin_amdgcn_rsqf(var + EPS);
            float y0 = v.x * rstd * g4.x + b4.x, y1 = v.y * rstd * g4.y + b4.y, y2 = v.z * rstd * g4.z + b4.z, y3 = v.w * rstd * g4.w + b4.w;
            y0 *= sigmoidf_(y0); y1 *= sigmoidf_(y1); y2 *= sigmoidf_(y2); y3 *= sigmoidf_(y3);
            const float ss = wave_sum(y0 * y0 + y1 * y1 + y2 * y2 + y3 * y3);
            const float rb = __builtin_amdgcn_rsqf(ss * (1.f / 256.f) + EPS);
            u32x2 o; o.x = cvt_pk(y0 * rb, y1 * rb); o.y = cvt_pk(y2 * rb, y3 * rb);
            *(u32x2*)(CAT + (size_t)(b * SEQ + t0 + t) * DM + 512 + lane * 4) = o;
        }
    }
    __syncthreads();
}

DI void shortconv_tile(const Params& p, int l, int tile) {
    const bf16_t* U = (const bf16_t*)(p.ws + OFF_U);
    bf16_t* CAT = (bf16_t*)(p.ws + OFF_CAT);
    const int w = tidx() >> 6, lane = tidx() & 63, c = lane * 4;
    const float* wp = p.in[I_CDWW] + (size_t)l * 3 * 256 + c;
    const float4 w0 = *(const float4*)(wp), w1 = *(const float4*)(wp + 256), w2 = *(const float4*)(wp + 512);
    const float4 bb = *(const float4*)(p.in[I_CDWB] + l * 256 + c);
#pragma unroll 4
    for (int r = 0; r < 16; ++r) {
        const int tok = tile * 64 + w * 16 + r, s = tok & (SEQ - 1);
        float pr[3][4];
#pragma unroll
        for (int j = 0; j < 3; ++j) {
            const int sj = s + j - 1;
            if (sj >= 0 && sj < SEQ) {
                const bf16_t* up = U + (size_t)(tok + j - 1) * UC;
                const u32x2 gc = *(const u32x2*)(up + 2048 + c), xi = *(const u32x2*)(up + 2304 + c);
                pr[j][0] = bflo(gc.x) * bflo(xi.x); pr[j][1] = bfhi(gc.x) * bfhi(xi.x); pr[j][2] = bflo(gc.y) * bflo(xi.y); pr[j][3] = bfhi(gc.y) * bfhi(xi.y);
            } else { pr[j][0] = pr[j][1] = pr[j][2] = pr[j][3] = 0.f; }
        }
        const u32x2 gb = *(const u32x2*)(U + (size_t)tok * UC + 1792 + c);
        const float y0 = bflo(gb.x) * (bb.x + w0.x * pr[0][0] + w1.x * pr[1][0] + w2.x * pr[2][0]);
        const float y1 = bfhi(gb.x) * (bb.y + w0.y * pr[0][1] + w1.y * pr[1][1] + w2.y * pr[2][1]);
        const float y2 = bflo(gb.y) * (bb.z + w0.z * pr[0][2] + w1.z * pr[1][2] + w2.z * pr[2][2]);
        const float y3 = bfhi(gb.y) * (bb.w + w0.w * pr[0][3] + w1.w * pr[1][3] + w2.w * pr[2][3]);
        const float ss = wave_sum(y0 * y0 + y1 * y1 + y2 * y2 + y3 * y3);
        const float rb = __builtin_amdgcn_rsqf(ss * (1.f / 256.f) + EPS);
        u32x2 o; o.x = cvt_pk(y0 * rb, y1 * rb); o.y = cvt_pk(y2 * rb, y3 * rb);
        *(u32x2*)(CAT + (size_t)tok * DM + 768 + c) = o;
    }
}

DI float hgrn_lower(const Params& p, int l, int dir, int ch) {
    const float* g = p.in[I_HGAM] + (size_t)dir * NL * 256 + ch;
    const float g0 = g[0], g1 = g[256], g2 = g[512], g3 = g[768];
    const float mx = fmaxf(fmaxf(g0, g1), fmaxf(g2, g3));
    const float e0 = __expf(g0 - mx), e1 = __expf(g1 - mx), e2 = __expf(g2 - mx), e3 = __expf(g3 - mx);
    const float inv = 1.f / (e0 + e1 + e2 + e3);
    float lb = 0.f;
    if (l >= 1) lb += e1; if (l >= 2) lb += e2; if (l >= 3) lb += e3;
    return lb * inv;
}

DI void hgrn_local_tile(const Params& p, int l, int item, unsigned char* smem) {
    const bf16_t* U = (const bf16_t*)(p.ws + OFF_U);
    bf16_t* HST = (bf16_t*)(p.ws + OFF_HST);
    float* HDEC = (float*)(p.ws + OFF_HDEC);
    const int dir = item >> 9, b = (item >> 6) & 7, c = item & 63;
    const int h = tidx() >> 6, lane = tidx() & 63, l15 = lane & 15, quad = lane >> 4;
    bf16_t* kT = (bf16_t*)(smem + h * 18432);
    bf16_t* vT = kT + 64 * 72;
    const float lb = hgrn_lower(p, l, dir, h * 64 + lane);
    const int tokbase = b * SEQ + c * 64;
    const bf16_t* zp = U + (size_t)tokbase * UC + 768 + dir * 256 + h * 64 + lane;
    const bf16_t* vp = U + (size_t)tokbase * UC + 1280 + h * 64 + lane;
    float suf = 0.f;
    {
        const int step = dir ? UC : -UC, di = dir ? 1 : -1;
        int i = dir ? 0 : 63;
        zp += (size_t)i * UC; vp += (size_t)i * UC;
        bf16_t* kw = kT + lane * 72 + i; bf16_t* vw = vT + lane * 72 + i;
        for (int hb = 0; hb < 2; ++hb) {
            bf16_t zz[32], vv[32];
#pragma unroll
            for (int ii = 0; ii < 32; ++ii) { zz[ii] = zp[(ptrdiff_t)ii * step]; vv[ii] = vp[(ptrdiff_t)ii * step]; }
            zp += (ptrdiff_t)32 * step; vp += (ptrdiff_t)32 * step;
#pragma unroll
            for (int ii = 0; ii < 32; ++ii) {
                const float z = bf2f(zz[ii]);
                const float sg = sigmoidf_(z), f = sg + lb * (1.f - sg), kk = (1.f - lb) * (1.f - sg);
                kw[ii * di] = f2bf(kk * __expf(suf));
                vw[ii * di] = vv[ii];
                suf += __logf(f);
            }
            kw += 32 * di; vw += 32 * di;
        }
    }
    const int seq = (dir * 8 + b) * 4 + h, cs = dir ? 63 - c : c;
    HDEC[((size_t)seq * 64 + cs) * 64 + lane] = __expf(suf);
    __syncthreads();
    f32x4 acc[4][4];
#pragma unroll
    for (int et = 0; et < 4; ++et)
#pragma unroll
        for (int dt = 0; dt < 4; ++dt) acc[et][dt] = (f32x4){0.f, 0.f, 0.f, 0.f};
#pragma unroll
    for (int ks = 0; ks < 2; ++ks) {
        bf16x8 av[4], bk[4];
#pragma unroll
        for (int t = 0; t < 4; ++t) {
            av[t] = *(const bf16x8*)(vT + (t * 16 + l15) * 72 + ks * 32 + quad * 8);
            bk[t] = *(const bf16x8*)(kT + (t * 16 + l15) * 72 + ks * 32 + quad * 8);
        }
#pragma unroll
        for (int et = 0; et < 4; ++et)
#pragma unroll
            for (int dt = 0; dt < 4; ++dt) acc[et][dt] = MFMA16(bk[dt], av[et], acc[et][dt]);
    }
    bf16_t* sp = HST + ((size_t)seq * 64 + cs) * 4096;
#pragma unroll
    for (int et = 0; et < 4; ++et)
#pragma unroll
        for (int dt = 0; dt < 4; ++dt) {
            u32x2 v; v.x = cvt_pk(acc[et][dt][0], acc[et][dt][1]); v.y = cvt_pk(acc[et][dt][2], acc[et][dt][3]);
            *(u32x2*)(sp + (et * 16 + l15) * 64 + dt * 16 + quad * 4) = v;
        }
    __syncthreads();
}

DI void hgrn_scan_item(const Params& p, int item) {
    unsigned* HSTU = (unsigned*)(p.ws + OFF_HST);
    const float* HDEC = (const float*)(p.ws + OFF_HDEC);
    const int gid = item * 256 + tidx(), seq = gid >> 11, pr = gid & 2047, d = (pr * 2) & 63;
    unsigned* sp = HSTU + (size_t)seq * 64 * 2048 + pr;
    const float* dp = HDEC + (size_t)seq * 64 * 64 + d;
    float s0 = 0.f, s1 = 0.f;
    for (int c0 = 0; c0 < 64; c0 += 8) {
        unsigned loc[8]; float2 dec[8];
#pragma unroll
        for (int j = 0; j < 8; ++j) { loc[j] = sp[(size_t)(c0 + j) * 2048]; dec[j] = *(const float2*)(dp + (c0 + j) * 64); }
#pragma unroll
        for (int j = 0; j < 8; ++j) { sp[(size_t)(c0 + j) * 2048] = cvt_pk(s0, s1); s0 = dec[j].x * s0 + bflo(loc[j]); s1 = dec[j].y * s1 + bfhi(loc[j]); }
    }
}

DI bf16x8 hg_frag(const bf16_t* qk, const float* bc, const float* ref, bool qside) {
    const uint4 x = *(const uint4*)qk;
    const float4 b0 = *(const float4*)bc, b1 = *(const float4*)(bc + 4);
    float4 r0 = {0.f, 0.f, 0.f, 0.f}, r1 = {0.f, 0.f, 0.f, 0.f};
    if (ref) { r0 = *(const float4*)ref; r1 = *(const float4*)(ref + 4); }
    float e[8] = {b0.x - r0.x, b0.y - r0.y, b0.z - r0.z, b0.w - r0.w, b1.x - r1.x, b1.y - r1.y, b1.z - r1.z, b1.w - r1.w};
    if (!qside) {
#pragma unroll
        for (int j = 0; j < 8; ++j) e[j] = -e[j];
    }
    u32x4 o;
    o.x = cvt_pk(bflo(x.x) * __expf(e[0]), bfhi(x.x) * __expf(e[1]));
    o.y = cvt_pk(bflo(x.y) * __expf(e[2]), bfhi(x.y) * __expf(e[3]));
    o.z = cvt_pk(bflo(x.z) * __expf(e[4]), bfhi(x.z) * __expf(e[5]));
    o.w = cvt_pk(bflo(x.w) * __expf(e[6]), bfhi(x.w) * __expf(e[7]));
    return __builtin_bit_cast(bf16x8, o);
}

DI void hgrn_out_tile(const Params& p, int l, int item, unsigned char* smem) {
    const bf16_t* U = (const bf16_t*)(p.ws + OFF_U);
    const bf16_t* HST = (const bf16_t*)(p.ws + OFF_HST);
    bf16_t* CAT = (bf16_t*)(p.ws + OFF_CAT);
    float* SSQB = (float*)(p.ws + OFF_SSQB);
    const int h = item & 3, c = (item >> 2) & 63, b = item >> 8;
    const int w = tidx() >> 6, lane = tidx() & 63, l15 = lane & 15, quad = lane >> 4;
    float* bc = (float*)smem;
    bf16_t* kk = (bf16_t*)(smem + 34816);
    bf16_t* qq = (bf16_t*)(smem + 34816 + 18432);
    bf16_t* vT = (bf16_t*)(smem + 34816 + 18432 + 9216);
    const int tokbase = b * SEQ + c * 64;
    u32x4 sfr[2][4];
    {
        const int dirp = w & 1;
        const int seqp = (dirp * 8 + b) * 4 + h, csp = dirp ? 63 - c : c;
        const bf16_t* sinp = HST + ((size_t)seqp * 64 + csp) * 4096;
#pragma unroll
        for (int ks = 0; ks < 2; ++ks)
#pragma unroll
            for (int et = 0; et < 4; ++et) sfr[ks][et] = *(const u32x4*)(sinp + (et * 16 + l15) * 64 + ks * 32 + quad * 8);
    }
    if (w < 2) {
        const int dir = w;
        const float lb = hgrn_lower(p, l, dir, h * 64 + lane);
        const bf16_t* zp = U + (size_t)tokbase * UC + 768 + dir * 256 + h * 64 + lane;
        float run = 0.f;
        const int step = dir ? -UC : UC, di = dir ? -1 : 1;
        int i = dir ? 63 : 0;
        zp += (size_t)i * UC;
        float* bw = bc + (dir * 64 + i) * 68 + lane; bf16_t* kw = kk + (dir * 64 + i) * 72 + lane;
        {
            bf16_t zz[64];
#pragma unroll
            for (int ii = 0; ii < 64; ++ii) zz[ii] = zp[(ptrdiff_t)ii * step];
#pragma unroll
            for (int ii = 0; ii < 64; ++ii) {
                const float z = bf2f(zz[ii]);
                const float sg = sigmoidf_(z), f = sg + lb * (1.f - sg);
                run += __logf(f);
                bw[ii * di * 68] = run; kw[ii * di * 72] = f2bf((1.f - lb) * (1.f - sg));
            }
        }
    } else if (w == 2) {
        const bf16_t* qp = U + (size_t)tokbase * UC + 512 + h * 64 + lane;
        {
            bf16_t t[64];
#pragma unroll
            for (int i = 0; i < 64; ++i) t[i] = qp[(size_t)i * UC];
#pragma unroll
            for (int i = 0; i < 64; ++i) qq[i * 72 + lane] = t[i];
        }
    } else {
        const bf16_t* vp = U + (size_t)tokbase * UC + 1280 + h * 64 + lane;
        {
            bf16_t t[64];
#pragma unroll
            for (int i = 0; i < 64; ++i) t[i] = vp[(size_t)i * UC];
#pragma unroll
            for (int i = 0; i < 64; ++i) vT[lane * 72 + i] = t[i];
        }
    }
    __syncthreads();
    const int dir = w & 1, iset = w >> 1;
    const int seq = (dir * 8 + b) * 4 + h, cs = dir ? 63 - c : c;
    const float* bcd = bc + dir * 64 * 68;
    const bf16_t* kkd = kk + dir * 64 * 72;
    f32x4 o[4][2];
#pragma unroll
    for (int et = 0; et < 4; ++et) { o[et][0] = (f32x4){0.f, 0.f, 0.f, 0.f}; o[et][1] = (f32x4){0.f, 0.f, 0.f, 0.f}; }
#pragma unroll
    for (int ii = 0; ii < 2; ++ii) {
        const int I = iset == 0 ? (ii == 0 ? 0 : 3) : (ii == 0 ? 1 : 2);
        const int irow = 16 * I + l15;
#pragma unroll
        for (int ks = 0; ks < 2; ++ks) {
            const int d0 = ks * 32 + quad * 8;
            const bf16x8 bq = hg_frag(qq + irow * 72 + d0, bcd + irow * 68 + d0, nullptr, true);
#pragma unroll
            for (int et = 0; et < 4; ++et) o[et][ii] = MFMA16(__builtin_bit_cast(bf16x8, sfr[ks][et]), bq, o[et][ii]);
        }
#pragma unroll
        for (int kk2 = 0; kk2 < 2; ++kk2) {
            f32x4 at[2];
            bool any = false;
#pragma unroll
            for (int jj = 0; jj < 2; ++jj) {
                const int J = 2 * kk2 + jj;
                at[jj] = (f32x4){0.f, 0.f, 0.f, 0.f};
                const bool active = dir == 0 ? (J <= I) : (J >= I);
                if (active) {
                    any = true;
                    const float* ref = nullptr;
                    if (dir == 0) { if (J > 0) ref = bcd + (16 * J - 1) * 68; } else { if (J < 3) ref = bcd + (16 * J + 16) * 68; }
                    const int srow = 16 * J + l15;
#pragma unroll
                    for (int ks = 0; ks < 2; ++ks) {
                        const int d0 = ks * 32 + quad * 8;
                        const bf16x8 ak = hg_frag(kkd + srow * 72 + d0, bcd + srow * 68 + d0, ref ? ref + d0 : nullptr, false);
                        const bf16x8 bq = hg_frag(qq + irow * 72 + d0, bcd + irow * 68 + d0, ref ? ref + d0 : nullptr, true);
                        at[jj] = MFMA16(ak, bq, at[jj]);
                    }
                    if (J == I) {
#pragma unroll
                        for (int r = 0; r < 4; ++r) {
                            const int sl = quad * 4 + r;
                            const bool keep = dir == 0 ? (sl <= l15) : (sl >= l15);
                            if (!keep) at[jj][r] = 0.f;
                        }
                    }
                }
            }
            if (any) {
                u32x4 pbw; pbw.x = cvt_pk(at[0][0], at[0][1]); pbw.y = cvt_pk(at[0][2], at[0][3]); pbw.z = cvt_pk(at[1][0], at[1][1]); pbw.w = cvt_pk(at[1][2], at[1][3]);
                const bf16x8 pb = __builtin_bit_cast(bf16x8, pbw);
#pragma unroll
                for (int et = 0; et < 4; ++et) {
                    const bf16_t* vp = vT + (et * 16 + l15) * 72 + kk2 * 32 + quad * 4;
                    const u32x2 lo = *(const u32x2*)vp, hi = *(const u32x2*)(vp + 16);
                    u32x4 a; a.x = lo.x; a.y = lo.y; a.z = hi.x; a.w = hi.y;
                    o[et][ii] = MFMA16(__builtin_bit_cast(bf16x8, a), pb, o[et][ii]);
                }
            }
        }
    }
    __syncthreads();
    float* ob = (float*)smem;
    if (dir == 1) {
#pragma unroll
        for (int ii = 0; ii < 2; ++ii) {
            const int I = iset == 0 ? (ii == 0 ? 0 : 3) : (ii == 0 ? 1 : 2);
#pragma unroll
            for (int et = 0; et < 4; ++et) *(f32x4*)(ob + (16 * I + l15) * 68 + et * 16 + quad * 4) = o[et][ii];
        }
    }
    __syncthreads();
    if (dir == 0) {
#pragma unroll
        for (int ii = 0; ii < 2; ++ii) {
            const int I = iset == 0 ? (ii == 0 ? 0 : 3) : (ii == 0 ? 1 : 2);
            const int tok = tokbase + 16 * I + l15;
            float ss = 0.f;
#pragma unroll
            for (int et = 0; et < 4; ++et) {
                o[et][ii] += *(const f32x4*)(ob + (16 * I + l15) * 68 + et * 16 + quad * 4);
                ss += o[et][ii][0] * o[et][ii][0] + o[et][ii][1] * o[et][ii][1] + o[et][ii][2] * o[et][ii][2] + o[et][ii][3] * o[et][ii][3];
            }
            ss += __shfl_xor(ss, 16); ss += __shfl_xor(ss, 32);
            const float rh = __builtin_amdgcn_rsqf(ss * (1.f / 64.f) + EPS);
            float ssy = 0.f;
#pragma unroll
            for (int et = 0; et < 4; ++et) {
                const int e = et * 16 + quad * 4;
                const u32x2 gg = *(const u32x2*)(U + (size_t)tok * UC + 1536 + h * 64 + e);
                const float4 og = *(const float4*)(p.in[I_HONG] + l * 256 + h * 64 + e);
                const float g0 = bflo(gg.x), g1 = bfhi(gg.x), g2 = bflo(gg.y), g3 = bfhi(gg.y);
                const float y0 = o[et][ii][0] * rh * og.x * g0 * sigmoidf_(g0), y1 = o[et][ii][1] * rh * og.y * g1 * sigmoidf_(g1);
                const float y2 = o[et][ii][2] * rh * og.z * g2 * sigmoidf_(g2), y3 = o[et][ii][3] * rh * og.w * g3 * sigmoidf_(g3);
                ssy += y0 * y0 + y1 * y1 + y2 * y2 + y3 * y3;
                u32x2 ov; ov.x = cvt_pk(y0, y1); ov.y = cvt_pk(y2, y3);
                *(u32x2*)(CAT + (size_t)tok * DM + h * 64 + e) = ov;
            }
            ssy += __shfl_xor(ssy, 16); ssy += __shfl_xor(ssy, 32);
            if (quad == 0) SSQB[(size_t)tok * 4 + h] = ssy;
        }
    }
    __syncthreads();
}

DI void mla_finish_tile(const Params& p, int l, int item, unsigned char* smem) {
    const bf16_t* U = (const bf16_t*)(p.ws + OFF_U);
    const bf16_t* QR = (const bf16_t*)(p.ws + OFF_QRAW);
    const bf16_t* KVR = (const bf16_t*)(p.ws + OFF_KVRAW);
    bf16_t* MQ = (bf16_t*)(p.ws + OFF_MQ);
    bf16_t* MK = (bf16_t*)(p.ws + OFF_MK);
    bf16_t* MVT = (bf16_t*)(p.ws + OFF_MVT);
    const float* CS = (const float*)(p.ws + OFF_ROPE);
    const float* SN = CS + (size_t)T_TOK * 16;
    bf16_t* vbuf = (bf16_t*)smem;
    const int w = tidx() >> 6, lane = tidx() & 63, h = lane >> 4, j = lane & 15;
    const float4 qg = *(const float4*)(p.in[I_MQNG] + l * 96 + 4 * j), kg = *(const float4*)(p.in[I_MKNG] + l * 96 + 4 * j);
    const float qg1 = p.in[I_MQNG][l * 96 + 64 + j], qg2 = p.in[I_MQNG][l * 96 + 80 + j];
    const float kg1 = p.in[I_MKNG][l * 96 + 64 + j], kg2 = p.in[I_MKNG][l * 96 + 80 + j];
#pragma unroll 4
    for (int r = 0; r < 16; ++r) {
        const int tl = w * 16 + r, tok = item * 64 + tl;
        const bf16_t* up = U + (size_t)tok * UC;
        float sq, skv;
        { const u32x2 a = *(const u32x2*)(up + 2560 + lane * 4);
          const float a0 = bflo(a.x), a1 = bfhi(a.x), a2 = bflo(a.y), a3 = bfhi(a.y);
          sq = __builtin_amdgcn_rsqf(wave_sum(a0 * a0 + a1 * a1 + a2 * a2 + a3 * a3) * (1.f / 256.f) + EPS);
          const unsigned c = *(const unsigned*)(up + 2816 + lane * 2);
          const float c0 = bflo(c), c1 = bfhi(c);
          skv = __builtin_amdgcn_rsqf(wave_sum(c0 * c0 + c1 * c1) * (1.f / 128.f) + EPS); }
        const float cs = CS[(size_t)tok * 16 + j], sn = SN[(size_t)tok * 16 + j];
        {
            const bf16_t* qp = QR + (size_t)tok * 384 + h * 96;
            const u32x2 a = *(const u32x2*)(qp + 4 * j);
            float q0 = bflo(a.x) * sq, q1 = bfhi(a.x) * sq, q2 = bflo(a.y) * sq, q3 = bfhi(a.y) * sq;
            float x1 = bf2f(qp[64 + j]) * sq, x2 = bf2f(qp[80 + j]) * sq;
            float ss = q0 * q0 + q1 * q1 + q2 * q2 + q3 * q3 + x1 * x1 + x2 * x2;
            ss += __shfl_xor(ss, 1); ss += __shfl_xor(ss, 2); ss += __shfl_xor(ss, 4); ss += __shfl_xor(ss, 8);
            const float rn = __builtin_amdgcn_rsqf(ss * (1.f / 96.f) + EPS);
            q0 *= rn * qg.x; q1 *= rn * qg.y; q2 *= rn * qg.z; q3 *= rn * qg.w; x1 *= rn * qg1; x2 *= rn * qg2;
            bf16_t* op = MQ + (size_t)tok * 384 + h * 96;
            u32x2 ov; ov.x = cvt_pk(q0, q1); ov.y = cvt_pk(q2, q3);
            *(u32x2*)(op + 4 * j) = ov;
            op[64 + j] = f2bf(x1 * cs - x2 * sn); op[80 + j] = f2bf(x2 * cs + x1 * sn);
        }
        {
            const bf16_t* kp = KVR + (size_t)tok * 512 + h * 128;
            const u32x2 a = *(const u32x2*)(kp + 4 * j);
            float k0 = bflo(a.x) * skv, k1 = bfhi(a.x) * skv, k2 = bflo(a.y) * skv, k3 = bfhi(a.y) * skv;
            float x1 = bf2f(up[2944 + j]), x2 = bf2f(up[2960 + j]);
            float ss = k0 * k0 + k1 * k1 + k2 * k2 + k3 * k3 + x1 * x1 + x2 * x2;
            ss += __shfl_xor(ss, 1); ss += __shfl_xor(ss, 2); ss += __shfl_xor(ss, 4); ss += __shfl_xor(ss, 8);
            const float rn = __builtin_amdgcn_rsqf(ss * (1.f / 96.f) + EPS);
            k0 *= rn * kg.x; k1 *= rn * kg.y; k2 *= rn * kg.z; k3 *= rn * kg.w; x1 *= rn * kg1; x2 *= rn * kg2;
            bf16_t* op = MK + (size_t)tok * 384 + h * 96;
            u32x2 ov; ov.x = cvt_pk(k0, k1); ov.y = cvt_pk(k2, k3);
            *(u32x2*)(op + 4 * j) = ov;
            op[64 + j] = f2bf(x1 * cs - x2 * sn); op[80 + j] = f2bf(x2 * cs + x1 * sn);
            const u32x2 vv = *(const u32x2*)(kp + 64 + 4 * j);
            u32x2 vo; vo.x = cvt_pk(bflo(vv.x) * skv, bfhi(vv.x) * skv); vo.y = cvt_pk(bflo(vv.y) * skv, bfhi(vv.y) * skv);
            *(u32x2*)(vbuf + tl * 256 + h * 64 + 4 * j) = vo;
        }
    }
    __syncthreads();
    {
        const int tid = tidx(), b = (item * 64) / SEQ, s0 = (item * 64) % SEQ, hh = tid >> 6, e = tid & 63;
        bf16_t* dst = MVT + ((size_t)(b * 4 + hh) * 64 + e) * SEQ + s0;
#pragma unroll
        for (int c8 = 0; c8 < 8; ++c8) {
            unsigned wds[4];
#pragma unroll
            for (int k = 0; k < 4; ++k) wds[k] = (unsigned)vbuf[(c8 * 8 + 2 * k) * 256 + tid] | ((unsigned)vbuf[(c8 * 8 + 2 * k + 1) * 256 + tid] << 16);
            uint4 o; o.x = wds[0]; o.y = wds[1]; o.z = wds[2]; o.w = wds[3];
            *(uint4*)(dst + c8 * 8) = o;
        }
    }
    __syncthreads();
}

DI void memkv_finish_tile(const Params& p, int item, unsigned char* smem) {
    const bf16_t* KVM = (const bf16_t*)(p.ws + OFF_KVMEM);
    bf16_t* XK = (bf16_t*)(p.ws + OFF_XK);
    bf16_t* XVT = (bf16_t*)(p.ws + OFF_XVT);
    bf16_t* vbuf = (bf16_t*)smem;
    const int l = item >> 5, b = (item >> 2) & 7, h = item & 3;
    const int w = tidx() >> 6, lane = tidx() & 63;
    const float kg = p.in[I_XKNG][l * 64 + lane];
    for (int r = 0; r < 64; ++r) {
        const int m = w * 64 + r;
        const bf16_t* src = KVM + ((size_t)l * 2048 + b * 256 + m) * 512 + h * 128;
        const float k = bf2f(src[lane]);
        const float rn = __builtin_amdgcn_rsqf(wave_sum(k * k) * (1.f / 64.f) + EPS);
        XK[(((size_t)(l * 8 + b) * 4 + h) * 256 + m) * 64 + lane] = f2bf(k * rn * kg);
        vbuf[m * 64 + lane] = src[64 + lane];
    }
    __syncthreads();
    {
        const int tid = tidx(), e = tid & 63, mq = tid >> 6;
        bf16_t* dst = XVT + (((size_t)(l * 8 + b) * 4 + h) * 64 + e) * 256 + mq * 64;
#pragma unroll
        for (int c8 = 0; c8 < 8; ++c8) {
            unsigned wds[4];
#pragma unroll
            for (int k = 0; k < 4; ++k) wds[k] = (unsigned)vbuf[(mq * 64 + c8 * 8 + 2 * k) * 64 + e] | ((unsigned)vbuf[(mq * 64 + c8 * 8 + 2 * k + 1) * 64 + e] << 16);
            uint4 o; o.x = wds[0]; o.y = wds[1]; o.z = wds[2]; o.w = wds[3];
            *(uint4*)(dst + c8 * 8) = o;
        }
    }
    __syncthreads();
}

template <int DQK, bool QNORM>
DI void attn_tile(const bf16_t* __restrict__ Q, int qs, const bf16_t* __restrict__ Kp, int kstr, const bf16_t* __restrict__ Vt, int vstr, int nkeys,
                  float c2, float mbound, const float* __restrict__ qgain, bf16_t* __restrict__ O, int os, float* __restrict__ ssq, int ssq_stride, unsigned char* smem) {
    constexpr int NKS = DQK / 32, KP = DQK * 2 + 16, KCH = DQK / 8, KB = 64 * KP, VB = 64 * 144, STG = KB + VB, NKL = (64 * KCH) / 256;
    const int tid = tidx(), w = tid >> 6, lane = tid & 63, l15 = lane & 15, quad = lane >> 4;
    bf16x8 bq[2][NKS];
#pragma unroll
    for (int qt = 0; qt < 2; ++qt) {
        const bf16_t* qp = Q + (size_t)(w * 32 + qt * 16 + l15) * qs + quad * 8;
        if (QNORM) {
            float v[NKS][8]; float ss = 0.f;
#pragma unroll
            for (int ks = 0; ks < NKS; ++ks) {
                const uint4 x = *(const uint4*)(qp + ks * 32);
                v[ks][0] = bflo(x.x); v[ks][1] = bfhi(x.x); v[ks][2] = bflo(x.y); v[ks][3] = bfhi(x.y); v[ks][4] = bflo(x.z); v[ks][5] = bfhi(x.z); v[ks][6] = bflo(x.w); v[ks][7] = bfhi(x.w);
#pragma unroll
                for (int j = 0; j < 8; ++j) ss += v[ks][j] * v[ks][j];
            }
            ss += __shfl_xor(ss, 16); ss += __shfl_xor(ss, 32);
            const float rn = __builtin_amdgcn_rsqf(ss * (1.f / DQK) + EPS);
#pragma unroll
            for (int ks = 0; ks < NKS; ++ks) {
                const float* gp = qgain + ks * 32 + quad * 8;
                u32x4 o;
                o.x = cvt_pk(v[ks][0] * rn * gp[0], v[ks][1] * rn * gp[1]); o.y = cvt_pk(v[ks][2] * rn * gp[2], v[ks][3] * rn * gp[3]);
                o.z = cvt_pk(v[ks][4] * rn * gp[4], v[ks][5] * rn * gp[5]); o.w = cvt_pk(v[ks][6] * rn * gp[6], v[ks][7] * rn * gp[7]);
                bq[qt][ks] = __builtin_bit_cast(bf16x8, o);
            }
        } else {
#pragma unroll
            for (int ks = 0; ks < NKS; ++ks) bq[qt][ks] = *(const bf16x8*)(qp + ks * 32);
        }
    }
    f32x4 o[4][2];
    float lrun[2];
#pragma unroll
    for (int qt = 0; qt < 2; ++qt) {
        lrun[qt] = 0.f;
#pragma unroll
        for (int et = 0; et < 4; ++et) o[et][qt] = (f32x4){0.f, 0.f, 0.f, 0.f};
    }
    uint4 ak0, ak1, ak2, av0, av1, bk0, bk1, bk2, bv0, bv1;
    ak2 = make_uint4(0u, 0u, 0u, 0u); bk2 = ak2;
    const int kr0 = tid / KCH, kc0 = tid % KCH, kr1 = (tid + 256) / KCH, kc1 = (tid + 256) % KCH, kr2 = (tid + 512) / KCH, kc2 = (tid + 512) % KCH;
    const int vr0 = tid >> 3, vc0 = tid & 7, vr1 = vr0 + 32;
#define A_LOAD(S, key0) do { S##k0 = *(const uint4*)(Kp + (size_t)((key0) + kr0) * kstr + kc0 * 8); S##k1 = *(const uint4*)(Kp + (size_t)((key0) + kr1) * kstr + kc1 * 8); \
                          if (NKL > 2) S##k2 = *(const uint4*)(Kp + (size_t)((key0) + kr2) * kstr + kc2 * 8); \
                          S##v0 = *(const uint4*)(Vt + (size_t)vr0 * vstr + (key0) + vc0 * 8); S##v1 = *(const uint4*)(Vt + (size_t)vr1 * vstr + (key0) + vc0 * 8); } while (0)
#define A_STORE(S, buf) do { unsigned char* kb_ = smem + (buf) * STG; unsigned char* vb_ = kb_ + KB; \
                          *(uint4*)(kb_ + kr0 * KP + kc0 * 16) = S##k0; *(uint4*)(kb_ + kr1 * KP + kc1 * 16) = S##k1; if (NKL > 2) *(uint4*)(kb_ + kr2 * KP + kc2 * 16) = S##k2; \
                          *(uint4*)(vb_ + vr0 * 144 + vc0 * 16) = S##v0; *(uint4*)(vb_ + vr1 * 144 + vc0 * 16) = S##v1; } while (0)
    const int nkb = nkeys >> 6;
    A_LOAD(a, 0); A_STORE(a, 0);
    A_LOAD(b, 64);
    if (2 < nkb) A_LOAD(a, 128);
    __syncthreads();
#define A_COMPUTE(cur) do { \
        const unsigned char* kb = smem + cur * STG; const unsigned char* vb = kb + KB; \
        f32x4 s[4][2]; \
_Pragma("unroll")         for (int kt = 0; kt < 4; ++kt) { s[kt][0] = (f32x4){0.f, 0.f, 0.f, 0.f}; s[kt][1] = (f32x4){0.f, 0.f, 0.f, 0.f}; } \
_Pragma("unroll")         for (int ks = 0; ks < NKS; ++ks) { \
            bf16x8 ak[4]; \
_Pragma("unroll")             for (int kt = 0; kt < 4; ++kt) ak[kt] = *(const bf16x8*)(kb + (kt * 16 + l15) * KP + ks * 64 + quad * 16); \
_Pragma("unroll")             for (int kt = 0; kt < 4; ++kt) { s[kt][0] = MFMA16(ak[kt], bq[0][ks], s[kt][0]); s[kt][1] = MFMA16(ak[kt], bq[1][ks], s[kt][1]); } \
        } \
        bf16x8 pb[2][2]; \
_Pragma("unroll")         for (int qt = 0; qt < 2; ++qt) { \
            float ls = 0.f; \
            float pv[4][4]; \
_Pragma("unroll")             for (int kt = 0; kt < 4; ++kt) \
_Pragma("unroll")                 for (int r = 0; r < 4; ++r) { pv[kt][r] = __builtin_amdgcn_exp2f(s[kt][qt][r] * c2 - mbound); ls += pv[kt][r]; } \
            lrun[qt] += ls; \
_Pragma("unroll")             for (int k2 = 0; k2 < 2; ++k2) { \
                u32x4 pw; pw.x = cvt_pk(pv[2 * k2][0], pv[2 * k2][1]); pw.y = cvt_pk(pv[2 * k2][2], pv[2 * k2][3]); \
                pw.z = cvt_pk(pv[2 * k2 + 1][0], pv[2 * k2 + 1][1]); pw.w = cvt_pk(pv[2 * k2 + 1][2], pv[2 * k2 + 1][3]); \
                pb[qt][k2] = __builtin_bit_cast(bf16x8, pw); \
            } \
        } \
_Pragma("unroll")         for (int k2 = 0; k2 < 2; ++k2) \
_Pragma("unroll")             for (int et = 0; et < 4; ++et) { \
                const unsigned char* vp = vb + (et * 16 + l15) * 144 + k2 * 64 + quad * 8; \
                const u32x2 lo = *(const u32x2*)vp, hi = *(const u32x2*)(vp + 32); \
                u32x4 a; a.x = lo.x; a.y = lo.y; a.z = hi.x; a.w = hi.y; \
                const bf16x8 av = __builtin_bit_cast(bf16x8, a); \
                o[et][0] = MFMA16(av, pb[0][k2], o[et][0]); \
                o[et][1] = MFMA16(av, pb[1][k2], o[et][1]); \
            } \
    } while (0)
#pragma unroll 1
    for (int jb = 0; jb < nkb; jb += 2) {
        A_STORE(b, 1);
        if (jb + 3 < nkb) A_LOAD(b, (jb + 3) * 64);
        __builtin_amdgcn_sched_barrier(0);
        A_COMPUTE(0);
        __syncthreads();
        if (jb + 2 < nkb) A_STORE(a, 0);
        if (jb + 4 < nkb) A_LOAD(a, (jb + 4) * 64);
        __builtin_amdgcn_sched_barrier(0);
        A_COMPUTE(1);
        __syncthreads();
    }
#undef A_COMPUTE
#undef A_LOAD
#undef A_STORE
#pragma unroll
    for (int qt = 0; qt < 2; ++qt) {
        float lt = lrun[qt]; lt += __shfl_xor(lt, 16); lt += __shfl_xor(lt, 32);
        const float inv = 1.f / lt;
        const int q = w * 32 + qt * 16 + l15;
        float ss = 0.f;
#pragma unroll
        for (int et = 0; et < 4; ++et) {
            const float y0 = o[et][qt][0] * inv, y1 = o[et][qt][1] * inv, y2 = o[et][qt][2] * inv, y3 = o[et][qt][3] * inv;
            ss += y0 * y0 + y1 * y1 + y2 * y2 + y3 * y3;
            u32x2 ov; ov.x = cvt_pk(y0, y1); ov.y = cvt_pk(y2, y3);
            *(u32x2*)(O + (size_t)q * os + et * 16 + quad * 4) = ov;
        }
        if (ssq) { ss += __shfl_xor(ss, 16); ss += __shfl_xor(ss, 32); if (quad == 0) ssq[(size_t)q * ssq_stride] = ss; }
    }
}

namespace pg8 {
#define PG8_LAS __attribute__((address_space(3)))
constexpr int BM = 256, BK = 64, HALF = 128, HTB = HALF * BK * 2, STAGE_BYTES = 8 * HTB, NXCD = 8, WGM = 8;
DI int lds_byte(int r, int c) { const int st = (r >> 4) * 2 + (c >> 5), rr = r & 15, cc = c & 31, ob = rr * 64 + cc * 2; return st * 1024 + (ob ^ (((ob >> 9) & 1) << 5)); }
DI void stage_rc(int b, int& R, int& C) { const int st = b / 1024, sb = b % 1024, swz = sb ^ (((sb >> 9) & 1) << 5); R = (st >> 1) * 16 + swz / 64; C = (st & 1) * 32 + (swz % 64) / 2; }
struct Unit { int pm, pn; };
struct Gemm { const bf16_t* A; const bf16_t* Bt; int M, N, K; };
struct StaticOrder {
    int nM, nN, nwg, G, c;
    DI void init(int M, int N, int G_, int c_) { nM = M / BM; nN = N / BM; nwg = nM * nN; G = G_; c = c_; }
    DI bool next(int i, Unit& u) const {
        const long L = (long)i * G + c; if (L >= nwg) return false;
        int wgid = (int)L; { const int q = nwg / NXCD, r = nwg % NXCD, xcd = wgid % NXCD, off = wgid / NXCD; wgid = (xcd < r ? xcd * (q + 1) : r * (q + 1) + (xcd - r) * q) + off; }
        const int nig = WGM * nN, gid = wgid / nig, fm = gid * WGM, gsz = (nM - fm) < WGM ? (nM - fm) : WGM;
        u.pm = fm + ((wgid % nig) % gsz); u.pn = (wgid % nig) / gsz; return true;
    }
};
DI float row_rstd(const float* part, int row) {
    const float4* p4 = (const float4*)(part + (size_t)row * 16);
    const float4 a = p4[0], b = p4[1], c = p4[2], d = p4[3];
    const float s = (a.x + a.y + a.z + a.w) + (b.x + b.y + b.z + b.w) + (c.x + c.y + c.z + c.w) + (d.x + d.y + d.z + d.w);
    return __builtin_amdgcn_rsqf(s * (1.f / DM) + EPS);
}
struct EpiScaled {
    bf16_t* O; int ldo; const float* part;
    DI void operator()(const f32x4 (&acc)[2][2][4][2], const Unit& u, int wr, int wc, int fr, int fq) const {
#pragma unroll
        for (int ai = 0; ai < 2; ++ai)
#pragma unroll
            for (int m = 0; m < 4; ++m) {
                const int row = u.pm * BM + ai * HALF + wr * 64 + m * 16 + fr;
                const float sc = row_rstd(part, row);
                bf16_t* rowp = O + (size_t)row * ldo + u.pn * BM + wc * 32 + fq * 4;
#pragma unroll
                for (int bj = 0; bj < 2; ++bj)
#pragma unroll
                    for (int n = 0; n < 2; ++n) {
                        u32x2 v; v.x = cvt_pk(acc[ai][bj][m][n][0] * sc, acc[ai][bj][m][n][1] * sc); v.y = cvt_pk(acc[ai][bj][m][n][2] * sc, acc[ai][bj][m][n][3] * sc);
                        *(u32x2*)(rowp + bj * HALF + n * 16) = v;
                    }
            }
    }
};
struct EpiSwiglu {
    bf16_t* H; const float* part;
    DI void operator()(const f32x4 (&acc)[2][2][4][2], const Unit& u, int wr, int wc, int fr, int fq) const {
#pragma unroll
        for (int ai = 0; ai < 2; ++ai)
#pragma unroll
            for (int m = 0; m < 4; ++m) {
                const int row = u.pm * BM + ai * HALF + wr * 64 + m * 16 + fr;
                const float sc = row_rstd(part, row);
                bf16_t* rowp = H + (size_t)row * DFF + ((u.pn * BM + wc * 32) >> 1) + fq * 4;
#pragma unroll
                for (int bj = 0; bj < 2; ++bj) {
                    float h[4];
#pragma unroll
                    for (int j = 0; j < 4; ++j) { const float a1 = acc[ai][bj][m][0][j] * sc, a3 = acc[ai][bj][m][1][j] * sc; h[j] = a1 * sigmoidf_(a1) * a3; }
                    u32x2 v; v.x = cvt_pk(h[0], h[1]); v.y = cvt_pk(h[2], h[3]);
                    *(u32x2*)(rowp + bj * (HALF / 2)) = v;
                }
            }
    }
};
struct EpiResid {
    float* X; bf16_t* XB; float* rowsq;
    DI void operator()(const f32x4 (&acc)[2][2][4][2], const Unit& u, int wr, int wc, int fr, int fq) const {
#pragma unroll
        for (int ai = 0; ai < 2; ++ai)
#pragma unroll
            for (int m = 0; m < 4; ++m) {
                const int row = u.pm * BM + ai * HALF + wr * 64 + m * 16 + fr;
                float ss = 0.f;
#pragma unroll
                for (int bj = 0; bj < 2; ++bj)
#pragma unroll
                    for (int n = 0; n < 2; ++n) {
                        const int col = u.pn * BM + bj * HALF + wc * 32 + n * 16 + fq * 4;
                        float4* xp = (float4*)(X + (size_t)row * DM + col);
                        float4 xv = *xp;
                        xv.x += acc[ai][bj][m][n][0]; xv.y += acc[ai][bj][m][n][1]; xv.z += acc[ai][bj][m][n][2]; xv.w += acc[ai][bj][m][n][3];
                        *xp = xv;
                        u32x2 v; v.x = cvt_pk(xv.x, xv.y); v.y = cvt_pk(xv.z, xv.w);
                        *(u32x2*)(XB + (size_t)row * DM + col) = v;
                        ss += xv.x * xv.x + xv.y * xv.y + xv.z * xv.z + xv.w * xv.w;
                    }
                ss += __shfl_xor(ss, 16); ss += __shfl_xor(ss, 32);
                if (fq == 0) rowsq[(size_t)row * 16 + u.pn * 4 + wc] = ss;
            }
    }
};

template <class Epi, bool SCALED = false>
DI void gemm_phase(PG8_LAS unsigned char* lds, const Gemm g, const StaticOrder& S, const Epi& E, const float* ssq0 = nullptr, const float* ssq1 = nullptr) {
    int tid = threadIdx.x; asm volatile("" : "+v"(tid));
    const int wid = __builtin_amdgcn_readfirstlane(tid >> 6), lane = tid & 63, wr = wid >> 2, wc = wid & 3, fr = lane & 15, fq = lane >> 4;
    const int K = g.K, nt = K / BK;
    unsigned voffA[2];
#pragma unroll
    for (int i = 0; i < 2; ++i) { int R, C; stage_rc(tid * 16 + i * 8192, R, C); voffA[i] = (unsigned)(R * K + C) * 2u; }
    const size_t kstep = (size_t)(BK * 2);
    const size_t hstep = (size_t)HALF * K * 2;
    const size_t tstep = 2 * hstep;
    const unsigned ldsw = (unsigned)wid * 1024u;
    const int aoff = lds_byte(wr * 64 + fr, fq * 8), boff = lds_byte(wc * 32 + fr, fq * 8);
#define PG8_SA(b, h) (((b) * 2 + (h)) * HTB)
#define PG8_SB(b, h) ((4 + (b) * 2 + (h)) * HTB)
#define PG8_STAGE(bufoff, gbase) do { _Pragma("unroll") for (int _i = 0; _i < 2; ++_i) \
        __builtin_amdgcn_global_load_lds((const unsigned*)((const char*)(gbase) + voffA[_i]), (PG8_LAS unsigned*)(lds + (bufoff) + ldsw + _i * 8192), 16, 0, 0); } while (0)
#define PG8_LDA(dst, b, h) do { _Pragma("unroll") for (int m = 0; m < 4; ++m) _Pragma("unroll") for (int k = 0; k < 2; ++k) dst[m][k] = *(const PG8_LAS bf16x8*)(lds + PG8_SA(b, h) + aoff + m * 2048 + k * 1024); } while (0)
#define PG8_LDB(dst, b, h) do { _Pragma("unroll") for (int n = 0; n < 2; ++n) _Pragma("unroll") for (int k = 0; k < 2; ++k) dst[n][k] = *(const PG8_LAS bf16x8*)(lds + PG8_SB(b, h) + boff + n * 2048 + k * 1024); } while (0)
#define PG8_MMA(ai, bj, At, Bt) do { __builtin_amdgcn_s_setprio(1); _Pragma("unroll") for (int m = 0; m < 4; ++m) _Pragma("unroll") for (int n = 0; n < 2; ++n) _Pragma("unroll") for (int k = 0; k < 2; ++k) \
        acc[ai][bj][m][n] = __builtin_amdgcn_mfma_f32_16x16x32_bf16(Bt[n][k], At[m][k], acc[ai][bj][m][n], 0, 0, 0); __builtin_amdgcn_s_setprio(0); } while (0)
#define PG8_WAIT_V(n) asm volatile("s_waitcnt vmcnt(" #n ")" ::: "memory")
#define PG8_WAIT_L(n) asm volatile("s_waitcnt lgkmcnt(" #n ")" ::: "memory")
#define PG8_BAR __builtin_amdgcn_s_barrier()
#define PG8_SCHED __builtin_amdgcn_sched_barrier(0)
    Unit cur, nxt; int ui = 0;
    if (!S.next(0, cur)) return;
    f32x4 acc[2][2][4][2];
#pragma unroll
    for (int a = 0; a < 2; ++a)
#pragma unroll
        for (int b = 0; b < 2; ++b)
#pragma unroll
            for (int m = 0; m < 4; ++m)
#pragma unroll
                for (int n = 0; n < 2; ++n) acc[a][b][m][n] = (f32x4){0.f, 0.f, 0.f, 0.f};
    bf16x8 At[4][2], B0[2][2], B1[2][2];
    const char* cA = (const char*)g.A + (size_t)cur.pm * tstep; const char* cB = (const char*)g.Bt + (size_t)cur.pn * tstep;
#define PG8_FTAB(unit) do { if (SCALED && tid < 256) { const int row_ = (unit).pm * BM + tid; \
        const float4 sb_ = *(const float4*)(ssq0 + (size_t)row_ * 4), sd_ = *(const float4*)(ssq1 + (size_t)row_ * 4); \
        const float rB_ = __builtin_amdgcn_rsqf((sb_.x + sb_.y + sb_.z + sb_.w) * (1.f / 256.f) + EPS), rD_ = __builtin_amdgcn_rsqf((sd_.x + sd_.y + sd_.z + sd_.w) * (1.f / 256.f) + EPS); \
        PG8_LAS float* ft_ = (PG8_LAS float*)(lds + STAGE_BYTES); ft_[tid] = rB_ / rD_; ft_[256 + tid] = rD_; } } while (0)
    PG8_FTAB(cur);
    PG8_STAGE(PG8_SB(0, 0), cB); PG8_STAGE(PG8_SB(0, 1), cB + hstep); PG8_STAGE(PG8_SA(0, 0), cA); PG8_STAGE(PG8_SA(0, 1), cA + hstep);
    if (wr == 1) PG8_BAR;
    PG8_WAIT_V(2); PG8_BAR;
    PG8_STAGE(PG8_SB(1, 0), cB + kstep); PG8_STAGE(PG8_SA(1, 0), cA + kstep); PG8_STAGE(PG8_SB(1, 1), cB + hstep + kstep);
    PG8_WAIT_V(6); PG8_BAR;
    for (;;) {
        const bool has_next = S.next(ui + 1, nxt);
        const char* nA = has_next ? (const char*)g.A + (size_t)nxt.pm * tstep : cA; const char* nB = has_next ? (const char*)g.Bt + (size_t)nxt.pn * tstep : cB;
        for (int t = 0; t < nt; t += 2) {
            const bool last = (t == nt - 2);
            const char* a1 = cA + (size_t)(t + 1) * kstep;
            const char* a2 = last ? nA : cA + (size_t)(t + 2) * kstep; const char* b2 = last ? nB : cB + (size_t)(t + 2) * kstep;
            const char* a3 = a2 + kstep; const char* b3 = b2 + kstep;
            if (SCALED && (t == 4 || t == 8)) {
                const PG8_LAS float* ft = (const PG8_LAS float*)(lds + STAGE_BYTES) + (t == 8 ? 256 : 0);
#pragma unroll
                for (int ai = 0; ai < 2; ++ai)
#pragma unroll
                    for (int m = 0; m < 4; ++m) {
                        const float f = ft[ai * HALF + wr * 64 + m * 16 + fr];
#pragma unroll
                        for (int bj = 0; bj < 2; ++bj)
#pragma unroll
                            for (int n = 0; n < 2; ++n) acc[ai][bj][m][n] *= f;
                    }
            }
            PG8_LDB(B0, 0, 0); PG8_LDB(B1, 0, 1); PG8_SCHED; PG8_LDA(At, 0, 0); PG8_STAGE(PG8_SA(1, 1), a1 + hstep);
            PG8_WAIT_V(8); PG8_WAIT_L(0); PG8_BAR; PG8_MMA(0, 0, At, B0); PG8_MMA(0, 1, At, B1); PG8_BAR; PG8_SCHED;
            PG8_LDA(At, 0, 1); PG8_STAGE(PG8_SB(0, 0), b2); PG8_STAGE(PG8_SB(0, 1), b2 + hstep); PG8_STAGE(PG8_SA(0, 0), a2);
            PG8_WAIT_V(8); PG8_WAIT_L(0); PG8_BAR; PG8_MMA(1, 0, At, B0); PG8_MMA(1, 1, At, B1); PG8_BAR; PG8_SCHED;
            PG8_LDB(B0, 1, 0); PG8_LDB(B1, 1, 1); PG8_SCHED; PG8_LDA(At, 1, 0); PG8_STAGE(PG8_SA(0, 1), a2 + hstep);
            PG8_WAIT_V(8); PG8_WAIT_L(0); PG8_BAR; PG8_MMA(0, 0, At, B0); PG8_MMA(0, 1, At, B1); PG8_BAR; PG8_SCHED;
            PG8_LDA(At, 1, 1); PG8_STAGE(PG8_SB(1, 0), b3); PG8_STAGE(PG8_SB(1, 1), b3 + hstep); PG8_STAGE(PG8_SA(1, 0), a3);
            PG8_WAIT_V(8); PG8_WAIT_L(0); PG8_BAR; PG8_MMA(1, 0, At, B0); PG8_MMA(1, 1, At, B1); PG8_BAR; PG8_SCHED;
        }
        if (wr == 0) PG8_BAR;
        E(acc, cur, wr, wc, fr, fq);
        if (!has_next) break;
#pragma unroll
        for (int a = 0; a < 2; ++a)
#pragma unroll
            for (int b = 0; b < 2; ++b)
#pragma unroll
                for (int m = 0; m < 4; ++m)
#pragma unroll
                    for (int n = 0; n < 2; ++n) acc[a][b][m][n] = (f32x4){0.f, 0.f, 0.f, 0.f};
        cur = nxt; cA = nA; cB = nB; ++ui;
        if (wr == 1) PG8_BAR;
        PG8_FTAB(cur);
    }
    PG8_WAIT_V(0);
    PG8_BAR;
#undef PG8_FTAB
#undef PG8_SA
#undef PG8_SB
#undef PG8_STAGE
#undef PG8_LDA
#undef PG8_LDB
#undef PG8_MMA
#undef PG8_WAIT_V
#undef PG8_WAIT_L
#undef PG8_BAR
#undef PG8_SCHED
}
}

enum { PH_PRO = 0, PH_CONV, PH_P1, PH_P2, PH_P3, PH_P4, PH_P5, PH_P6, PH_P7, PH_P8, PH_P9, PH_P10, PH_COUNT };

DI void gemm_item_bf16(const bf16_t* A, int lda, const bf16_t* Bt, int K, int nM, int nN, int L, bf16_t* O, int ldo, const float* part, int npart, float inv_n, unsigned char* smem) {
    int pm, pn; tile_order(L, nM, nN, pm, pn);
    if (part) fill_rs(smem, part, npart, pm * 128, inv_n);
    f32x4 acc[4][4];
    gemm_mainloop<false>(A, lda, Bt, K, pm * 128, pn * 128, smem, acc);
    epi_bf16(acc, O, ldo, pm * 128, pn * 128, part ? (const float*)(smem + 65536) : nullptr);
    __syncthreads();
}
template <bool ASC>
DI void gemm_item_resid(const Params& p, const bf16_t* A, int lda, const bf16_t* Bt, int K, int L, unsigned char* smem) {
    int pm, pn; tile_order(L, 256, 8, pm, pn);
    if (ASC) {
        float* asc = (float*)(smem + 66048);
        const float* sb = (const float*)(p.ws + OFF_SSQB); const float* sd = (const float*)(p.ws + OFF_SSQD);
        const int tid = tidx();
        if (tid < 128) {
            const float4 a = *(const float4*)(sb + (size_t)(pm * 128 + tid) * 4), d = *(const float4*)(sd + (size_t)(pm * 128 + tid) * 4);
            asc[tid * 2] = __builtin_amdgcn_rsqf((a.x + a.y + a.z + a.w) * (1.f / 256.f) + EPS);
            asc[tid * 2 + 1] = __builtin_amdgcn_rsqf((d.x + d.y + d.z + d.w) * (1.f / 256.f) + EPS);
        }
    }
    f32x4 acc[4][4];
    gemm_mainloop<ASC>(A, lda, Bt, K, pm * 128, pn * 128, smem, acc);
    epi_resid(acc, p.out, (bf16_t*)(p.ws + OFF_XB), (float*)(p.ws + OFF_ROWSQ), pm * 128, pn * 128);
    __syncthreads();
}

DI void run_phase(const Params& p, int ph, int l, unsigned char* smem0) {
    const int vb = __builtin_amdgcn_readfirstlane((int)(threadIdx.x >> 8));
    unsigned char* smem = smem0 + vb * LDS_BYTES;
    const int G = gridDim.x * 2, bid = blockIdx.x * 2 + vb;
    const bf16_t* W = (const bf16_t*)(p.ws + OFF_W);
    const bf16_t* XB = (const bf16_t*)(p.ws + OFF_XB);
    bf16_t* U = (bf16_t*)(p.ws + OFF_U);
    const float* ROWSQ = (const float*)(p.ws + OFF_ROWSQ);
#ifdef ONLY_PH
    if (ph != ONLY_PH) return;
#endif
    switch (ph) {
    case PH_PRO: {
        for (int i = bid; i < 2048; i += G) pro_rows(p.in[I_X], p.out, (bf16_t*)(p.ws + OFF_XB), (float*)(p.ws + OFF_ROWSQ), 16, i);
        for (int i = bid; i < 128; i += G) pro_rows(p.in[I_MEM], nullptr, (bf16_t*)(p.ws + OFF_MEMB), (float*)(p.ws + OFF_MEMSQ), 1, i);
        for (int i = bid; i < 128; i += G) pro_rope(p, i);
        for (int i = bid; i < 512; i += G) { const int ll = i >> 7; conv_tile(p.in[I_XWKV] + (size_t)ll * DM * 512, DM, 512, 512, p.in[I_GMEM] + ll * DM, 0, (bf16_t*)(p.ws + OFF_XWKV) + (size_t)ll * 512 * DM, i & 127, smem); }
        for (int i = bid; i < CONV_TILES; i += G) conv_layer_item(p, 0, i, smem);
    } break;
    case PH_CONV: {
        for (int it = bid; it < CONV_TILES; it += G) conv_layer_item(p, l, it, smem);
    } break;
    case PH_P1: {
        { pg8::Gemm g{XB, W + W_IN, T_TOK, UC, DM}; pg8::StaticOrder S; S.init(T_TOK, UC, gridDim.x, blockIdx.x);
          pg8::EpiScaled E{U, UC, ROWSQ};
          pg8::gemm_phase<pg8::EpiScaled>((PG8_LAS unsigned char*)smem0, g, S, E); }
        if (l == 0) {
            for (int i = bid; i < 256; i += G) {
                const int ll = i >> 6;
                gemm_item_bf16((const bf16_t*)(p.ws + OFF_MEMB), DM, (const bf16_t*)(p.ws + OFF_XWKV) + (size_t)ll * 512 * DM, DM, 16, 4, i & 63,
                               (bf16_t*)(p.ws + OFF_KVMEM) + (size_t)ll * 2048 * 512, 512, (const float*)(p.ws + OFF_MEMSQ), 1, 1.f / DM, smem);
            }
        }
    } break;
    case PH_P2: {
        for (int i = bid; i < 1024; i += G) hgrn_local_tile(p, l, i, smem);
#ifdef RP2_HL
        for (int i = bid; i < 1024; i += G) hgrn_local_tile(p, l, i, smem);
#endif
        for (int i = bid; i < 1024; i += G) conformer_tile(p, l, i, smem);
#ifdef RP2_CF
        for (int i = bid; i < 1024; i += G) conformer_tile(p, l, i, smem);
#endif
#ifdef RP2_G
        for (int i = bid; i < 768; i += G) gemm_item_bf16(U + 2560, UC, W + W_UQ, 256, 256, 3, i, (bf16_t*)(p.ws + OFF_QRAW), 384, nullptr, 0, 0.f, smem);
        for (int i = bid; i < 1024; i += G) gemm_item_bf16(U + 2816, UC, W + W_UKV, 128, 256, 4, i, (bf16_t*)(p.ws + OFF_KVRAW), 512, nullptr, 0, 0.f, smem);
#endif
#ifdef RP2_SC
        for (int i = bid; i < 512; i += G) shortconv_tile(p, l, i);
#endif
        for (int i = bid; i < 768; i += G) gemm_item_bf16(U + 2560, UC, W + W_UQ, 256, 256, 3, i, (bf16_t*)(p.ws + OFF_QRAW), 384, nullptr, 0, 0.f, smem);
        for (int i = bid; i < 1024; i += G) gemm_item_bf16(U + 2816, UC, W + W_UKV, 128, 256, 4, i, (bf16_t*)(p.ws + OFF_KVRAW), 512, nullptr, 0, 0.f, smem);
        for (int i = bid; i < 512; i += G) shortconv_tile(p, l, i);
        if (l == 0) { for (int i = bid; i < 128; i += G) memkv_finish_tile(p, i, smem); }
    } break;
    case PH_P3: {
        for (int i = bid; i < 512; i += G) hgrn_scan_item(p, i);
        for (int i = bid; i < 512; i += G) mla_finish_tile(p, l, i, smem);
#ifdef RP3_MF
        for (int i = bid; i < 512; i += G) mla_finish_tile(p, l, i, smem);
#endif
    } break;
    case PH_P4: {
        const float c2 = 0.10206207261596575f * 1.4426950408889634f;
        float mb;
        {
            const int ln = tidx() & 63;
            float gq = fmaxf(fabsf(p.in[I_MQNG][l * 96 + ln]), ln < 32 ? fabsf(p.in[I_MQNG][l * 96 + 64 + ln]) : 0.f);
            float gk = fmaxf(fabsf(p.in[I_MKNG][l * 96 + ln]), ln < 32 ? fabsf(p.in[I_MKNG][l * 96 + 64 + ln]) : 0.f);
#pragma unroll
            for (int o = 32; o > 0; o >>= 1) { gq = fmaxf(gq, __shfl_xor(gq, o)); gk = fmaxf(gk, __shfl_xor(gk, o)); }
            mb = 96.f * gq * gk * c2;
        }
        for (int it0 = bid; it0 < 1024; it0 += G) {
            const int xcd = blockIdx.x & 7, jx = ((blockIdx.x >> 3) << 1) + vb, loc = (it0 / G) * 64 + jx;
            const int it = (G == 512) ? (xcd * 128 + loc) : it0;
            const int bh = it >> 5, qt = it & 31, b = bh >> 2, h = bh & 3;
            const size_t tok0 = (size_t)b * SEQ + qt * 128;
            attn_tile<96, false>((const bf16_t*)(p.ws + OFF_MQ) + tok0 * 384 + h * 96, 384, (const bf16_t*)(p.ws + OFF_MK) + (size_t)b * SEQ * 384 + h * 96, 384,
                                 (const bf16_t*)(p.ws + OFF_MVT) + (size_t)bh * 64 * SEQ, SEQ, SEQ, c2, mb, nullptr,
                                 (bf16_t*)(p.ws + OFF_CAT) + tok0 * DM + 256 + h * 64, DM, (float*)(p.ws + OFF_SSQD) + tok0 * 4 + h, 4, smem);
        }
        for (int i = bid; i < 2048; i += G) hgrn_out_tile(p, l, i, smem);
#ifdef REPEAT_HGOUT
        for (int i = bid; i < 2048; i += G) hgrn_out_tile(p, l, i, smem);
#endif
    } break;
    case PH_P5: {
        pg8::Gemm g{(const bf16_t*)(p.ws + OFF_CAT), W + W_OUT, T_TOK, DM, DM}; pg8::StaticOrder S; S.init(T_TOK, DM, gridDim.x, blockIdx.x);
        pg8::EpiResid E{p.out, (bf16_t*)(p.ws + OFF_XB), (float*)(p.ws + OFF_ROWSQ)};
        pg8::gemm_phase<pg8::EpiResid, true>((PG8_LAS unsigned char*)smem0, g, S, E, (const float*)(p.ws + OFF_SSQB), (const float*)(p.ws + OFF_SSQD));
    } break;
    case PH_P6: {
        for (int it = bid; it < 512; it += G) gemm_item_bf16(XB, DM, W + W_XQ, DM, 256, 2, it, (bf16_t*)(p.ws + OFF_XQ), 256, ROWSQ, 16, 1.f / DM, smem);
    } break;
    case PH_P7: {
        const float c2 = 0.125f * 1.4426950408889634f;
        float mb;
        {
            const int ln = tidx() & 63;
            float gq = fabsf(p.in[I_XQNG][l * 64 + ln]), gk = fabsf(p.in[I_XKNG][l * 64 + ln]);
#pragma unroll
            for (int o = 32; o > 0; o >>= 1) { gq = fmaxf(gq, __shfl_xor(gq, o)); gk = fmaxf(gk, __shfl_xor(gk, o)); }
            mb = 64.f * gq * gk * c2;
        }
        for (int it0 = bid; it0 < 1024; it0 += G) {
            const int xcd = blockIdx.x & 7, jx = ((blockIdx.x >> 3) << 1) + vb, loc = (it0 / G) * 64 + jx;
            const int it = (G == 512) ? (xcd * 128 + loc) : it0;
            const int bh = it >> 5, qt = it & 31, b = bh >> 2, h = bh & 3;
            const size_t tok0 = (size_t)b * SEQ + qt * 128;
            attn_tile<64, true>((const bf16_t*)(p.ws + OFF_XQ) + tok0 * 256 + h * 64, 256, (const bf16_t*)(p.ws + OFF_XK) + ((size_t)(l * 8 + b) * 4 + h) * 256 * 64, 64,
                                (const bf16_t*)(p.ws + OFF_XVT) + ((size_t)(l * 8 + b) * 4 + h) * 64 * 256, 256, 256, c2, mb, p.in[I_XQNG] + l * 64,
                                (bf16_t*)(p.ws + OFF_XO) + tok0 * 256 + h * 64, 256, nullptr, 0, smem);
        }
    } break;
    case PH_P8: {
        pg8::Gemm g{(const bf16_t*)(p.ws + OFF_XO), W + W_XO, T_TOK, DM, 256}; pg8::StaticOrder S; S.init(T_TOK, DM, gridDim.x, blockIdx.x);
        pg8::EpiResid E{p.out, (bf16_t*)(p.ws + OFF_XB), (float*)(p.ws + OFF_ROWSQ)};
        pg8::gemm_phase<pg8::EpiResid>((PG8_LAS unsigned char*)smem0, g, S, E);
    } break;
    case PH_P9: {
        pg8::Gemm g{XB, W + W_13, T_TOK, 2 * DFF, DM}; pg8::StaticOrder S; S.init(T_TOK, 2 * DFF, gridDim.x, blockIdx.x);
        pg8::EpiSwiglu E{(bf16_t*)(p.ws + OFF_HFF), ROWSQ};
        pg8::gemm_phase<pg8::EpiSwiglu>((PG8_LAS unsigned char*)smem0, g, S, E);
    } break;
    case PH_P10: {
        pg8::Gemm g{(const bf16_t*)(p.ws + OFF_HFF), W + W_2, T_TOK, DM, DFF}; pg8::StaticOrder S; S.init(T_TOK, DM, gridDim.x, blockIdx.x);
        pg8::EpiResid E{p.out, (bf16_t*)(p.ws + OFF_XB), (float*)(p.ws + OFF_ROWSQ)};
        pg8::gemm_phase<pg8::EpiResid>((PG8_LAS unsigned char*)smem0, g, S, E);
    } break;
    }
}

#define XB_TMO      128
#define XB_XCNT(j)  (256  + 64 * (j))
#define XB_XSUB(j)  (1280 + 64 * (j))
#define XB_XGEN(j)  (2304 + 64 * (j))
#define XB_TOP      3328
#define XB_TOPGEN   3392
#define XCD_BAR_WORDS 3456
#define XB_SPIN_CAP (1u << 22)
#define LAS __attribute__((address_space(3)))
DI unsigned xb_ld(unsigned* p)              { return __hip_atomic_load(p, __ATOMIC_RELAXED, __HIP_MEMORY_SCOPE_AGENT); }
DI unsigned xb_add(unsigned* p, unsigned v) { return __hip_atomic_fetch_add(p, v, __ATOMIC_RELAXED, __HIP_MEMORY_SCOPE_AGENT); }
DI unsigned xb_xcc_id() { return (unsigned)__builtin_amdgcn_s_getreg((3 << 11) | 20) & 0xFu; }
#define XB_SPIN(cond, bar) do { unsigned _sp = 0; while (cond) { __builtin_amdgcn_s_sleep(1); \
    if ((++_sp & 255u) == 0u) { if (xb_ld(&(bar)[XB_TMO])) break; if (_sp > XB_SPIN_CAP) { atomicAdd(&(bar)[XB_TMO], 1u); break; } } } } while (0)
struct XcdBarrier { unsigned* bar; unsigned x; volatile LAS unsigned* st; };
DI XcdBarrier xcd_barrier_post(unsigned* bar, volatile LAS unsigned* st) {
    XcdBarrier b; b.bar = bar; b.x = xb_xcc_id(); b.st = st;
    if (threadIdx.x == 0) (void)xb_add(&bar[XB_XCNT(b.x)], 1u);
    return b;
}
DI void xcd_barrier_complete(unsigned* bar, unsigned x, unsigned& nloc, unsigned& nx) {
    const unsigned G = gridDim.x * gridDim.y * gridDim.z;
    unsigned sum, cnt, mine, sp = 0u;
    for (;;) {
        sum = 0u; cnt = 0u; mine = 0u;
#pragma unroll
        for (unsigned j = 0; j < 16; ++j) { const unsigned c = xb_ld(&bar[XB_XCNT(j)]); sum += c; cnt += (c > 0u) ? 1u : 0u; mine = (j == x) ? c : mine; }
        if (sum == G) break;
        __builtin_amdgcn_s_sleep(1);
        if ((++sp & 255u) == 0u) { if (xb_ld(&bar[XB_TMO])) break; if (sp > XB_SPIN_CAP) { atomicAdd(&bar[XB_TMO], 1u); break; } }
    }
    nloc = mine > 0u ? mine : 1u; nx = cnt > 0u ? cnt : 1u;
}
DI void xcd_barrier(const XcdBarrier& b) {
    asm volatile("s_waitcnt vmcnt(0)" ::: "memory");
    __syncthreads();
    if (threadIdx.x == 0) {
        unsigned* bar = b.bar;
        __builtin_amdgcn_s_waitcnt(0);
        unsigned nloc = b.st[0], nx = b.st[1];
        if (nloc == 0u) { xcd_barrier_complete(bar, b.x, nloc, nx); b.st[0] = nloc; b.st[1] = nx; }
        const unsigned old = xb_add(&bar[XB_XSUB(b.x)], 1u);
        const unsigned gen = old / nloc;
        if (old + 1u == (gen + 1u) * nloc) {
            __builtin_amdgcn_fence(__ATOMIC_RELEASE, "agent");
            asm volatile("s_waitcnt vmcnt(0)" ::: "memory");
            const unsigned og = xb_add(&bar[XB_TOP], 1u);
            const unsigned tg = og / nx;
            if (og + 1u == (tg + 1u) * nx) xb_add(&bar[XB_TOPGEN], 1u);
            else XB_SPIN(xb_ld(&bar[XB_TOPGEN]) == tg, bar);
            __builtin_amdgcn_fence(__ATOMIC_ACQUIRE, "agent");
            xb_add(&bar[XB_XGEN(b.x)], 1u);
            asm volatile("s_waitcnt vmcnt(0)" ::: "memory");
        } else {
            XB_SPIN(xb_ld(&bar[XB_XGEN(b.x)]) == gen, bar);
            __builtin_amdgcn_fence(__ATOMIC_ACQUIRE, "agent");
            asm volatile("s_waitcnt vmcnt(0)" ::: "memory");
        }
    }
    __syncthreads();
}

extern __shared__ __attribute__((aligned(16))) unsigned char dyn_smem[];

__global__ void __launch_bounds__(512, 2) mega_kernel(Params p) {
    cg::grid_group grid = cg::this_grid();
    volatile LAS unsigned* st = (volatile LAS unsigned*)(dyn_smem + 2 * LDS_BYTES);
    if (threadIdx.x == 0) { st[0] = 0u; st[1] = 0u; st[2] = 0u; st[3] = 0u; }
    __syncthreads();
    XcdBarrier xb = xcd_barrier_post((unsigned*)(p.ws + WS_BAR), st);
    const int nsteps = p.ph_hi;
    const bool single = (p.ph_hi - p.ph_lo) == 1;
    for (int step = p.ph_lo; step < nsteps; ++step) {
        int ph, l;
        if (step == 0) { ph = PH_PRO; l = 0; }
        else { l = (step - 1) / 11; ph = PH_CONV + (step - 1) % 11; }
        if (ph == PH_CONV && l == 0) continue;
        run_phase(p, ph, l, dyn_smem);
#ifdef REPEAT_PH
        if (ph == REPEAT_PH) { xcd_barrier(xb); run_phase(p, ph, l, dyn_smem); }
#endif
        if (single) break;
        if (step == 0) grid.sync();
        else if (step + 1 < nsteps) xcd_barrier(xb);
    }
}

extern "C" void kernel_launch(void* const* d_in, const int* in_sizes, int n_in, void* d_out, int out_size, void* d_ws, size_t ws_size, hipStream_t stream) {
    static int grid = 0;
    if (grid == 0) {
        if (n_in != N_IN || ws_size < WS_END + 256 || out_size != T_TOK * DM) { fprintf(stderr, "kernel_launch: unexpected sizes n_in %d ws %zu (need %zu) out %d\n", n_in, ws_size, (size_t)WS_END, out_size); grid = -1; return; }
        int dev = 0, cus = 0, per_cu = 0;
        (void)hipGetDevice(&dev);
        (void)hipDeviceGetAttribute(&cus, hipDeviceAttributeMultiprocessorCount, dev);
        (void)hipFuncSetAttribute((const void*)mega_kernel, hipFuncAttributeMaxDynamicSharedMemorySize, LDS_ALLOC);
        (void)hipOccupancyMaxActiveBlocksPerMultiprocessor(&per_cu, (const void*)mega_kernel, 512, LDS_ALLOC);
        if (per_cu < 1) fprintf(stderr, "kernel_launch: occupancy query says %d blocks per CU\n", per_cu);
        grid = cus;
        (void)hipGetLastError();
    }
    if (grid < 0) return;
    Params p{};
    for (int i = 0; i < N_IN; ++i) p.in[i] = (const float*)d_in[i];
    p.out = (float*)d_out; p.ws = (unsigned char*)d_ws;
    (void)hipMemsetAsync((unsigned char*)d_ws + WS_BAR, 0, XCD_BAR_WORDS * 4, stream);
    p.ph_lo = 0; p.ph_hi = 1 + NL * 11;
    void* args[] = {&p};
    hipError_t e = hipLaunchCooperativeKernel((const void*)mega_kernel, dim3(grid), dim3(512), args, LDS_ALLOC, stream);
    if (e != hipSuccess) fprintf(stderr, "cooperative launch failed: %s (grid %d)\n", hipGetErrorString(e), grid);
}
```

```cpp
#include <hip/hip_runtime.h>
#include <hip/hip_cooperative_groups.h>
#include <cstdio>
#include <cstdint>
namespace cg = cooperative_groups;

#ifndef MEGA
#define MEGA 1
#endif

typedef unsigned short bf16_t;
typedef short bf16x8 __attribute__((ext_vector_type(8)));
typedef float f32x4 __attribute__((ext_vector_type(4)));
typedef unsigned u32x4 __attribute__((ext_vector_type(4)));
typedef unsigned u32x2 __attribute__((ext_vector_type(2)));

#define DI __device__ __forceinline__
#define MFMA16(a, b, c) __builtin_amdgcn_mfma_f32_16x16x32_bf16((a), (b), (c), 0, 0, 0)

constexpr int T_TOK = 32768, SEQ = 4096, NB = 8, DM = 1024, NL = 4;
constexpr int UC = 3072;
constexpr int INC = 2976;
constexpr int DFF = 2816;
constexpr float EPS = 1e-6f;
constexpr int LDS_BYTES = 73728;
constexpr int LDS_ALLOC = 2 * LDS_BYTES + 16;

constexpr size_t SZ_W = 13533184ull * 2;
constexpr size_t OFF_W = 0;
constexpr size_t OFF_XWKV = OFF_W + SZ_W;
constexpr size_t OFF_XB = OFF_XWKV + 4ull * 512 * 1024 * 2;
constexpr size_t OFF_MEMB = OFF_XB + (size_t)T_TOK * 1024 * 2;
constexpr size_t OFF_U = OFF_MEMB + 2048ull * 1024 * 2;
constexpr size_t OFF_CAT = OFF_U + (size_t)T_TOK * UC * 2;
constexpr size_t OFF_MQ = OFF_CAT + (size_t)T_TOK * 1024 * 2;
constexpr size_t OFF_MK = OFF_MQ + (size_t)T_TOK * 384 * 2;
constexpr size_t OFF_MVT = OFF_MK + (size_t)T_TOK * 384 * 2;
constexpr size_t OFF_HST = OFF_MVT + (size_t)T_TOK * 256 * 2;
constexpr size_t OFF_HDEC = OFF_HST + 64ull * 64 * 4096 * 4;
constexpr size_t OFF_XK = OFF_HDEC + 64ull * 64 * 64 * 4;
constexpr size_t OFF_XVT = OFF_XK + 4ull * 8 * 4 * 256 * 64 * 2;
constexpr size_t OFF_ROPE = OFF_XVT + 4ull * 8 * 4 * 256 * 64 * 2;
constexpr size_t OFF_ROWSQ = OFF_ROPE + (size_t)T_TOK * 16 * 2 * 4;
constexpr size_t OFF_MEMSQ = OFF_ROWSQ + (size_t)T_TOK * 16 * 4;
constexpr size_t OFF_SSQB = OFF_MEMSQ + 2048 * 4;
constexpr size_t OFF_SSQD = OFF_SSQB + (size_t)T_TOK * 4 * 4;
constexpr size_t WS_BAR = OFF_SSQD + (size_t)T_TOK * 4 * 4;
constexpr size_t WS_END = WS_BAR + 16384;
constexpr size_t QRAW_IN_OUT = 0;
constexpr size_t KVRAW_IN_OUT = (size_t)T_TOK * 384 * 2;
constexpr size_t OFF_KVMEM = OFF_MQ;
constexpr size_t OFF_XQ = OFF_U;
constexpr size_t OFF_XO = OFF_U + (size_t)T_TOK * 256 * 2;
constexpr size_t OFF_HFF = OFF_U;
constexpr size_t W_IN = 0, W_OUT = 3145728, W_UQ = 4194304, W_UKV = 4292608, W_XQ = 4358144, W_XO = 4620288, W_13 = 4882432, W_2 = 10649600;

enum { I_X = 0, I_MEM, I_POS, I_GMIX, I_WIN, I_ADWW, I_ADWB, I_ALNG, I_ALNB, I_HGAM, I_HONG, I_CDWW, I_CDWB, I_MQAG, I_MWUQ, I_MKVAG,
       I_MWUKV, I_MQNG, I_MKNG, I_GBR, I_WOUT, I_GXQ, I_GMEM, I_XWQ, I_XWKV, I_XQNG, I_XKNG, I_XWO, I_GFFN, I_W13, I_W2, N_IN };

struct Params {
    const float* in[N_IN];
    float* out;
    unsigned char* ws;
    int ph_lo, ph_hi;
    int layer, pad;
};

typedef __bf16 bf2_t __attribute__((ext_vector_type(2)));
typedef float f2_t __attribute__((ext_vector_type(2)));
DI unsigned cvt_pk(float lo, float hi) { f2_t v = {lo, hi}; bf2_t b = __builtin_convertvector(v, bf2_t); return __builtin_bit_cast(unsigned, b); }
DI bf16_t f2bf(float x) { return (bf16_t)(cvt_pk(x, 0.f) & 0xffffu); }
DI float bf2f(bf16_t h) { return __uint_as_float(((unsigned)h) << 16); }
DI float bflo(unsigned w) { return __uint_as_float(w << 16); }
DI float bfhi(unsigned w) { return __uint_as_float(w & 0xffff0000u); }
DI float sigmoidf_(float x) { return __builtin_amdgcn_rcpf(1.f + __expf(-x)); }
DI int tidx() { int t = threadIdx.x & 255; asm volatile("" : "+v"(t)); return t; }
DI float wave_sum(float v) {
#pragma unroll
    for (int o = 32; o > 0; o >>= 1) v += __shfl_xor(v, o);
    return v;
}

DI int sw_off(int row, int chunk) { return row * 128 + ((chunk ^ ((row >> 1) & 7)) << 4); }

DI void scale_chunk(uint4& v, float s) {
    v.x = cvt_pk(bflo(v.x) * s, bfhi(v.x) * s); v.y = cvt_pk(bflo(v.y) * s, bfhi(v.y) * s);
    v.z = cvt_pk(bflo(v.z) * s, bfhi(v.z) * s); v.w = cvt_pk(bflo(v.w) * s, bfhi(v.w) * s);
}

template <bool ASC>
DI void gemm_mainloop(const bf16_t* __restrict__ A, int lda, const bf16_t* __restrict__ Bt, int K, int row0, int col0,
                      unsigned char* smem, f32x4 (&acc)[4][4]) {
    const int tid = tidx(), lane = tid & 63, w = tid >> 6, wr = w >> 1, wc = w & 1, l15 = lane & 15, quad = lane >> 4;
    const int lr = tid >> 3, lc = tid & 7;
    const bf16_t* Ap = A + (size_t)(row0 + lr) * lda + lc * 8;
    const bf16_t* Bp = Bt + (size_t)(col0 + lr) * K + lc * 8;
    const size_t as1 = (size_t)32 * lda, bs1 = (size_t)32 * K;
    const float* asc = (const float*)(smem + 66048);
    uint4 ra0, ra1, ra2, ra3, rb0, rb1, rb2, rb3;
#define G_LOAD(ko) do { ra0 = *(const uint4*)(Ap + (ko)); ra1 = *(const uint4*)(Ap + as1 + (ko)); ra2 = *(const uint4*)(Ap + 2 * as1 + (ko)); ra3 = *(const uint4*)(Ap + 3 * as1 + (ko)); \
                        rb0 = *(const uint4*)(Bp + (ko)); rb1 = *(const uint4*)(Bp + bs1 + (ko)); rb2 = *(const uint4*)(Bp + 2 * bs1 + (ko)); rb3 = *(const uint4*)(Bp + 3 * bs1 + (ko)); } while (0)
#define G_STORE(buf) do { unsigned char* Ad_ = smem + (buf) * 16384; unsigned char* Bd_ = smem + 32768 + (buf) * 16384; const int o_ = sw_off(lr, lc); \
                          *(uint4*)(Ad_ + o_) = ra0; *(uint4*)(Ad_ + o_ + 4096) = ra1; *(uint4*)(Ad_ + o_ + 8192) = ra2; *(uint4*)(Ad_ + o_ + 12288) = ra3; \
                          *(uint4*)(Bd_ + o_) = rb0; *(uint4*)(Bd_ + o_ + 4096) = rb1; *(uint4*)(Bd_ + o_ + 8192) = rb2; *(uint4*)(Bd_ + o_ + 12288) = rb3; } while (0)
    const int plc = (tid & 7) ^ ((tid >> 4) & 7);
    const bf16_t* Adp = A + (size_t)(row0 + lr) * lda + plc * 8;
    const bf16_t* Bdp = Bt + (size_t)(col0 + lr) * K + plc * 8;
#define D_STAGE(buf, ko) do { _Pragma("unroll") for (int i_ = 0; i_ < 4; ++i_) { \
        __builtin_amdgcn_global_load_lds((const unsigned*)(Adp + i_ * as1 + (ko)), (unsigned*)(smem + (buf) * 16384 + i_ * 4096 + tid * 16), 16, 0, 0); \
        __builtin_amdgcn_global_load_lds((const unsigned*)(Bdp + i_ * bs1 + (ko)), (unsigned*)(smem + 32768 + (buf) * 16384 + i_ * 4096 + tid * 16), 16, 0, 0); } } while (0)
    if (ASC) { G_LOAD(0); } else { D_STAGE(0, 0); }
#pragma unroll
    for (int m = 0; m < 4; ++m)
#pragma unroll
        for (int n = 0; n < 4; ++n) acc[m][n] = (f32x4){0.f, 0.f, 0.f, 0.f};
    if (ASC) { G_STORE(0); }
    __syncthreads();
    const int nk = K >> 6;
    for (int kt = 0; kt < nk; ++kt) {
        const int cur = kt & 1;
        const bool more = (kt + 1 < nk);
        if (more) { const int ko = (kt + 1) * 64; if (ASC) { G_LOAD(ko); } else { D_STAGE(cur ^ 1, ko); } }
        __builtin_amdgcn_sched_barrier(0);
        const unsigned char* As = smem + cur * 16384;
        const unsigned char* Bs = smem + 32768 + cur * 16384;
#pragma unroll
        for (int ks = 0; ks < 2; ++ks) {
            bf16x8 af[4], bfv[4];
#pragma unroll
            for (int m = 0; m < 4; ++m) af[m] = *(const bf16x8*)(As + sw_off(wr * 64 + m * 16 + l15, ks * 4 + quad));
#pragma unroll
            for (int n = 0; n < 4; ++n) bfv[n] = *(const bf16x8*)(Bs + sw_off(wc * 64 + n * 16 + l15, ks * 4 + quad));
#pragma unroll
            for (int m = 0; m < 4; ++m)
#pragma unroll
                for (int n = 0; n < 4; ++n) acc[m][n] = MFMA16(bfv[n], af[m], acc[m][n]);
        }
        __builtin_amdgcn_sched_barrier(0);
        if (ASC && more) {
            const int grp = ((kt + 1) * 64) >> 8;
            if (grp & 1) {
                const int which = grp >> 1;
                scale_chunk(ra0, asc[lr * 2 + which]); scale_chunk(ra1, asc[(lr + 32) * 2 + which]);
                scale_chunk(ra2, asc[(lr + 64) * 2 + which]); scale_chunk(ra3, asc[(lr + 96) * 2 + which]);
            }
            G_STORE(cur ^ 1);
        }
        __syncthreads();
    }
#undef G_LOAD
#undef G_STORE
#undef D_STAGE
}

DI void tile_order(int L, int nM, int nN, int& pm, int& pn) {
    const int nwg = nM * nN;
    int wgid = L;
    { const int q = nwg / 8, r = nwg % 8, xcd = wgid % 8, off = wgid / 8; wgid = (xcd < r ? xcd * (q + 1) : r * (q + 1) + (xcd - r) * q) + off; }
    const int WGM = 8;
    const int nig = WGM * nN, gid = wgid / nig, fm = gid * WGM, gsz = (nM - fm) < WGM ? (nM - fm) : WGM;
    pm = fm + ((wgid % nig) % gsz); pn = (wgid % nig) / gsz;
}

DI void fill_rs(unsigned char* smem, const float* part, int npart, int row0, float inv_n) {
    float* rs = (float*)(smem + 65536);
    const int tid = tidx();
    if (tid < 128) {
        float s = 0.f;
        for (int i = 0; i < npart; ++i) s += part[(size_t)(row0 + tid) * npart + i];
        rs[tid] = __builtin_amdgcn_rsqf(s * inv_n + EPS);
    }
}

DI void epi_bf16(const f32x4 (&acc)[4][4], bf16_t* O, int ldo, int row0, int col0, const float* rs) {
    const int lane = tidx() & 63, w = tidx() >> 6, wr = w >> 1, wc = w & 1, l15 = lane & 15, quad = lane >> 4;
#pragma unroll
    for (int m = 0; m < 4; ++m) {
        const int rl = wr * 64 + m * 16 + l15;
        const float sc = rs ? rs[rl] : 1.f;
        bf16_t* rowp = O + (size_t)(row0 + rl) * ldo + col0 + wc * 64 + quad * 4;
#pragma unroll
        for (int n = 0; n < 4; ++n) {
            u32x2 v; v.x = cvt_pk(acc[m][n][0] * sc, acc[m][n][1] * sc); v.y = cvt_pk(acc[m][n][2] * sc, acc[m][n][3] * sc);
            *(u32x2*)(rowp + n * 16) = v;
        }
    }
}
DI void epi_resid(const f32x4 (&acc)[4][4], float* X, bf16_t* XB, float* rowsq, int row0, int col0) {
    const int lane = tidx() & 63, w = tidx() >> 6, wr = w >> 1, wc = w & 1, l15 = lane & 15, quad = lane >> 4;
    const int pn = col0 >> 7;
#pragma unroll
    for (int m = 0; m < 4; ++m) {
        const int row = row0 + wr * 64 + m * 16 + l15;
        float ss = 0.f;
#pragma unroll
        for (int n = 0; n < 4; ++n) {
            const int col = col0 + wc * 64 + n * 16 + quad * 4;
            float4* xp = (float4*)(X + (size_t)row * DM + col);
            float4 xv = *xp;
            xv.x += acc[m][n][0]; xv.y += acc[m][n][1]; xv.z += acc[m][n][2]; xv.w += acc[m][n][3];
            *xp = xv;
            u32x2 v; v.x = cvt_pk(xv.x, xv.y); v.y = cvt_pk(xv.z, xv.w);
            *(u32x2*)(XB + (size_t)row * DM + col) = v;
            ss += xv.x * xv.x + xv.y * xv.y + xv.z * xv.z + xv.w * xv.w;
        }
        ss += __shfl_xor(ss, 16); ss += __shfl_xor(ss, 32);
        if (quad == 0) rowsq[(size_t)row * 16 + pn * 2 + wc] = ss;
    }
}
DI void epi_swiglu(const f32x4 (&acc)[4][4], bf16_t* H, int row0, int col0, const float* rs) {
    const int lane = tidx() & 63, w = tidx() >> 6, wr = w >> 1, wc = w & 1, l15 = lane & 15, quad = lane >> 4;
#pragma unroll
    for (int m = 0; m < 4; ++m) {
        const int rl = wr * 64 + m * 16 + l15;
        const float sc = rs[rl];
        bf16_t* rowp = H + (size_t)(row0 + rl) * DFF + ((col0 + wc * 64) >> 1) + quad * 4;
#pragma unroll
        for (int np = 0; np < 2; ++np) {
            float h[4];
#pragma unroll
            for (int j = 0; j < 4; ++j) { const float a1 = acc[m][2 * np][j] * sc, a3 = acc[m][2 * np + 1][j] * sc; h[j] = a1 * sigmoidf_(a1) * a3; }
            u32x2 v; v.x = cvt_pk(h[0], h[1]); v.y = cvt_pk(h[2], h[3]);
            *(u32x2*)(rowp + np * 16) = v;
        }
    }
}

DI void conv_tile(const float* __restrict__ src, int K, int N, int Npad, const float* __restrict__ gain, int perm, bf16_t* __restrict__ dst, int tile, unsigned char* smem) {
    float* lds = (float*)smem;
    const int nkt = K >> 6, kt = tile % nkt, nt = tile / nkt, k0 = kt * 64, n0 = nt * 64;
    const int tid = tidx(), nl = tid & 63, kq = tid >> 6;
    const int R = n0 + nl;
    int sc = R;
    if (perm == 1) { const int g = R >> 5, j = R & 31; sc = (j < 16) ? (16 * g + j) : (DFF + 16 * g + j - 16); }
    const bool ok = R < N;
#pragma unroll
    for (int i = 0; i < 16; ++i) { const int kl = kq + 4 * i; lds[kl * 65 + nl] = ok ? src[(size_t)(k0 + kl) * N + sc] : 0.f; }
    __syncthreads();
    const int kc = tid & 7, nr = tid >> 3;
    int kd0 = k0;
    if (perm == 2) { const int g = k0 >> 8; const int gm = (g == 0) ? 2 : (g == 1) ? 0 : (g == 2) ? 3 : 1; kd0 = gm * 256 + (k0 & 255); }
    float g8[8];
#pragma unroll
    for (int j = 0; j < 8; ++j) g8[j] = gain ? gain[k0 + kc * 8 + j] : 1.f;
#pragma unroll
    for (int i = 0; i < 2; ++i) {
        const int nl2 = nr + 32 * i;
        float v[8];
#pragma unroll
        for (int j = 0; j < 8; ++j) v[j] = lds[(kc * 8 + j) * 65 + nl2] * g8[j];
        uint4 o; o.x = cvt_pk(v[0], v[1]); o.y = cvt_pk(v[2], v[3]); o.z = cvt_pk(v[4], v[5]); o.w = cvt_pk(v[6], v[7]);
        *(uint4*)(dst + (size_t)(n0 + nl2) * K + kd0 + kc * 8) = o;
    }
    __syncthreads();
}

constexpr int CONV_TILES = 768 + 256 + 24 + 16 + 64 + 64 + 1408 + 704;
DI void conv_layer_item(const Params& p, int l, int it, unsigned char* smem) {
    bf16_t* W = (bf16_t*)(p.ws + OFF_W);
    if (it < 768) { conv_tile(p.in[I_WIN] + (size_t)l * DM * INC, DM, INC, UC, p.in[I_GMIX] + l * DM, 0, W + W_IN, it, smem); return; } it -= 768;
    if (it < 256) { conv_tile(p.in[I_WOUT] + (size_t)l * DM * DM, DM, DM, DM, p.in[I_GBR] + l * DM, 2, W + W_OUT, it, smem); return; } it -= 256;
    if (it < 24) { conv_tile(p.in[I_MWUQ] + (size_t)l * 256 * 384, 256, 384, 384, p.in[I_MQAG] + l * 256, 0, W + W_UQ, it, smem); return; } it -= 24;
    if (it < 16) { conv_tile(p.in[I_MWUKV] + (size_t)l * 128 * 512, 128, 512, 512, p.in[I_MKVAG] + l * 128, 0, W + W_UKV, it, smem); return; } it -= 16;
    if (it < 64) { conv_tile(p.in[I_XWQ] + (size_t)l * DM * 256, DM, 256, 256, p.in[I_GXQ] + l * DM, 0, W + W_XQ, it, smem); return; } it -= 64;
    if (it < 64) { conv_tile(p.in[I_XWO] + (size_t)l * 256 * DM, 256, DM, DM, nullptr, 0, W + W_XO, it, smem); return; } it -= 64;
    if (it < 1408) { conv_tile(p.in[I_W13] + (size_t)l * DM * 2 * DFF, DM, 2 * DFF, 2 * DFF, p.in[I_GFFN] + l * DM, 1, W + W_13, it, smem); return; } it -= 1408;
    conv_tile(p.in[I_W2] + (size_t)l * DFF * DM, DFF, DM, DM, nullptr, 0, W + W_2, it, smem);
}

DI void pro_rows(const float* __restrict__ src, float* __restrict__ cpy, bf16_t* __restrict__ dstb, float* __restrict__ sq, int sqstride, int item) {
    const int w = tidx() >> 6, lane = tidx() & 63;
    for (int r = 0; r < 4; ++r) {
        const int row = item * 16 + w * 4 + r;
        const float4* s4 = (const float4*)(src + (size_t)row * DM);
        float s = 0.f;
#pragma unroll
        for (int i = 0; i < 4; ++i) {
            const float4 v = s4[lane + 64 * i];
            if (cpy) ((float4*)(cpy + (size_t)row * DM))[lane + 64 * i] = v;
            u32x2 o; o.x = cvt_pk(v.x, v.y); o.y = cvt_pk(v.z, v.w);
            *(u32x2*)(dstb + (size_t)row * DM + (lane + 64 * i) * 4) = o;
            s += v.x * v.x + v.y * v.y + v.z * v.z + v.w * v.w;
        }
        s = wave_sum(s);
        if (lane < sqstride) sq[(size_t)row * sqstride + lane] = (lane == 0) ? s : 0.f;
    }
}
DI void pro_rope(const Params& p, int item) {
    const int tok = item * 256 + tidx();
    const int* pos = (const int*)p.in[I_POS];
    float* cs = (float*)(p.ws + OFF_ROPE);
    float* sn = cs + (size_t)T_TOK * 16;
    const float pf = (float)pos[tok];
#pragma unroll
    for (int i = 0; i < 16; ++i) {
        const float inv = powf(10000.0f, -(float)(2 * i) / 32.0f);
        const float ang = pf * inv;
        cs[(size_t)tok * 16 + i] = cosf(ang);
        sn[(size_t)tok * 16 + i] = sinf(ang);
    }
}

DI void conformer_tile(const Params& p, int l, int tile, unsigned char* smem) {
    float* hs = (float*)smem;
    const bf16_t* U = (const bf16_t*)(p.ws + OFF_U);
    bf16_t* CAT = (bf16_t*)(p.ws + OFF_CAT);
    const int tid = tidx(), b = tile >> 7, t0 = (tile & 127) * 32;
    {
        const int c2 = (tid & 127) * 2, half = tid >> 7;
        for (int r0 = half; r0 < 62; r0 += 32) {
            unsigned av[16], gv[16];
#pragma unroll
            for (int k = 0; k < 16; ++k) {
                const int r = r0 + 2 * k, t = t0 - 15 + r;
                av[k] = 0u; gv[k] = 0u;
                if (r < 62 && t >= 0 && t < SEQ) {
                    const bf16_t* up = U + (size_t)(b * SEQ + t) * UC;
                    av[k] = *(const unsigned*)(up + c2); gv[k] = *(const unsigned*)(up + 256 + c2);
                }
            }
#pragma unroll
            for (int k = 0; k < 16; ++k) {
                const int r = r0 + 2 * k;
                if (r < 62) {
                    hs[r * 256 + c2] = bflo(av[k]) * sigmoidf_(bflo(gv[k]));
                    hs[r * 256 + c2 + 1] = bfhi(av[k]) * sigmoidf_(bfhi(gv[k]));
                }
            }
        }
    }
    __syncthreads();
    {
        const int c = tid;
        float wv[31];
        const float* wp = p.in[I_ADWW] + (size_t)l * 31 * 256 + c;
#pragma unroll
        for (int j = 0; j < 31; ++j) wv[j] = wp[j * 256];
        const float bias = p.in[I_ADWB][l * 256 + c];
        for (int t = 0; t < 32; ++t) {
            float y = bias;
#pragma unroll
            for (int j = 0; j < 31; ++j) y += wv[j] * hs[(t + j) * 256 + c];
            hs[t * 256 + c] = y;
        }
    }
    __syncthreads();
    {
        const int w = tid >> 6, lane = tid & 63;
        const float4 g4 = *(const float4*)(p.in[I_ALNG] + l * 256 + lane * 4), b4 = *(const float4*)(p.in[I_ALNB] + l * 256 + lane * 4);
        for (int r = 0; r < 8; ++r) {
            const int t = w * 8 + r;
            float4 v = *(const float4*)(hs + t * 256 + lane * 4);
            const float mu = wave_sum(v.x + v.y + v.z + v.w) * (1.f / 256.f);
            v.x -= mu; v.y -= mu; v.z -= mu; v.w -= mu;
            const float var = wave_sum(v.x * v.x + v.y * v.y + v.z * v.z + v.w * v.w) * (1.f / 256.f);
            const float rstd = __builtin_amdgcn_rsqf(var + EPS);
            float y0 = v.x * rstd * g4.x + b4.x, y1 = v.y * rstd * g4.y + b4.y, y2 = v.z * rstd * g4.z + b4.z, y3 = v.w * rstd * g4.w + b4.w;
            y0 *= sigmoidf_(y0); y1 *= sigmoidf_(y1); y2 *= sigmoidf_(y2); y3 *= sigmoidf_(y3);
            const float ss = wave_sum(y0 * y0 + y1 * y1 + y2 * y2 + y3 * y3);
            const float rb = __builtin_amdgcn_rsqf(ss * (1.f / 256.f) + EPS);
            u32x2 o; o.x = cvt_pk(y0 * rb, y1 * rb); o.y = cvt_pk(y2 * rb, y3 * rb);
            *(u32x2*)(CAT + (size_t)(b * SEQ + t0 + t) * DM + 512 + lane * 4) = o;
        }
    }
    __syncthreads();
}

DI void shortconv_tile(const Params& p, int l, int tile) {
    const bf16_t* U = (const bf16_t*)(p.ws + OFF_U);
    bf16_t* CAT = (bf16_t*)(p.ws + OFF_CAT);
    const int w = tidx() >> 6, lane = tidx() & 63, c = lane * 4;
    const float* wp = p.in[I_CDWW] + (size_t)l * 3 * 256 + c;
    const float4 w0 = *(const float4*)(wp), w1 = *(const float4*)(wp + 256), w2 = *(const float4*)(wp + 512);
    const float4 bb = *(const float4*)(p.in[I_CDWB] + l * 256 + c);
#pragma unroll 4
    for (int r = 0; r < 16; ++r) {
        const int tok = tile * 64 + w * 16 + r, s = tok & (SEQ - 1);
        float pr[3][4];
#pragma unroll
        for (int j = 0; j < 3; ++j) {
            const int sj = s + j - 1;
            if (sj >= 0 && sj < SEQ) {
                const bf16_t* up = U + (size_t)(tok + j - 1) * UC;
                const u32x2 gc = *(const u32x2*)(up + 2048 + c), xi = *(const u32x2*)(up + 2304 + c);
                pr[j][0] = bflo(gc.x) * bflo(xi.x); pr[j][1] = bfhi(gc.x) * bfhi(xi.x); pr[j][2] = bflo(gc.y) * bflo(xi.y); pr[j][3] = bfhi(gc.y) * bfhi(xi.y);
            } else { pr[j][0] = pr[j][1] = pr[j][2] = pr[j][3] = 0.f; }
        }
        const u32x2 gb = *(const u32x2*)(U + (size_t)tok * UC + 1792 + c);
        const float y0 = bflo(gb.x) * (bb.x + w0.x * pr[0][0] + w1.x * pr[1][0] + w2.x * pr[2][0]);
        const float y1 = bfhi(gb.x) * (bb.y + w0.y * pr[0][1] + w1.y * pr[1][1] + w2.y * pr[2][1]);
        const float y2 = bflo(gb.y) * (bb.z + w0.z * pr[0][2] + w1.z * pr[1][2] + w2.z * pr[2][2]);
        const float y3 = bfhi(gb.y) * (bb.w + w0.w * pr[0][3] + w1.w * pr[1][3] + w2.w * pr[2][3]);
        const float ss = wave_sum(y0 * y0 + y1 * y1 + y2 * y2 + y3 * y3);
        const float rb = __builtin_amdgcn_rsqf(ss * (1.f / 256.f) + EPS);
        u32x2 o; o.x = cvt_pk(y0 * rb, y1 * rb); o.y = cvt_pk(y2 * rb, y3 * rb);
        *(u32x2*)(CAT + (size_t)tok * DM + 768 + c) = o;
    }
}

DI float hgrn_lower(const Params& p, int l, int dir, int ch) {
    const float* g = p.in[I_HGAM] + (size_t)dir * NL * 256 + ch;
    const float g0 = g[0], g1 = g[256], g2 = g[512], g3 = g[768];
    const float mx = fmaxf(fmaxf(g0, g1), fmaxf(g2, g3));
    const float e0 = __expf(g0 - mx), e1 = __expf(g1 - mx), e2 = __expf(g2 - mx), e3 = __expf(g3 - mx);
    const float inv = 1.f / (e0 + e1 + e2 + e3);
    float lb = 0.f;
    if (l >= 1) lb += e1; if (l >= 2) lb += e2; if (l >= 3) lb += e3;
    return lb * inv;
}

DI void hgrn_local_tile(const Params& p, int l, int item, unsigned char* smem) {
    const bf16_t* U = (const bf16_t*)(p.ws + OFF_U);
    float* HST = (float*)(p.ws + OFF_HST);
    float* HDEC = (float*)(p.ws + OFF_HDEC);
    const int dir = item >> 9, b = (item >> 6) & 7, c = item & 63;
    const int h = tidx() >> 6, lane = tidx() & 63, l15 = lane & 15, quad = lane >> 4;
    bf16_t* kT = (bf16_t*)(smem + h * 18432);
    bf16_t* vT = kT + 64 * 72;
    const float lb = hgrn_lower(p, l, dir, h * 64 + lane);
    const int tokbase = b * SEQ + c * 64;
    const bf16_t* zp = U + (size_t)tokbase * UC + 768 + dir * 256 + h * 64 + lane;
    const bf16_t* vp = U + (size_t)tokbase * UC + 1280 + h * 64 + lane;
    float suf = 0.f;
    {
        const int step = dir ? UC : -UC, di = dir ? 1 : -1;
        int i = dir ? 0 : 63;
        zp += (size_t)i * UC; vp += (size_t)i * UC;
        bf16_t* kw = kT + lane * 72 + i; bf16_t* vw = vT + lane * 72 + i;
        for (int hb = 0; hb < 2; ++hb) {
            bf16_t zz[32], vv[32];
#pragma unroll
            for (int ii = 0; ii < 32; ++ii) { zz[ii] = zp[(ptrdiff_t)ii * step]; vv[ii] = vp[(ptrdiff_t)ii * step]; }
            zp += (ptrdiff_t)32 * step; vp += (ptrdiff_t)32 * step;
#pragma unroll
            for (int ii = 0; ii < 32; ++ii) {
                const float z = bf2f(zz[ii]);
                const float sg = sigmoidf_(z), f = sg + lb * (1.f - sg), kk = (1.f - lb) * (1.f - sg);
                kw[ii * di] = f2bf(kk * __expf(suf));
                vw[ii * di] = vv[ii];
                suf += __logf(f);
            }
            kw += 32 * di; vw += 32 * di;
        }
    }
    const int seq = (dir * 8 + b) * 4 + h, cs = dir ? 63 - c : c;
    HDEC[((size_t)seq * 64 + cs) * 64 + lane] = __expf(suf);
    __syncthreads();
    f32x4 acc[4][4];
#pragma unroll
    for (int et = 0; et < 4; ++et)
#pragma unroll
        for (int dt = 0; dt < 4; ++dt) acc[et][dt] = (f32x4){0.f, 0.f, 0.f, 0.f};
#pragma unroll
    for (int ks = 0; ks < 2; ++ks) {
        bf16x8 av[4], bk[4];
#pragma unroll
        for (int t = 0; t < 4; ++t) {
            av[t] = *(const bf16x8*)(vT + (t * 16 + l15) * 72 + ks * 32 + quad * 8);
            bk[t] = *(const bf16x8*)(kT + (t * 16 + l15) * 72 + ks * 32 + quad * 8);
        }
#pragma unroll
        for (int et = 0; et < 4; ++et)
#pragma unroll
            for (int dt = 0; dt < 4; ++dt) acc[et][dt] = MFMA16(av[et], bk[dt], acc[et][dt]);
    }
    float* sp = HST + ((size_t)seq * 64 + cs) * 4096;
#pragma unroll
    for (int et = 0; et < 4; ++et)
#pragma unroll
        for (int dt = 0; dt < 4; ++dt)
#pragma unroll
            for (int r = 0; r < 4; ++r) sp[(et * 16 + quad * 4 + r) * 64 + dt * 16 + l15] = acc[et][dt][r];
    __syncthreads();
}

DI void hgrn_scan_item(const Params& p, int item) {
    float* HST = (float*)(p.ws + OFF_HST);
    const float* HDEC = (const float*)(p.ws + OFF_HDEC);
    const int gid = item * 256 + tidx(), seq = gid >> 12, ed = gid & 4095, d = ed & 63;
    float* sp = HST + (size_t)seq * 64 * 4096 + ed;
    const float* dp = HDEC + (size_t)seq * 64 * 64 + d;
    float s = 0.f;
    for (int c0 = 0; c0 < 64; c0 += 8) {
        float loc[8], dec[8];
#pragma unroll
        for (int j = 0; j < 8; ++j) { loc[j] = sp[(size_t)(c0 + j) * 4096]; dec[j] = dp[(c0 + j) * 64]; }
#pragma unroll
        for (int j = 0; j < 8; ++j) { sp[(size_t)(c0 + j) * 4096] = s; s = dec[j] * s + loc[j]; }
    }
}

DI void hgrn_scan_dummy(const Params& p, int item) {
    float* HST = (float*)(p.ws + OFF_HST);
    const float* HDEC = (const float*)(p.ws + OFF_HDEC);
    const int gid = item * 256 + tidx(), seq = gid >> 12, ed = gid & 4095, d = ed & 63;
    float* sp = HST + (size_t)seq * 64 * 4096 + ed;
    const float* dp = HDEC + (size_t)seq * 64 * 64 + d;
    float s = 0.f;
    for (int c0 = 0; c0 < 64; c0 += 8) {
        float loc[8], dec[8];
#pragma unroll
        for (int j = 0; j < 8; ++j) { loc[j] = sp[(size_t)(c0 + j) * 4096]; dec[j] = dp[(c0 + j) * 64]; }
#pragma unroll
        for (int j = 0; j < 8; ++j) { s = dec[j] * s + loc[j]; sp[(size_t)(c0 + j) * 4096] = (s == 12345.678f) ? s : loc[j]; }
    }
}
DI bf16x8 hg_frag(const bf16_t* qk, const float* bc, const float* ref, bool qside) {
    const uint4 x = *(const uint4*)qk;
    const float4 b0 = *(const float4*)bc, b1 = *(const float4*)(bc + 4);
    float4 r0 = {0.f, 0.f, 0.f, 0.f}, r1 = {0.f, 0.f, 0.f, 0.f};
    if (ref) { r0 = *(const float4*)ref; r1 = *(const float4*)(ref + 4); }
    float e[8] = {b0.x - r0.x, b0.y - r0.y, b0.z - r0.z, b0.w - r0.w, b1.x - r1.x, b1.y - r1.y, b1.z - r1.z, b1.w - r1.w};
    if (!qside) {
#pragma unroll
        for (int j = 0; j < 8; ++j) e[j] = -e[j];
    }
    u32x4 o;
    o.x = cvt_pk(bflo(x.x) * __expf(e[0]), bfhi(x.x) * __expf(e[1]));
    o.y = cvt_pk(bflo(x.y) * __expf(e[2]), bfhi(x.y) * __expf(e[3]));
    o.z = cvt_pk(bflo(x.z) * __expf(e[4]), bfhi(x.z) * __expf(e[5]));
    o.w = cvt_pk(bflo(x.w) * __expf(e[6]), bfhi(x.w) * __expf(e[7]));
    return __builtin_bit_cast(bf16x8, o);
}

DI void hgrn_out_tile(const Params& p, int l, int item, unsigned char* smem) {
    const bf16_t* U = (const bf16_t*)(p.ws + OFF_U);
    const float* HST = (const float*)(p.ws + OFF_HST);
    bf16_t* CAT = (bf16_t*)(p.ws + OFF_CAT);
    float* SSQB = (float*)(p.ws + OFF_SSQB);
    const int h = item & 3, c = (item >> 2) & 63, b = item >> 8;
    const int w = tidx() >> 6, lane = tidx() & 63, l15 = lane & 15, quad = lane >> 4;
    float* bc = (float*)smem;
    bf16_t* kk = (bf16_t*)(smem + 34816);
    bf16_t* qq = (bf16_t*)(smem + 34816 + 18432);
    bf16_t* vT = (bf16_t*)(smem + 34816 + 18432 + 9216);
    const int tokbase = b * SEQ + c * 64;
    u32x4 sfr[2][4];
    {
        const int dirp = w & 1;
        const int seqp = (dirp * 8 + b) * 4 + h, csp = dirp ? 63 - c : c;
        const float* sinp = HST + ((size_t)seqp * 64 + csp) * 4096;
#pragma unroll
        for (int ks = 0; ks < 2; ++ks)
#pragma unroll
            for (int et = 0; et < 4; ++et) {
                const float* sp = sinp + (et * 16 + l15) * 64 + ks * 32 + quad * 8;
                const float4 s0 = *(const float4*)sp, s1 = *(const float4*)(sp + 4);
                sfr[ks][et].x = cvt_pk(s0.x, s0.y); sfr[ks][et].y = cvt_pk(s0.z, s0.w); sfr[ks][et].z = cvt_pk(s1.x, s1.y); sfr[ks][et].w = cvt_pk(s1.z, s1.w);
            }
    }
    if (w < 2) {
        const int dir = w;
        const float lb = hgrn_lower(p, l, dir, h * 64 + lane);
        const bf16_t* zp = U + (size_t)tokbase * UC + 768 + dir * 256 + h * 64 + lane;
        float run = 0.f;
        const int step = dir ? -UC : UC, di = dir ? -1 : 1;
        int i = dir ? 63 : 0;
        zp += (size_t)i * UC;
        float* bw = bc + (dir * 64 + i) * 68 + lane; bf16_t* kw = kk + (dir * 64 + i) * 72 + lane;
        {
            bf16_t zz[64];
#pragma unroll
            for (int ii = 0; ii < 64; ++ii) zz[ii] = zp[(ptrdiff_t)ii * step];
#pragma unroll
            for (int ii = 0; ii < 64; ++ii) {
                const float z = bf2f(zz[ii]);
                const float sg = sigmoidf_(z), f = sg + lb * (1.f - sg);
                run += __logf(f);
                bw[ii * di * 68] = run; kw[ii * di * 72] = f2bf((1.f - lb) * (1.f - sg));
            }
        }
    } else if (w == 2) {
        const bf16_t* qp = U + (size_t)tokbase * UC + 512 + h * 64 + lane;
        {
            bf16_t t[64];
#pragma unroll
            for (int i = 0; i < 64; ++i) t[i] = qp[(size_t)i * UC];
#pragma unroll
            for (int i = 0; i < 64; ++i) qq[i * 72 + lane] = t[i];
        }
    } else {
        const bf16_t* vp = U + (size_t)tokbase * UC + 1280 + h * 64 + lane;
        {
            bf16_t t[64];
#pragma unroll
            for (int i = 0; i < 64; ++i) t[i] = vp[(size_t)i * UC];
#pragma unroll
            for (int i = 0; i < 64; ++i) vT[lane * 72 + i] = t[i];
        }
    }
    __syncthreads();
    const int dir = w & 1, iset = w >> 1;
    const int seq = (dir * 8 + b) * 4 + h, cs = dir ? 63 - c : c;
    const float* bcd = bc + dir * 64 * 68;
    const bf16_t* kkd = kk + dir * 64 * 72;
    f32x4 o[4][2];
#pragma unroll
    for (int et = 0; et < 4; ++et) { o[et][0] = (f32x4){0.f, 0.f, 0.f, 0.f}; o[et][1] = (f32x4){0.f, 0.f, 0.f, 0.f}; }
#pragma unroll
    for (int ii = 0; ii < 2; ++ii) {
        const int I = iset == 0 ? (ii == 0 ? 0 : 3) : (ii == 0 ? 1 : 2);
        const int irow = 16 * I + l15;
#pragma unroll
        for (int ks = 0; ks < 2; ++ks) {
            const int d0 = ks * 32 + quad * 8;
            const bf16x8 bq = hg_frag(qq + irow * 72 + d0, bcd + irow * 68 + d0, nullptr, true);
#pragma unroll
            for (int et = 0; et < 4; ++et) o[et][ii] = MFMA16(__builtin_bit_cast(bf16x8, sfr[ks][et]), bq, o[et][ii]);
        }
#pragma unroll
        for (int kk2 = 0; kk2 < 2; ++kk2) {
            f32x4 at[2];
            bool any = false;
#pragma unroll
            for (int jj = 0; jj < 2; ++jj) {
                const int J = 2 * kk2 + jj;
                at[jj] = (f32x4){0.f, 0.f, 0.f, 0.f};
                const bool active = dir == 0 ? (J <= I) : (J >= I);
                if (active) {
                    any = true;
                    const float* ref = nullptr;
                    if (dir == 0) { if (J > 0) ref = bcd + (16 * J - 1) * 68; } else { if (J < 3) ref = bcd + (16 * J + 16) * 68; }
                    const int srow = 16 * J + l15;
#pragma unroll
                    for (int ks = 0; ks < 2; ++ks) {
                        const int d0 = ks * 32 + quad * 8;
                        const bf16x8 ak = hg_frag(kkd + srow * 72 + d0, bcd + srow * 68 + d0, ref ? ref + d0 : nullptr, false);
                        const bf16x8 bq = hg_frag(qq + irow * 72 + d0, bcd + irow * 68 + d0, ref ? ref + d0 : nullptr, true);
                        at[jj] = MFMA16(ak, bq, at[jj]);
                    }
                    if (J == I) {
#pragma unroll
                        for (int r = 0; r < 4; ++r) {
                            const int sl = quad * 4 + r;
                            const bool keep = dir == 0 ? (sl <= l15) : (sl >= l15);
                            if (!keep) at[jj][r] = 0.f;
                        }
                    }
                }
            }
            if (any) {
                u32x4 pbw; pbw.x = cvt_pk(at[0][0], at[0][1]); pbw.y = cvt_pk(at[0][2], at[0][3]); pbw.z = cvt_pk(at[1][0], at[1][1]); pbw.w = cvt_pk(at[1][2], at[1][3]);
                const bf16x8 pb = __builtin_bit_cast(bf16x8, pbw);
#pragma unroll
                for (int et = 0; et < 4; ++et) {
                    const bf16_t* vp = vT + (et * 16 + l15) * 72 + kk2 * 32 + quad * 4;
                    const u32x2 lo = *(const u32x2*)vp, hi = *(const u32x2*)(vp + 16);
                    u32x4 a; a.x = lo.x; a.y = lo.y; a.z = hi.x; a.w = hi.y;
                    o[et][ii] = MFMA16(__builtin_bit_cast(bf16x8, a), pb, o[et][ii]);
                }
            }
        }
    }
    __syncthreads();
    float* ob = (float*)smem;
    if (dir == 1) {
#pragma unroll
        for (int ii = 0; ii < 2; ++ii) {
            const int I = iset == 0 ? (ii == 0 ? 0 : 3) : (ii == 0 ? 1 : 2);
#pragma unroll
            for (int et = 0; et < 4; ++et) *(f32x4*)(ob + (16 * I + l15) * 68 + et * 16 + quad * 4) = o[et][ii];
        }
    }
    __syncthreads();
    if (dir == 0) {
#pragma unroll
        for (int ii = 0; ii < 2; ++ii) {
            const int I = iset == 0 ? (ii == 0 ? 0 : 3) : (ii == 0 ? 1 : 2);
            const int tok = tokbase + 16 * I + l15;
            float ss = 0.f;
#pragma unroll
            for (int et = 0; et < 4; ++et) {
                o[et][ii] += *(const f32x4*)(ob + (16 * I + l15) * 68 + et * 16 + quad * 4);
                ss += o[et][ii][0] * o[et][ii][0] + o[et][ii][1] * o[et][ii][1] + o[et][ii][2] * o[et][ii][2] + o[et][ii][3] * o[et][ii][3];
            }
            ss += __shfl_xor(ss, 16); ss += __shfl_xor(ss, 32);
            const float rh = __builtin_amdgcn_rsqf(ss * (1.f / 64.f) + EPS);
            float ssy = 0.f;
#pragma unroll
            for (int et = 0; et < 4; ++et) {
                const int e = et * 16 + quad * 4;
                const u32x2 gg = *(const u32x2*)(U + (size_t)tok * UC + 1536 + h * 64 + e);
                const float4 og = *(const float4*)(p.in[I_HONG] + l * 256 + h * 64 + e);
                const float g0 = bflo(gg.x), g1 = bfhi(gg.x), g2 = bflo(gg.y), g3 = bfhi(gg.y);
                const float y0 = o[et][ii][0] * rh * og.x * g0 * sigmoidf_(g0), y1 = o[et][ii][1] * rh * og.y * g1 * sigmoidf_(g1);
                const float y2 = o[et][ii][2] * rh * og.z * g2 * sigmoidf_(g2), y3 = o[et][ii][3] * rh * og.w * g3 * sigmoidf_(g3);
                ssy += y0 * y0 + y1 * y1 + y2 * y2 + y3 * y3;
                u32x2 ov; ov.x = cvt_pk(y0, y1); ov.y = cvt_pk(y2, y3);
                *(u32x2*)(CAT + (size_t)tok * DM + h * 64 + e) = ov;
            }
            ssy += __shfl_xor(ssy, 16); ssy += __shfl_xor(ssy, 32);
            if (quad == 0) SSQB[(size_t)tok * 4 + h] = ssy;
        }
    }
    __syncthreads();
}

DI void mla_finish_tile(const Params& p, int l, int item, unsigned char* smem) {
    const bf16_t* U = (const bf16_t*)(p.ws + OFF_U);
    const bf16_t* QR = (const bf16_t*)((const unsigned char*)p.out + QRAW_IN_OUT);
    const bf16_t* KVR = (const bf16_t*)((const unsigned char*)p.out + KVRAW_IN_OUT);
    bf16_t* MQ = (bf16_t*)(p.ws + OFF_MQ);
    bf16_t* MK = (bf16_t*)(p.ws + OFF_MK);
    bf16_t* MVT = (bf16_t*)(p.ws + OFF_MVT);
    const float* CS = (const float*)(p.ws + OFF_ROPE);
    const float* SN = CS + (size_t)T_TOK * 16;
    bf16_t* vbuf = (bf16_t*)smem;
    const int w = tidx() >> 6, lane = tidx() & 63, h = lane >> 4, j = lane & 15;
    const float4 qg = *(const float4*)(p.in[I_MQNG] + l * 96 + 4 * j), kg = *(const float4*)(p.in[I_MKNG] + l * 96 + 4 * j);
    const float qg1 = p.in[I_MQNG][l * 96 + 64 + j], qg2 = p.in[I_MQNG][l * 96 + 80 + j];
    const float kg1 = p.in[I_MKNG][l * 96 + 64 + j], kg2 = p.in[I_MKNG][l * 96 + 80 + j];
#pragma unroll 4
    for (int r = 0; r < 16; ++r) {
        const int tl = w * 16 + r, tok = item * 64 + tl;
        const bf16_t* up = U + (size_t)tok * UC;
        float sq, skv;
        { const u32x2 a = *(const u32x2*)(up + 2560 + lane * 4);
          const float a0 = bflo(a.x), a1 = bfhi(a.x), a2 = bflo(a.y), a3 = bfhi(a.y);
          sq = __builtin_amdgcn_rsqf(wave_sum(a0 * a0 + a1 * a1 + a2 * a2 + a3 * a3) * (1.f / 256.f) + EPS);
          const unsigned c = *(const unsigned*)(up + 2816 + lane * 2);
          const float c0 = bflo(c), c1 = bfhi(c);
          skv = __builtin_amdgcn_rsqf(wave_sum(c0 * c0 + c1 * c1) * (1.f / 128.f) + EPS); }
        const float cs = CS[(size_t)tok * 16 + j], sn = SN[(size_t)tok * 16 + j];
        {
            const bf16_t* qp = QR + (size_t)tok * 384 + h * 96;
            const u32x2 a = *(const u32x2*)(qp + 4 * j);
            float q0 = bflo(a.x) * sq, q1 = bfhi(a.x) * sq, q2 = bflo(a.y) * sq, q3 = bfhi(a.y) * sq;
            float x1 = bf2f(qp[64 + j]) * sq, x2 = bf2f(qp[80 + j]) * sq;
            float ss = q0 * q0 + q1 * q1 + q2 * q2 + q3 * q3 + x1 * x1 + x2 * x2;
            ss += __shfl_xor(ss, 1); ss += __shfl_xor(ss, 2); ss += __shfl_xor(ss, 4); ss += __shfl_xor(ss, 8);
            const float rn = __builtin_amdgcn_rsqf(ss * (1.f / 96.f) + EPS);
            q0 *= rn * qg.x; q1 *= rn * qg.y; q2 *= rn * qg.z; q3 *= rn * qg.w; x1 *= rn * qg1; x2 *= rn * qg2;
            bf16_t* op = MQ + (size_t)tok * 384 + h * 96;
            u32x2 ov; ov.x = cvt_pk(q0, q1); ov.y = cvt_pk(q2, q3);
            *(u32x2*)(op + 4 * j) = ov;
            op[64 + j] = f2bf(x1 * cs - x2 * sn); op[80 + j] = f2bf(x2 * cs + x1 * sn);
        }
        {
            const bf16_t* kp = KVR + (size_t)tok * 512 + h * 128;
            const u32x2 a = *(const u32x2*)(kp + 4 * j);
            float k0 = bflo(a.x) * skv, k1 = bfhi(a.x) * skv, k2 = bflo(a.y) * skv, k3 = bfhi(a.y) * skv;
            float x1 = bf2f(up[2944 + j]), x2 = bf2f(up[2960 + j]);
            float ss = k0 * k0 + k1 * k1 + k2 * k2 + k3 * k3 + x1 * x1 + x2 * x2;
            ss += __shfl_xor(ss, 1); ss += __shfl_xor(ss, 2); ss += __shfl_xor(ss, 4); ss += __shfl_xor(ss, 8);
            const float rn = __builtin_amdgcn_rsqf(ss * (1.f / 96.f) + EPS);
            k0 *= rn * kg.x; k1 *= rn * kg.y; k2 *= rn * kg.z; k3 *= rn * kg.w; x1 *= rn * kg1; x2 *= rn * kg2;
            bf16_t* op = MK + (size_t)tok * 384 + h * 96;
            u32x2 ov; ov.x = cvt_pk(k0, k1); ov.y = cvt_pk(k2, k3);
            *(u32x2*)(op + 4 * j) = ov;
            op[64 + j] = f2bf(x1 * cs - x2 * sn); op[80 + j] = f2bf(x2 * cs + x1 * sn);
            const u32x2 vv = *(const u32x2*)(kp + 64 + 4 * j);
            u32x2 vo; vo.x = cvt_pk(bflo(vv.x) * skv, bfhi(vv.x) * skv); vo.y = cvt_pk(bflo(vv.y) * skv, bfhi(vv.y) * skv);
            *(u32x2*)(vbuf + tl * 256 + h * 64 + 4 * j) = vo;
        }
    }
    __syncthreads();
    {
        const int tid = tidx(), b = (item * 64) / SEQ, s0 = (item * 64) % SEQ, hh = tid >> 6, e = tid & 63;
        bf16_t* dst = MVT + ((size_t)(b * 4 + hh) * 64 + e) * SEQ + s0;
#pragma unroll
        for (int c8 = 0; c8 < 8; ++c8) {
            unsigned wds[4];
#pragma unroll
            for (int k = 0; k < 4; ++k) wds[k] = (unsigned)vbuf[(c8 * 8 + 2 * k) * 256 + tid] | ((unsigned)vbuf[(c8 * 8 + 2 * k + 1) * 256 + tid] << 16);
            uint4 o; o.x = wds[0]; o.y = wds[1]; o.z = wds[2]; o.w = wds[3];
            *(uint4*)(dst + c8 * 8) = o;
        }
    }
    __syncthreads();
}

DI void memkv_finish_tile(const Params& p, int item, unsigned char* smem) {
    const bf16_t* KVM = (const bf16_t*)(p.ws + OFF_KVMEM);
    bf16_t* XK = (bf16_t*)(p.ws + OFF_XK);
    bf16_t* XVT = (bf16_t*)(p.ws + OFF_XVT);
    bf16_t* vbuf = (bf16_t*)smem;
    const int l = item >> 5, b = (item >> 2) & 7, h = item & 3;
    const int w = tidx() >> 6, lane = tidx() & 63;
    const float kg = p.in[I_XKNG][l * 64 + lane];
    for (int r = 0; r < 64; ++r) {
        const int m = w * 64 + r;
        const bf16_t* src = KVM + ((size_t)l * 2048 + b * 256 + m) * 512 + h * 128;
        const float k = bf2f(src[lane]);
        const float rn = __builtin_amdgcn_rsqf(wave_sum(k * k) * (1.f / 64.f) + EPS);
        XK[(((size_t)(l * 8 + b) * 4 + h) * 256 + m) * 64 + lane] = f2bf(k * rn * kg);
        vbuf[m * 64 + lane] = src[64 + lane];
    }
    __syncthreads();
    {
        const int tid = tidx(), e = tid & 63, mq = tid >> 6;
        bf16_t* dst = XVT + (((size_t)(l * 8 + b) * 4 + h) * 64 + e) * 256 + mq * 64;
#pragma unroll
        for (int c8 = 0; c8 < 8; ++c8) {
            unsigned wds[4];
#pragma unroll
            for (int k = 0; k < 4; ++k) wds[k] = (unsigned)vbuf[(mq * 64 + c8 * 8 + 2 * k) * 64 + e] | ((unsigned)vbuf[(mq * 64 + c8 * 8 + 2 * k + 1) * 64 + e] << 16);
            uint4 o; o.x = wds[0]; o.y = wds[1]; o.z = wds[2]; o.w = wds[3];
            *(uint4*)(dst + c8 * 8) = o;
        }
    }
    __syncthreads();
}

template <int DQK, bool QNORM>
DI void attn_tile(const bf16_t* __restrict__ Q, int qs, const bf16_t* __restrict__ Kp, int kstr, const bf16_t* __restrict__ Vt, int vstr, int nkeys,
                  float c2, float mbound, const float* __restrict__ qgain, bf16_t* __restrict__ O, int os, float* __restrict__ ssq, int ssq_stride, unsigned char* smem) {
    constexpr int NKS = DQK / 32, KP = DQK * 2 + 16, KCH = DQK / 8, KB = 64 * KP, VB = 64 * 144, STG = KB + VB, NKL = (64 * KCH) / 256;
    const int tid = tidx(), w = tid >> 6, lane = tid & 63, l15 = lane & 15, quad = lane >> 4;
    bf16x8 bq[2][NKS];
#pragma unroll
    for (int qt = 0; qt < 2; ++qt) {
        const bf16_t* qp = Q + (size_t)(w * 32 + qt * 16 + l15) * qs + quad * 8;
        if (QNORM) {
            float v[NKS][8]; float ss = 0.f;
#pragma unroll
            for (int ks = 0; ks < NKS; ++ks) {
                const uint4 x = *(const uint4*)(qp + ks * 32);
                v[ks][0] = bflo(x.x); v[ks][1] = bfhi(x.x); v[ks][2] = bflo(x.y); v[ks][3] = bfhi(x.y); v[ks][4] = bflo(x.z); v[ks][5] = bfhi(x.z); v[ks][6] = bflo(x.w); v[ks][7] = bfhi(x.w);
#pragma unroll
                for (int j = 0; j < 8; ++j) ss += v[ks][j] * v[ks][j];
            }
            ss += __shfl_xor(ss, 16); ss += __shfl_xor(ss, 32);
            const float rn = __builtin_amdgcn_rsqf(ss * (1.f / DQK) + EPS);
#pragma unroll
            for (int ks = 0; ks < NKS; ++ks) {
                const float* gp = qgain + ks * 32 + quad * 8;
                u32x4 o;
                o.x = cvt_pk(v[ks][0] * rn * gp[0], v[ks][1] * rn * gp[1]); o.y = cvt_pk(v[ks][2] * rn * gp[2], v[ks][3] * rn * gp[3]);
                o.z = cvt_pk(v[ks][4] * rn * gp[4], v[ks][5] * rn * gp[5]); o.w = cvt_pk(v[ks][6] * rn * gp[6], v[ks][7] * rn * gp[7]);
                bq[qt][ks] = __builtin_bit_cast(bf16x8, o);
            }
        } else {
#pragma unroll
            for (int ks = 0; ks < NKS; ++ks) bq[qt][ks] = *(const bf16x8*)(qp + ks * 32);
        }
    }
    f32x4 o[4][2];
    float lrun[2];
#pragma unroll
    for (int qt = 0; qt < 2; ++qt) {
        lrun[qt] = 0.f;
#pragma unroll
        for (int et = 0; et < 4; ++et) o[et][qt] = (f32x4){0.f, 0.f, 0.f, 0.f};
    }
    uint4 ak0, ak1, ak2, av0, av1, bk0, bk1, bk2, bv0, bv1;
    ak2 = make_uint4(0u, 0u, 0u, 0u); bk2 = ak2;
    const int kr0 = tid / KCH, kc0 = tid % KCH, kr1 = (tid + 256) / KCH, kc1 = (tid + 256) % KCH, kr2 = (tid + 512) / KCH, kc2 = (tid + 512) % KCH;
    const int vr0 = tid >> 3, vc0 = tid & 7, vr1 = vr0 + 32;
#define A_LOAD(S, key0) do { S##k0 = *(const uint4*)(Kp + (size_t)((key0) + kr0) * kstr + kc0 * 8); S##k1 = *(const uint4*)(Kp + (size_t)((key0) + kr1) * kstr + kc1 * 8); \
                          if (NKL > 2) S##k2 = *(const uint4*)(Kp + (size_t)((key0) + kr2) * kstr + kc2 * 8); \
                          S##v0 = *(const uint4*)(Vt + (size_t)vr0 * vstr + (key0) + vc0 * 8); S##v1 = *(const uint4*)(Vt + (size_t)vr1 * vstr + (key0) + vc0 * 8); } while (0)
#define A_STORE(S, buf) do { unsigned char* kb_ = smem + (buf) * STG; unsigned char* vb_ = kb_ + KB; \
                          *(uint4*)(kb_ + kr0 * KP + kc0 * 16) = S##k0; *(uint4*)(kb_ + kr1 * KP + kc1 * 16) = S##k1; if (NKL > 2) *(uint4*)(kb_ + kr2 * KP + kc2 * 16) = S##k2; \
                          *(uint4*)(vb_ + vr0 * 144 + vc0 * 16) = S##v0; *(uint4*)(vb_ + vr1 * 144 + vc0 * 16) = S##v1; } while (0)
    const int nkb = nkeys >> 6;
    A_LOAD(a, 0); A_STORE(a, 0);
    A_LOAD(b, 64);
    if (2 < nkb) A_LOAD(a, 128);
    __syncthreads();
#define A_COMPUTE(cur) do { \
        const unsigned char* kb = smem + cur * STG; const unsigned char* vb = kb + KB; \
        f32x4 s[4][2]; \
_Pragma("unroll")         for (int kt = 0; kt < 4; ++kt) { s[kt][0] = (f32x4){0.f, 0.f, 0.f, 0.f}; s[kt][1] = (f32x4){0.f, 0.f, 0.f, 0.f}; } \
_Pragma("unroll")         for (int ks = 0; ks < NKS; ++ks) { \
            bf16x8 ak[4]; \
_Pragma("unroll")             for (int kt = 0; kt < 4; ++kt) ak[kt] = *(const bf16x8*)(kb + (kt * 16 + l15) * KP + ks * 64 + quad * 16); \
_Pragma("unroll")             for (int kt = 0; kt < 4; ++kt) { s[kt][0] = MFMA16(ak[kt], bq[0][ks], s[kt][0]); s[kt][1] = MFMA16(ak[kt], bq[1][ks], s[kt][1]); } \
        } \
        bf16x8 pb[2][2]; \
_Pragma("unroll")         for (int qt = 0; qt < 2; ++qt) { \
            float ls = 0.f; \
            float pv[4][4]; \
_Pragma("unroll")             for (int kt = 0; kt < 4; ++kt) \
_Pragma("unroll")                 for (int r = 0; r < 4; ++r) { pv[kt][r] = __builtin_amdgcn_exp2f(s[kt][qt][r] * c2 - mbound); ls += pv[kt][r]; } \
            lrun[qt] += ls; \
_Pragma("unroll")             for (int k2 = 0; k2 < 2; ++k2) { \
                u32x4 pw; pw.x = cvt_pk(pv[2 * k2][0], pv[2 * k2][1]); pw.y = cvt_pk(pv[2 * k2][2], pv[2 * k2][3]); \
                pw.z = cvt_pk(pv[2 * k2 + 1][0], pv[2 * k2 + 1][1]); pw.w = cvt_pk(pv[2 * k2 + 1][2], pv[2 * k2 + 1][3]); \
                pb[qt][k2] = __builtin_bit_cast(bf16x8, pw); \
            } \
        } \
_Pragma("unroll")         for (int k2 = 0; k2 < 2; ++k2) \
_Pragma("unroll")             for (int et = 0; et < 4; ++et) { \
                const unsigned char* vp = vb + (et * 16 + l15) * 144 + k2 * 64 + quad * 8; \
                const u32x2 lo = *(const u32x2*)vp, hi = *(const u32x2*)(vp + 32); \
                u32x4 a; a.x = lo.x; a.y = lo.y; a.z = hi.x; a.w = hi.y; \
                const bf16x8 av = __builtin_bit_cast(bf16x8, a); \
                o[et][0] = MFMA16(av, pb[0][k2], o[et][0]); \
                o[et][1] = MFMA16(av, pb[1][k2], o[et][1]); \
            } \
    } while (0)
#pragma unroll 1
    for (int jb = 0; jb < nkb; jb += 2) {
        A_STORE(b, 1);
        if (jb + 3 < nkb) A_LOAD(b, (jb + 3) * 64);
        __builtin_amdgcn_sched_barrier(0);
        A_COMPUTE(0);
        __syncthreads();
        if (jb + 2 < nkb) A_STORE(a, 0);
        if (jb + 4 < nkb) A_LOAD(a, (jb + 4) * 64);
        __builtin_amdgcn_sched_barrier(0);
        A_COMPUTE(1);
        __syncthreads();
    }
#undef A_COMPUTE
#undef A_LOAD
#undef A_STORE
#pragma unroll
    for (int qt = 0; qt < 2; ++qt) {
        float lt = lrun[qt]; lt += __shfl_xor(lt, 16); lt += __shfl_xor(lt, 32);
        const float inv = 1.f / lt;
        const int q = w * 32 + qt * 16 + l15;
        float ss = 0.f;
#pragma unroll
        for (int et = 0; et < 4; ++et) {
            const float y0 = o[et][qt][0] * inv, y1 = o[et][qt][1] * inv, y2 = o[et][qt][2] * inv, y3 = o[et][qt][3] * inv;
            ss += y0 * y0 + y1 * y1 + y2 * y2 + y3 * y3;
            u32x2 ov; ov.x = cvt_pk(y0, y1); ov.y = cvt_pk(y2, y3);
            *(u32x2*)(O + (size_t)q * os + et * 16 + quad * 4) = ov;
        }
        if (ssq) { ss += __shfl_xor(ss, 16); ss += __shfl_xor(ss, 32); if (quad == 0) ssq[(size_t)q * ssq_stride] = ss; }
    }
}

namespace pg8 {
#define PG8_LAS __attribute__((address_space(3)))
constexpr int BM = 256, BK = 64, HALF = 128, HTB = HALF * BK * 2, STAGE_BYTES = 8 * HTB, NXCD = 8, WGM = 8;
DI int lds_byte(int r, int c) { const int st = (r >> 4) * 2 + (c >> 5), rr = r & 15, cc = c & 31, ob = rr * 64 + cc * 2; return st * 1024 + (ob ^ (((ob >> 9) & 1) << 5)); }
DI void stage_rc(int b, int& R, int& C) { const int st = b / 1024, sb = b % 1024, swz = sb ^ (((sb >> 9) & 1) << 5); R = (st >> 1) * 16 + swz / 64; C = (st & 1) * 32 + (swz % 64) / 2; }
struct Unit { int pm, pn; };
struct Gemm { const bf16_t* A; const bf16_t* Bt; int M, N, K; };
struct StaticOrder {
    int nM, nN, nwg, G, c;
    DI void init(int M, int N, int G_, int c_) { nM = M / BM; nN = N / BM; nwg = nM * nN; G = G_; c = c_; }
    DI bool next(int i, Unit& u) const {
        const long L = (long)i * G + c; if (L >= nwg) return false;
        int wgid = (int)L; { const int q = nwg / NXCD, r = nwg % NXCD, xcd = wgid % NXCD, off = wgid / NXCD; wgid = (xcd < r ? xcd * (q + 1) : r * (q + 1) + (xcd - r) * q) + off; }
        const int nig = WGM * nN, gid = wgid / nig, fm = gid * WGM, gsz = (nM - fm) < WGM ? (nM - fm) : WGM;
        u.pm = fm + ((wgid % nig) % gsz); u.pn = (wgid % nig) / gsz; return true;
    }
};
DI float row_rstd(const float* part, int row) {
    const float4* p4 = (const float4*)(part + (size_t)row * 16);
    const float4 a = p4[0], b = p4[1], c = p4[2], d = p4[3];
    const float s = (a.x + a.y + a.z + a.w) + (b.x + b.y + b.z + b.w) + (c.x + c.y + c.z + c.w) + (d.x + d.y + d.z + d.w);
    return __builtin_amdgcn_rsqf(s * (1.f / DM) + EPS);
}
struct EpiScaled {
    bf16_t* O; int ldo; const float* part;
    DI void operator()(const f32x4 (&acc)[2][2][4][2], const Unit& u, int wr, int wc, int fr, int fq) const {
#pragma unroll
        for (int ai = 0; ai < 2; ++ai)
#pragma unroll
            for (int m = 0; m < 4; ++m) {
                const int row = u.pm * BM + ai * HALF + wr * 64 + m * 16 + fr;
                const float sc = row_rstd(part, row);
                bf16_t* rowp = O + (size_t)row * ldo + u.pn * BM + wc * 32 + fq * 4;
#pragma unroll
                for (int bj = 0; bj < 2; ++bj)
#pragma unroll
                    for (int n = 0; n < 2; ++n) {
                        u32x2 v; v.x = cvt_pk(acc[ai][bj][m][n][0] * sc, acc[ai][bj][m][n][1] * sc); v.y = cvt_pk(acc[ai][bj][m][n][2] * sc, acc[ai][bj][m][n][3] * sc);
                        *(u32x2*)(rowp + bj * HALF + n * 16) = v;
                    }
            }
    }
};
struct EpiSwiglu {
    bf16_t* H; const float* part;
    DI void operator()(const f32x4 (&acc)[2][2][4][2], const Unit& u, int wr, int wc, int fr, int fq) const {
#pragma unroll
        for (int ai = 0; ai < 2; ++ai)
#pragma unroll
            for (int m = 0; m < 4; ++m) {
                const int row = u.pm * BM + ai * HALF + wr * 64 + m * 16 + fr;
                const float sc = row_rstd(part, row);
                bf16_t* rowp = H + (size_t)row * DFF + ((u.pn * BM + wc * 32) >> 1) + fq * 4;
#pragma unroll
                for (int bj = 0; bj < 2; ++bj) {
                    float h[4];
#pragma unroll
                    for (int j = 0; j < 4; ++j) { const float a1 = acc[ai][bj][m][0][j] * sc, a3 = acc[ai][bj][m][1][j] * sc; h[j] = a1 * sigmoidf_(a1) * a3; }
                    u32x2 v; v.x = cvt_pk(h[0], h[1]); v.y = cvt_pk(h[2], h[3]);
                    *(u32x2*)(rowp + bj * (HALF / 2)) = v;
                }
            }
    }
};
struct EpiResid {
    bf16_t* XB; float* rowsq; float* OUT;
    DI void operator()(const f32x4 (&acc)[2][2][4][2], const Unit& u, int wr, int wc, int fr, int fq) const {
#pragma unroll
        for (int ai = 0; ai < 2; ++ai)
#pragma unroll
            for (int m = 0; m < 4; ++m) {
                const int row = u.pm * BM + ai * HALF + wr * 64 + m * 16 + fr;
                float ss = 0.f;
#pragma unroll
                for (int bj = 0; bj < 2; ++bj)
#pragma unroll
                    for (int n = 0; n < 2; ++n) {
                        const int col = u.pn * BM + bj * HALF + wc * 32 + n * 16 + fq * 4;
                        u32x2* xp = (u32x2*)(XB + (size_t)row * DM + col);
                        const u32x2 xo = *xp;
                        const float x0 = bflo(xo.x) + acc[ai][bj][m][n][0], x1 = bfhi(xo.x) + acc[ai][bj][m][n][1];
                        const float x2 = bflo(xo.y) + acc[ai][bj][m][n][2], x3 = bfhi(xo.y) + acc[ai][bj][m][n][3];
                        u32x2 v; v.x = cvt_pk(x0, x1); v.y = cvt_pk(x2, x3);
                        *xp = v;
                        if (OUT) *(f32x4*)(OUT + (size_t)row * DM + col) = (f32x4){x0, x1, x2, x3};
                        ss += x0 * x0 + x1 * x1 + x2 * x2 + x3 * x3;
                    }
                ss += __shfl_xor(ss, 16); ss += __shfl_xor(ss, 32);
                if (fq == 0) rowsq[(size_t)row * 16 + u.pn * 4 + wc] = ss;
            }
    }
};

template <class Epi, bool SCALED = false>
DI void gemm_phase(PG8_LAS unsigned char* lds, const Gemm g, const StaticOrder& S, const Epi& E, const float* ssq0 = nullptr, const float* ssq1 = nullptr) {
    int tid = threadIdx.x; asm volatile("" : "+v"(tid));
    const int wid = __builtin_amdgcn_readfirstlane(tid >> 6), lane = tid & 63, wr = wid >> 2, wc = wid & 3, fr = lane & 15, fq = lane >> 4;
    const int K = g.K, nt = K / BK;
    unsigned voffA[2];
#pragma unroll
    for (int i = 0; i < 2; ++i) { int R, C; stage_rc(tid * 16 + i * 8192, R, C); voffA[i] = (unsigned)(R * K + C) * 2u; }
    const size_t kstep = (size_t)(BK * 2);
    const size_t hstep = (size_t)HALF * K * 2;
    const size_t tstep = 2 * hstep;
    const unsigned ldsw = (unsigned)wid * 1024u;
    const int aoff = lds_byte(wr * 64 + fr, fq * 8), boff = lds_byte(wc * 32 + fr, fq * 8);
#define PG8_SA(b, h) (((b) * 2 + (h)) * HTB)
#define PG8_SB(b, h) ((4 + (b) * 2 + (h)) * HTB)
#define PG8_STAGE(bufoff, gbase) do { _Pragma("unroll") for (int _i = 0; _i < 2; ++_i) \
        __builtin_amdgcn_global_load_lds((const unsigned*)((const char*)(gbase) + voffA[_i]), (PG8_LAS unsigned*)(lds + (bufoff) + ldsw + _i * 8192), 16, 0, 0); } while (0)
#define PG8_LDA(dst, b, h) do { _Pragma("unroll") for (int m = 0; m < 4; ++m) _Pragma("unroll") for (int k = 0; k < 2; ++k) dst[m][k] = *(const PG8_LAS bf16x8*)(lds + PG8_SA(b, h) + aoff + m * 2048 + k * 1024); } while (0)
#define PG8_LDB(dst, b, h) do { _Pragma("unroll") for (int n = 0; n < 2; ++n) _Pragma("unroll") for (int k = 0; k < 2; ++k) dst[n][k] = *(const PG8_LAS bf16x8*)(lds + PG8_SB(b, h) + boff + n * 2048 + k * 1024); } while (0)
#define PG8_MMA(ai, bj, At, Bt) do { __builtin_amdgcn_s_setprio(1); _Pragma("unroll") for (int m = 0; m < 4; ++m) _Pragma("unroll") for (int n = 0; n < 2; ++n) _Pragma("unroll") for (int k = 0; k < 2; ++k) \
        acc[ai][bj][m][n] = __builtin_amdgcn_mfma_f32_16x16x32_bf16(Bt[n][k], At[m][k], acc[ai][bj][m][n], 0, 0, 0); __builtin_amdgcn_s_setprio(0); } while (0)
#define PG8_WAIT_V(n) asm volatile("s_waitcnt vmcnt(" #n ")" ::: "memory")
#define PG8_WAIT_L(n) asm volatile("s_waitcnt lgkmcnt(" #n ")" ::: "memory")
#define PG8_BAR __builtin_amdgcn_s_barrier()
#define PG8_SCHED __builtin_amdgcn_sched_barrier(0)
    Unit cur, nxt; int ui = 0;
    if (!S.next(0, cur)) return;
    f32x4 acc[2][2][4][2];
#pragma unroll
    for (int a = 0; a < 2; ++a)
#pragma unroll
        for (int b = 0; b < 2; ++b)
#pragma unroll
            for (int m = 0; m < 4; ++m)
#pragma unroll
                for (int n = 0; n < 2; ++n) acc[a][b][m][n] = (f32x4){0.f, 0.f, 0.f, 0.f};
    bf16x8 At[4][2], B0[2][2], B1[2][2];
    const char* cA = (const char*)g.A + (size_t)cur.pm * tstep; const char* cB = (const char*)g.Bt + (size_t)cur.pn * tstep;
#define PG8_FTAB(unit) do { if (SCALED && tid < 256) { const int row_ = (unit).pm * BM + tid; \
        const float4 sb_ = *(const float4*)(ssq0 + (size_t)row_ * 4), sd_ = *(const float4*)(ssq1 + (size_t)row_ * 4); \
        const float rB_ = __builtin_amdgcn_rsqf((sb_.x + sb_.y + sb_.z + sb_.w) * (1.f / 256.f) + EPS), rD_ = __builtin_amdgcn_rsqf((sd_.x + sd_.y + sd_.z + sd_.w) * (1.f / 256.f) + EPS); \
        PG8_LAS float* ft_ = (PG8_LAS float*)(lds + STAGE_BYTES); ft_[tid] = rB_ / rD_; ft_[256 + tid] = rD_; } } while (0)
    PG8_FTAB(cur);
    PG8_STAGE(PG8_SB(0, 0), cB); PG8_STAGE(PG8_SB(0, 1), cB + hstep); PG8_STAGE(PG8_SA(0, 0), cA); PG8_STAGE(PG8_SA(0, 1), cA + hstep);
    if (wr == 1) PG8_BAR;
    PG8_WAIT_V(2); PG8_BAR;
    PG8_STAGE(PG8_SB(1, 0), cB + kstep); PG8_STAGE(PG8_SA(1, 0), cA + kstep); PG8_STAGE(PG8_SB(1, 1), cB + hstep + kstep);
    PG8_WAIT_V(6); PG8_BAR;
    for (;;) {
        const bool has_next = S.next(ui + 1, nxt);
        const char* nA = has_next ? (const char*)g.A + (size_t)nxt.pm * tstep : cA; const char* nB = has_next ? (const char*)g.Bt + (size_t)nxt.pn * tstep : cB;
        for (int t = 0; t < nt; t += 2) {
            const bool last = (t == nt - 2);
            const char* a1 = cA + (size_t)(t + 1) * kstep;
            const char* a2 = last ? nA : cA + (size_t)(t + 2) * kstep; const char* b2 = last ? nB : cB + (size_t)(t + 2) * kstep;
            const char* a3 = a2 + kstep; const char* b3 = b2 + kstep;
            if (SCALED && (t == 4 || t == 8)) {
                const PG8_LAS float* ft = (const PG8_LAS float*)(lds + STAGE_BYTES) + (t == 8 ? 256 : 0);
#pragma unroll
                for (int ai = 0; ai < 2; ++ai)
#pragma unroll
                    for (int m = 0; m < 4; ++m) {
                        const float f = ft[ai * HALF + wr * 64 + m * 16 + fr];
#pragma unroll
                        for (int bj = 0; bj < 2; ++bj)
#pragma unroll
                            for (int n = 0; n < 2; ++n) acc[ai][bj][m][n] *= f;
                    }
            }
            PG8_LDB(B0, 0, 0); PG8_LDB(B1, 0, 1); PG8_SCHED; PG8_LDA(At, 0, 0); PG8_STAGE(PG8_SA(1, 1), a1 + hstep);
            PG8_WAIT_V(8); PG8_WAIT_L(0); PG8_BAR; PG8_MMA(0, 0, At, B0); PG8_MMA(0, 1, At, B1); PG8_BAR; PG8_SCHED;
            PG8_LDA(At, 0, 1); PG8_STAGE(PG8_SB(0, 0), b2); PG8_STAGE(PG8_SB(0, 1), b2 + hstep); PG8_STAGE(PG8_SA(0, 0), a2);
            PG8_WAIT_V(8); PG8_WAIT_L(0); PG8_BAR; PG8_MMA(1, 0, At, B0); PG8_MMA(1, 1, At, B1); PG8_BAR; PG8_SCHED;
            PG8_LDB(B0, 1, 0); PG8_LDB(B1, 1, 1); PG8_SCHED; PG8_LDA(At, 1, 0); PG8_STAGE(PG8_SA(0, 1), a2 + hstep);
            PG8_WAIT_V(8); PG8_WAIT_L(0); PG8_BAR; PG8_MMA(0, 0, At, B0); PG8_MMA(0, 1, At, B1); PG8_BAR; PG8_SCHED;
            PG8_LDA(At, 1, 1); PG8_STAGE(PG8_SB(1, 0), b3); PG8_STAGE(PG8_SB(1, 1), b3 + hstep); PG8_STAGE(PG8_SA(1, 0), a3);
            PG8_WAIT_V(8); PG8_WAIT_L(0); PG8_BAR; PG8_MMA(1, 0, At, B0); PG8_MMA(1, 1, At, B1); PG8_BAR; PG8_SCHED;
        }
        if (wr == 0) PG8_BAR;
        E(acc, cur, wr, wc, fr, fq);
        if (!has_next) break;
#pragma unroll
        for (int a = 0; a < 2; ++a)
#pragma unroll
            for (int b = 0; b < 2; ++b)
#pragma unroll
                for (int m = 0; m < 4; ++m)
#pragma unroll
                    for (int n = 0; n < 2; ++n) acc[a][b][m][n] = (f32x4){0.f, 0.f, 0.f, 0.f};
        cur = nxt; cA = nA; cB = nB; ++ui;
        if (wr == 1) PG8_BAR;
        PG8_FTAB(cur);
    }
    PG8_WAIT_V(0);
    PG8_BAR;
#undef PG8_FTAB
#undef PG8_SA
#undef PG8_SB
#undef PG8_STAGE
#undef PG8_LDA
#undef PG8_LDB
#undef PG8_MMA
#undef PG8_WAIT_V
#undef PG8_WAIT_L
#undef PG8_BAR
#undef PG8_SCHED
}
}

enum { PH_PRO = 0, PH_CONV, PH_P1, PH_P2, PH_P3, PH_P4, PH_P5, PH_P6, PH_P7, PH_P8, PH_P9, PH_P10, PH_COUNT };

DI void gemm_item_bf16(const bf16_t* A, int lda, const bf16_t* Bt, int K, int nM, int nN, int L, bf16_t* O, int ldo, const float* part, int npart, float inv_n, unsigned char* smem) {
    int pm, pn; tile_order(L, nM, nN, pm, pn);
    if (part) fill_rs(smem, part, npart, pm * 128, inv_n);
    f32x4 acc[4][4];
    gemm_mainloop<false>(A, lda, Bt, K, pm * 128, pn * 128, smem, acc);
    epi_bf16(acc, O, ldo, pm * 128, pn * 128, part ? (const float*)(smem + 65536) : nullptr);
    __syncthreads();
}
template <bool ASC>
DI void gemm_item_resid(const Params& p, const bf16_t* A, int lda, const bf16_t* Bt, int K, int L, unsigned char* smem) {
    int pm, pn; tile_order(L, 256, 8, pm, pn);
    if (ASC) {
        float* asc = (float*)(smem + 66048);
        const float* sb = (const float*)(p.ws + OFF_SSQB); const float* sd = (const float*)(p.ws + OFF_SSQD);
        const int tid = tidx();
        if (tid < 128) {
            const float4 a = *(const float4*)(sb + (size_t)(pm * 128 + tid) * 4), d = *(const float4*)(sd + (size_t)(pm * 128 + tid) * 4);
            asc[tid * 2] = __builtin_amdgcn_rsqf((a.x + a.y + a.z + a.w) * (1.f / 256.f) + EPS);
            asc[tid * 2 + 1] = __builtin_amdgcn_rsqf((d.x + d.y + d.z + d.w) * (1.f / 256.f) + EPS);
        }
    }
    f32x4 acc[4][4];
    gemm_mainloop<ASC>(A, lda, Bt, K, pm * 128, pn * 128, smem, acc);
    epi_resid(acc, p.out, (bf16_t*)(p.ws + OFF_XB), (float*)(p.ws + OFF_ROWSQ), pm * 128, pn * 128);
    __syncthreads();
}

DI void run_phase(const Params& p, int ph, int l, unsigned char* smem0) {
    const int vb = __builtin_amdgcn_readfirstlane((int)(threadIdx.x >> 8));
    unsigned char* smem = smem0 + vb * LDS_BYTES;
    const int G = gridDim.x * 2, bid = blockIdx.x * 2 + vb;
    const bf16_t* W = (const bf16_t*)(p.ws + OFF_W);
    const bf16_t* XB = (const bf16_t*)(p.ws + OFF_XB);
    bf16_t* U = (bf16_t*)(p.ws + OFF_U);
    const float* ROWSQ = (const float*)(p.ws + OFF_ROWSQ);
#ifdef ONLY_PH
    if (ph != ONLY_PH) return;
#endif
    switch (ph) {
    case PH_PRO: {
        for (int i = bid; i < 2048; i += G) pro_rows(p.in[I_X], nullptr, (bf16_t*)(p.ws + OFF_XB), (float*)(p.ws + OFF_ROWSQ), 16, i);
        for (int i = bid; i < 128; i += G) pro_rows(p.in[I_MEM], nullptr, (bf16_t*)(p.ws + OFF_MEMB), (float*)(p.ws + OFF_MEMSQ), 1, i);
        for (int i = bid; i < 128; i += G) pro_rope(p, i);
        for (int i = bid; i < 512; i += G) { const int ll = i >> 7; conv_tile(p.in[I_XWKV] + (size_t)ll * DM * 512, DM, 512, 512, p.in[I_GMEM] + ll * DM, 0, (bf16_t*)(p.ws + OFF_XWKV) + (size_t)ll * 512 * DM, i & 127, smem); }
        for (int i = bid; i < CONV_TILES; i += G) conv_layer_item(p, 0, i, smem);
    } break;
    case PH_CONV: {
        for (int it = bid; it < CONV_TILES; it += G) conv_layer_item(p, l, it, smem);
    } break;
    case PH_P1: {
        { pg8::Gemm g{XB, W + W_IN, T_TOK, UC, DM}; pg8::StaticOrder S; S.init(T_TOK, UC, gridDim.x, blockIdx.x);
          pg8::EpiScaled E{U, UC, ROWSQ};
          pg8::gemm_phase<pg8::EpiScaled>((PG8_LAS unsigned char*)smem0, g, S, E); }
        if (l == 0) {
            for (int i = bid; i < 256; i += G) {
                const int ll = i >> 6;
                gemm_item_bf16((const bf16_t*)(p.ws + OFF_MEMB), DM, (const bf16_t*)(p.ws + OFF_XWKV) + (size_t)ll * 512 * DM, DM, 16, 4, i & 63,
                               (bf16_t*)(p.ws + OFF_KVMEM) + (size_t)ll * 2048 * 512, 512, (const float*)(p.ws + OFF_MEMSQ), 1, 1.f / DM, smem);
            }
        }
    } break;
    case PH_P2: {
        for (int i = bid; i < 1024; i += G) hgrn_local_tile(p, l, i, smem);
#ifdef RP2_HL
        for (int i = bid; i < 1024; i += G) hgrn_local_tile(p, l, i, smem);
#endif
        for (int i = bid; i < 1024; i += G) conformer_tile(p, l, i, smem);
#ifdef RP2_CF
        for (int i = bid; i < 1024; i += G) conformer_tile(p, l, i, smem);
#endif
#ifdef RP2_G
        for (int i = bid; i < 768; i += G) gemm_item_bf16(U + 2560, UC, W + W_UQ, 256, 256, 3, i, (bf16_t*)((unsigned char*)p.out + QRAW_IN_OUT), 384, nullptr, 0, 0.f, smem);
        for (int i = bid; i < 1024; i += G) gemm_item_bf16(U + 2816, UC, W + W_UKV, 128, 256, 4, i, (bf16_t*)((unsigned char*)p.out + KVRAW_IN_OUT), 512, nullptr, 0, 0.f, smem);
#endif
#ifdef RP2_SC
        for (int i = bid; i < 512; i += G) shortconv_tile(p, l, i);
#endif
        for (int i = bid; i < 768; i += G) gemm_item_bf16(U + 2560, UC, W + W_UQ, 256, 256, 3, i, (bf16_t*)((unsigned char*)p.out + QRAW_IN_OUT), 384, nullptr, 0, 0.f, smem);
        for (int i = bid; i < 1024; i += G) gemm_item_bf16(U + 2816, UC, W + W_UKV, 128, 256, 4, i, (bf16_t*)((unsigned char*)p.out + KVRAW_IN_OUT), 512, nullptr, 0, 0.f, smem);
        for (int i = bid; i < 512; i += G) shortconv_tile(p, l, i);
        if (l == 0) { for (int i = bid; i < 128; i += G) memkv_finish_tile(p, i, smem); }
    } break;
    case PH_P3: {
        for (int i = bid; i < 1024; i += G) hgrn_scan_item(p, i);
        for (int i = bid; i < 512; i += G) mla_finish_tile(p, l, i, smem);
#ifdef RP3_MF
        for (int i = bid; i < 512; i += G) mla_finish_tile(p, l, i, smem);
#endif
#ifdef RP3_SC
        for (int i = bid; i < 1024; i += G) hgrn_scan_dummy(p, i);
#endif
    } break;
    case PH_P4: {
        const float c2 = 0.10206207261596575f * 1.4426950408889634f;
        float mb;
        {
            const int ln = tidx() & 63;
            float gq = fmaxf(fabsf(p.in[I_MQNG][l * 96 + ln]), ln < 32 ? fabsf(p.in[I_MQNG][l * 96 + 64 + ln]) : 0.f);
            float gk = fmaxf(fabsf(p.in[I_MKNG][l * 96 + ln]), ln < 32 ? fabsf(p.in[I_MKNG][l * 96 + 64 + ln]) : 0.f);
#pragma unroll
            for (int o = 32; o > 0; o >>= 1) { gq = fmaxf(gq, __shfl_xor(gq, o)); gk = fmaxf(gk, __shfl_xor(gk, o)); }
            mb = 96.f * gq * gk * c2;
        }
        for (int it0 = bid; it0 < 1024; it0 += G) {
            const int xcd = blockIdx.x & 7, jx = ((blockIdx.x >> 3) << 1) + vb, loc = (it0 / G) * 64 + jx;
            const int it = (G == 512) ? (xcd * 128 + loc) : it0;
            const int bh = it >> 5, qt = it & 31, b = bh >> 2, h = bh & 3;
            const size_t tok0 = (size_t)b * SEQ + qt * 128;
            attn_tile<96, false>((const bf16_t*)(p.ws + OFF_MQ) + tok0 * 384 + h * 96, 384, (const bf16_t*)(p.ws + OFF_MK) + (size_t)b * SEQ * 384 + h * 96, 384,
                                 (const bf16_t*)(p.ws + OFF_MVT) + (size_t)bh * 64 * SEQ, SEQ, SEQ, c2, mb, nullptr,
                                 (bf16_t*)(p.ws + OFF_CAT) + tok0 * DM + 256 + h * 64, DM, (float*)(p.ws + OFF_SSQD) + tok0 * 4 + h, 4, smem);
        }
        for (int i = bid; i < 2048; i += G) hgrn_out_tile(p, l, i, smem);
#ifdef REPEAT_HGOUT
        for (int i = bid; i < 2048; i += G) hgrn_out_tile(p, l, i, smem);
#endif
    } break;
    case PH_P5: {
        pg8::Gemm g{(const bf16_t*)(p.ws + OFF_CAT), W + W_OUT, T_TOK, DM, DM}; pg8::StaticOrder S; S.init(T_TOK, DM, gridDim.x, blockIdx.x);
        pg8::EpiResid E{(bf16_t*)(p.ws + OFF_XB), (float*)(p.ws + OFF_ROWSQ), nullptr};
        pg8::gemm_phase<pg8::EpiResid, true>((PG8_LAS unsigned char*)smem0, g, S, E, (const float*)(p.ws + OFF_SSQB), (const float*)(p.ws + OFF_SSQD));
    } break;
    case PH_P6: {
        for (int it = bid; it < 512; it += G) gemm_item_bf16(XB, DM, W + W_XQ, DM, 256, 2, it, (bf16_t*)(p.ws + OFF_XQ), 256, ROWSQ, 16, 1.f / DM, smem);
    } break;
    case PH_P7: {
        const float c2 = 0.125f * 1.4426950408889634f;
        float mb;
        {
            const int ln = tidx() & 63;
            float gq = fabsf(p.in[I_XQNG][l * 64 + ln]), gk = fabsf(p.in[I_XKNG][l * 64 + ln]);
#pragma unroll
            for (int o = 32; o > 0; o >>= 1) { gq = fmaxf(gq, __shfl_xor(gq, o)); gk = fmaxf(gk, __shfl_xor(gk, o)); }
            mb = 64.f * gq * gk * c2;
        }
        for (int it0 = bid; it0 < 1024; it0 += G) {
            const int xcd = blockIdx.x & 7, jx = ((blockIdx.x >> 3) << 1) + vb, loc = (it0 / G) * 64 + jx;
            const int it = (G == 512) ? (xcd * 128 + loc) : it0;
            const int bh = it >> 5, qt = it & 31, b = bh >> 2, h = bh & 3;
            const size_t tok0 = (size_t)b * SEQ + qt * 128;
            attn_tile<64, true>((const bf16_t*)(p.ws + OFF_XQ) + tok0 * 256 + h * 64, 256, (const bf16_t*)(p.ws + OFF_XK) + ((size_t)(l * 8 + b) * 4 + h) * 256 * 64, 64,
                                (const bf16_t*)(p.ws + OFF_XVT) + ((size_t)(l * 8 + b) * 4 + h) * 64 * 256, 256, 256, c2, mb, p.in[I_XQNG] + l * 64,
                                (bf16_t*)(p.ws + OFF_XO) + tok0 * 256 + h * 64, 256, nullptr, 0, smem);
        }
    } break;
    case PH_P8: {
        pg8::Gemm g{(const bf16_t*)(p.ws + OFF_XO), W + W_XO, T_TOK, DM, 256}; pg8::StaticOrder S; S.init(T_TOK, DM, gridDim.x, blockIdx.x);
        pg8::EpiResid E{(bf16_t*)(p.ws + OFF_XB), (float*)(p.ws + OFF_ROWSQ), nullptr};
        pg8::gemm_phase<pg8::EpiResid>((PG8_LAS unsigned char*)smem0, g, S, E);
    } break;
    case PH_P9: {
        pg8::Gemm g{XB, W + W_13, T_TOK, 2 * DFF, DM}; pg8::StaticOrder S; S.init(T_TOK, 2 * DFF, gridDim.x, blockIdx.x);
        pg8::EpiSwiglu E{(bf16_t*)(p.ws + OFF_HFF), ROWSQ};
        pg8::gemm_phase<pg8::EpiSwiglu>((PG8_LAS unsigned char*)smem0, g, S, E);
    } break;
    case PH_P10: {
        pg8::Gemm g{(const bf16_t*)(p.ws + OFF_HFF), W + W_2, T_TOK, DM, DFF}; pg8::StaticOrder S; S.init(T_TOK, DM, gridDim.x, blockIdx.x);
        pg8::EpiResid E{(bf16_t*)(p.ws + OFF_XB), (float*)(p.ws + OFF_ROWSQ), (l == NL - 1) ? p.out : nullptr};
        pg8::gemm_phase<pg8::EpiResid>((PG8_LAS unsigned char*)smem0, g, S, E);
    } break;
    }
}

#define XB_TMO      128
#define XB_XCNT(j)  (256  + 64 * (j))
#define XB_XSUB(j)  (1280 + 64 * (j))
#define XB_XGEN(j)  (2304 + 64 * (j))
#define XB_TOP      3328
#define XB_TOPGEN   3392
#define XCD_BAR_WORDS 3456
#define XB_SPIN_CAP (1u << 22)
#define LAS __attribute__((address_space(3)))
DI unsigned xb_ld(unsigned* p)              { return __hip_atomic_load(p, __ATOMIC_RELAXED, __HIP_MEMORY_SCOPE_AGENT); }
DI unsigned xb_add(unsigned* p, unsigned v) { return __hip_atomic_fetch_add(p, v, __ATOMIC_RELAXED, __HIP_MEMORY_SCOPE_AGENT); }
DI unsigned xb_xcc_id() { return (unsigned)__builtin_amdgcn_s_getreg((3 << 11) | 20) & 0xFu; }
#define XB_SPIN(cond, bar) do { unsigned _sp = 0; while (cond) { __builtin_amdgcn_s_sleep(1); \
    if ((++_sp & 255u) == 0u) { if (xb_ld(&(bar)[XB_TMO])) break; if (_sp > XB_SPIN_CAP) { atomicAdd(&(bar)[XB_TMO], 1u); break; } } } } while (0)
struct XcdBarrier { unsigned* bar; unsigned x; volatile LAS unsigned* st; };
DI XcdBarrier xcd_barrier_post(unsigned* bar, volatile LAS unsigned* st) {
    XcdBarrier b; b.bar = bar; b.x = xb_xcc_id(); b.st = st;
    if (threadIdx.x == 0) (void)xb_add(&bar[XB_XCNT(b.x)], 1u);
    return b;
}
DI void xcd_barrier_complete(unsigned* bar, unsigned x, unsigned& nloc, unsigned& nx) {
    const unsigned G = gridDim.x * gridDim.y * gridDim.z;
    unsigned sum, cnt, mine, sp = 0u;
    for (;;) {
        sum = 0u; cnt = 0u; mine = 0u;
#pragma unroll
        for (unsigned j = 0; j < 16; ++j) { const unsigned c = xb_ld(&bar[XB_XCNT(j)]); sum += c; cnt += (c > 0u) ? 1u : 0u; mine = (j == x) ? c : mine; }
        if (sum == G) break;
        __builtin_amdgcn_s_sleep(1);
        if ((++sp & 255u) == 0u) { if (xb_ld(&bar[XB_TMO])) break; if (sp > XB_SPIN_CAP) { atomicAdd(&bar[XB_TMO], 1u); break; } }
    }
    nloc = mine > 0u ? mine : 1u; nx = cnt > 0u ? cnt : 1u;
}
DI void xcd_barrier(const XcdBarrier& b) {
    asm volatile("s_waitcnt vmcnt(0)" ::: "memory");
    __syncthreads();
    if (threadIdx.x == 0) {
        unsigned* bar = b.bar;
        __builtin_amdgcn_s_waitcnt(0);
        unsigned nloc = b.st[0], nx = b.st[1];
        if (nloc == 0u) { xcd_barrier_complete(bar, b.x, nloc, nx); b.st[0] = nloc; b.st[1] = nx; }
        const unsigned old = xb_add(&bar[XB_XSUB(b.x)], 1u);
        const unsigned gen = old / nloc;
        if (old + 1u == (gen + 1u) * nloc) {
            __builtin_amdgcn_fence(__ATOMIC_RELEASE, "agent");
            asm volatile("s_waitcnt vmcnt(0)" ::: "memory");
            const unsigned og = xb_add(&bar[XB_TOP], 1u);
            const unsigned tg = og / nx;
            if (og + 1u == (tg + 1u) * nx) xb_add(&bar[XB_TOPGEN], 1u);
            else XB_SPIN(xb_ld(&bar[XB_TOPGEN]) == tg, bar);
            __builtin_amdgcn_fence(__ATOMIC_ACQUIRE, "agent");
            xb_add(&bar[XB_XGEN(b.x)], 1u);
            asm volatile("s_waitcnt vmcnt(0)" ::: "memory");
        } else {
            XB_SPIN(xb_ld(&bar[XB_XGEN(b.x)]) == gen, bar);
            __builtin_amdgcn_fence(__ATOMIC_ACQUIRE, "agent");
            asm volatile("s_waitcnt vmcnt(0)" ::: "memory");
        }
    }
    __syncthreads();
}

extern __shared__ __attribute__((aligned(16))) unsigned char dyn_smem[];

__global__ void __launch_bounds__(512, 2) mega_kernel(Params p) {
    cg::grid_group grid = cg::this_grid();
    volatile LAS unsigned* st = (volatile LAS unsigned*)(dyn_smem + 2 * LDS_BYTES);
    if (threadIdx.x == 0) { st[0] = 0u; st[1] = 0u; st[2] = 0u; st[3] = 0u; }
    __syncthreads();
    XcdBarrier xb = xcd_barrier_post((unsigned*)(p.ws + WS_BAR), st);
    const int nsteps = p.ph_hi;
    const bool single = (p.ph_hi - p.ph_lo) == 1;
    for (int step = p.ph_lo; step < nsteps; ++step) {
        int ph, l;
        if (step == 0) { ph = PH_PRO; l = 0; }
        else { l = (step - 1) / 11; ph = PH_CONV + (step - 1) % 11; }
        if (ph == PH_CONV && l == 0) continue;
        run_phase(p, ph, l, dyn_smem);
#ifdef REPEAT_PH
        if (ph == REPEAT_PH) { xcd_barrier(xb); run_phase(p, ph, l, dyn_smem); }
#endif
        if (single) break;
        if (step == 0) grid.sync();
        else if (step + 1 < nsteps) xcd_barrier(xb);
    }
}

extern "C" void kernel_launch(void* const* d_in, const int* in_sizes, int n_in, void* d_out, int out_size, void* d_ws, size_t ws_size, hipStream_t stream) {
    static int grid = 0;
    if (grid == 0) {
        if (n_in != N_IN || ws_size < WS_END + 256 || out_size != T_TOK * DM) { fprintf(stderr, "kernel_launch: unexpected sizes n_in %d ws %zu (need %zu) out %d\n", n_in, ws_size, (size_t)WS_END, out_size); grid = -1; return; }
        int dev = 0, cus = 0, per_cu = 0;
        (void)hipGetDevice(&dev);
        (void)hipDeviceGetAttribute(&cus, hipDeviceAttributeMultiprocessorCount, dev);
        (void)hipFuncSetAttribute((const void*)mega_kernel, hipFuncAttributeMaxDynamicSharedMemorySize, LDS_ALLOC);
        (void)hipOccupancyMaxActiveBlocksPerMultiprocessor(&per_cu, (const void*)mega_kernel, 512, LDS_ALLOC);
        if (per_cu < 1) fprintf(stderr, "kernel_launch: occupancy query says %d blocks per CU\n", per_cu);
        grid = cus;
        (void)hipGetLastError();
    }
    if (grid < 0) return;
    Params p{};
    for (int i = 0; i < N_IN; ++i) p.in[i] = (const float*)d_in[i];
    p.out = (float*)d_out; p.ws = (unsigned char*)d_ws;
    (void)hipMemsetAsync((unsigned char*)d_ws + WS_BAR, 0, XCD_BAR_WORDS * 4, stream);
    p.ph_lo = 0; p.ph_hi = 1 + NL * 11;
    void* args[] = {&p};
    hipError_t e = hipLaunchCooperativeKernel((const void*)mega_kernel, dim3(grid), dim3(512), args, LDS_ALLOC, stream);
    if (e != hipSuccess) fprintf(stderr, "cooperative launch failed: %s (grid %d)\n", hipGetErrorString(e), grid);
}
```

```cpp
#include <hip/hip_runtime.h>
#include <hip/hip_cooperative_groups.h>
#include <cstdio>
#include <cstdint>
namespace cg = cooperative_groups;

#ifndef MEGA
#define MEGA 1
#endif

typedef unsigned short bf16_t;
typedef short bf16x8 __attribute__((ext_vector_type(8)));
typedef float f32x4 __attribute__((ext_vector_type(4)));
typedef unsigned u32x4 __attribute__((ext_vector_type(4)));
typedef unsigned u32x2 __attribute__((ext_vector_type(2)));

#define DI __device__ __forceinline__
#define MFMA16(a, b, c) __builtin_amdgcn_mfma_f32_16x16x32_bf16((a), (b), (c), 0, 0, 0)

constexpr int T_TOK = 32768, SEQ = 4096, NB = 8, DM = 1024, NL = 4;
constexpr int UC = 3072;
constexpr int INC = 2976;
constexpr int DFF = 2816;
constexpr float EPS = 1e-6f;
constexpr int LDS_BYTES = 73728;
constexpr int LDS_ALLOC = 2 * LDS_BYTES + 16;

constexpr size_t SZ_W = 13533184ull * 2;
constexpr size_t OFF_W = 0;
constexpr size_t OFF_XWKV = OFF_W + SZ_W;
constexpr size_t OFF_XB = OFF_XWKV + 4ull * 512 * 1024 * 2;
constexpr size_t OFF_MEMB = OFF_XB + (size_t)T_TOK * 1024 * 2;
constexpr size_t OFF_U = OFF_MEMB + 2048ull * 1024 * 2;
constexpr size_t OFF_CAT = OFF_U + (size_t)T_TOK * UC * 2;
constexpr size_t OFF_MQ = OFF_CAT + (size_t)T_TOK * 1024 * 2;
constexpr size_t OFF_MK = OFF_MQ + (size_t)T_TOK * 384 * 2;
constexpr size_t OFF_MVT = OFF_MK + (size_t)T_TOK * 384 * 2;
constexpr size_t OFF_HST = OFF_MVT + (size_t)T_TOK * 256 * 2;
constexpr size_t OFF_HDEC = OFF_HST + 64ull * 64 * 4096 * 4;
constexpr size_t OFF_XK = OFF_HDEC + 64ull * 64 * 64 * 4;
constexpr size_t OFF_XVT = OFF_XK + 4ull * 8 * 4 * 256 * 64 * 2;
constexpr size_t OFF_ROPE = OFF_XVT + 4ull * 8 * 4 * 256 * 64 * 2;
constexpr size_t OFF_ROWSQ = OFF_ROPE + (size_t)T_TOK * 16 * 2 * 4;
constexpr size_t OFF_MEMSQ = OFF_ROWSQ + (size_t)T_TOK * 16 * 4;
constexpr size_t OFF_SSQB = OFF_MEMSQ + 2048 * 4;
constexpr size_t OFF_SSQD = OFF_SSQB + (size_t)T_TOK * 4 * 4;
constexpr size_t WS_BAR = OFF_SSQD + (size_t)T_TOK * 4 * 4;
constexpr size_t WS_END = WS_BAR + 16384;
constexpr size_t QRAW_IN_OUT = 0;
constexpr size_t KVRAW_IN_OUT = (size_t)T_TOK * 384 * 2;
constexpr size_t OFF_KVMEM = OFF_MQ;
constexpr size_t OFF_XQ = OFF_U;
constexpr size_t OFF_XO = OFF_U + (size_t)T_TOK * 256 * 2;
constexpr size_t OFF_HFF = OFF_U;
constexpr size_t W_IN = 0, W_OUT = 3145728, W_UQ = 4194304, W_UKV = 4292608, W_XQ = 4358144, W_XO = 4620288, W_13 = 4882432, W_2 = 10649600;

enum { I_X = 0, I_MEM, I_POS, I_GMIX, I_WIN, I_ADWW, I_ADWB, I_ALNG, I_ALNB, I_HGAM, I_HONG, I_CDWW, I_CDWB, I_MQAG, I_MWUQ, I_MKVAG,
       I_MWUKV, I_MQNG, I_MKNG, I_GBR, I_WOUT, I_GXQ, I_GMEM, I_XWQ, I_XWKV, I_XQNG, I_XKNG, I_XWO, I_GFFN, I_W13, I_W2, N_IN };

struct Params {
    const float* in[N_IN];
    float* out;
    unsigned char* ws;
    int ph_lo, ph_hi;
    int layer, pad;
};

typedef __bf16 bf2_t __attribute__((ext_vector_type(2)));
typedef float f2_t __attribute__((ext_vector_type(2)));
DI unsigned cvt_pk(float lo, float hi) { f2_t v = {lo, hi}; bf2_t b = __builtin_convertvector(v, bf2_t); return __builtin_bit_cast(unsigned, b); }
DI bf16_t f2bf(float x) { return (bf16_t)(cvt_pk(x, 0.f) & 0xffffu); }
DI float bf2f(bf16_t h) { return __uint_as_float(((unsigned)h) << 16); }
DI float bflo(unsigned w) { return __uint_as_float(w << 16); }
DI float bfhi(unsigned w) { return __uint_as_float(w & 0xffff0000u); }
DI float sigmoidf_(float x) { return __builtin_amdgcn_rcpf(1.f + __expf(-x)); }
DI int tidx() { int t = threadIdx.x & 255; asm volatile("" : "+v"(t)); return t; }
DI float wave_sum(float v) {
#pragma unroll
    for (int o = 32; o > 0; o >>= 1) v += __shfl_xor(v, o);
    return v;
}

DI int sw_off(int row, int chunk) { return row * 128 + ((chunk ^ ((row >> 1) & 7)) << 4); }

DI void scale_chunk(uint4& v, float s) {
    v.x = cvt_pk(bflo(v.x) * s, bfhi(v.x) * s); v.y = cvt_pk(bflo(v.y) * s, bfhi(v.y) * s);
    v.z = cvt_pk(bflo(v.z) * s, bfhi(v.z) * s); v.w = cvt_pk(bflo(v.w) * s, bfhi(v.w) * s);
}

template <bool ASC>
DI void gemm_mainloop(const bf16_t* __restrict__ A, int lda, const bf16_t* __restrict__ Bt, int K, int row0, int col0,
                      unsigned char* smem, f32x4 (&acc)[4][4]) {
    const int tid = tidx(), lane = tid & 63, w = tid >> 6, wr = w >> 1, wc = w & 1, l15 = lane & 15, quad = lane >> 4;
    const int lr = tid >> 3, lc = tid & 7;
    const bf16_t* Ap = A + (size_t)(row0 + lr) * lda + lc * 8;
    const bf16_t* Bp = Bt + (size_t)(col0 + lr) * K + lc * 8;
    const size_t as1 = (size_t)32 * lda, bs1 = (size_t)32 * K;
    const float* asc = (const float*)(smem + 66048);
    uint4 ra0, ra1, ra2, ra3, rb0, rb1, rb2, rb3;
#define G_LOAD(ko) do { ra0 = *(const uint4*)(Ap + (ko)); ra1 = *(const uint4*)(Ap + as1 + (ko)); ra2 = *(const uint4*)(Ap + 2 * as1 + (ko)); ra3 = *(const uint4*)(Ap + 3 * as1 + (ko)); \
                        rb0 = *(const uint4*)(Bp + (ko)); rb1 = *(const uint4*)(Bp + bs1 + (ko)); rb2 = *(const uint4*)(Bp + 2 * bs1 + (ko)); rb3 = *(const uint4*)(Bp + 3 * bs1 + (ko)); } while (0)
#define G_STORE(buf) do { unsigned char* Ad_ = smem + (buf) * 16384; unsigned char* Bd_ = smem + 32768 + (buf) * 16384; const int o_ = sw_off(lr, lc); \
                          *(uint4*)(Ad_ + o_) = ra0; *(uint4*)(Ad_ + o_ + 4096) = ra1; *(uint4*)(Ad_ + o_ + 8192) = ra2; *(uint4*)(Ad_ + o_ + 12288) = ra3; \
                          *(uint4*)(Bd_ + o_) = rb0; *(uint4*)(Bd_ + o_ + 4096) = rb1; *(uint4*)(Bd_ + o_ + 8192) = rb2; *(uint4*)(Bd_ + o_ + 12288) = rb3; } while (0)
    const int plc = (tid & 7) ^ ((tid >> 4) & 7);
    const bf16_t* Adp = A + (size_t)(row0 + lr) * lda + plc * 8;
    const bf16_t* Bdp = Bt + (size_t)(col0 + lr) * K + plc * 8;
#define D_STAGE(buf, ko) do { _Pragma("unroll") for (int i_ = 0; i_ < 4; ++i_) { \
        __builtin_amdgcn_global_load_lds((const unsigned*)(Adp + i_ * as1 + (ko)), (unsigned*)(smem + (buf) * 16384 + i_ * 4096 + tid * 16), 16, 0, 0); \
        __builtin_amdgcn_global_load_lds((const unsigned*)(Bdp + i_ * bs1 + (ko)), (unsigned*)(smem + 32768 + (buf) * 16384 + i_ * 4096 + tid * 16), 16, 0, 0); } } while (0)
    if (ASC) { G_LOAD(0); } else { D_STAGE(0, 0); }
#pragma unroll
    for (int m = 0; m < 4; ++m)
#pragma unroll
        for (int n = 0; n < 4; ++n) acc[m][n] = (f32x4){0.f, 0.f, 0.f, 0.f};
    if (ASC) { G_STORE(0); }
    __syncthreads();
    const int nk = K >> 6;
    for (int kt = 0; kt < nk; ++kt) {
        const int cur = kt & 1;
        const bool more = (kt + 1 < nk);
        if (more) { const int ko = (kt + 1) * 64; if (ASC) { G_LOAD(ko); } else { D_STAGE(cur ^ 1, ko); } }
        __builtin_amdgcn_sched_barrier(0);
        const unsigned char* As = smem + cur * 16384;
        const unsigned char* Bs = smem + 32768 + cur * 16384;
#pragma unroll
        for (int ks = 0; ks < 2; ++ks) {
            bf16x8 af[4], bfv[4];
#pragma unroll
            for (int m = 0; m < 4; ++m) af[m] = *(const bf16x8*)(As + sw_off(wr * 64 + m * 16 + l15, ks * 4 + quad));
#pragma unroll
            for (int n = 0; n < 4; ++n) bfv[n] = *(const bf16x8*)(Bs + sw_off(wc * 64 + n * 16 + l15, ks * 4 + quad));
#pragma unroll
            for (int m = 0; m < 4; ++m)
#pragma unroll
                for (int n = 0; n < 4; ++n) acc[m][n] = MFMA16(bfv[n], af[m], acc[m][n]);
        }
        __builtin_amdgcn_sched_barrier(0);
        if (ASC && more) {
            const int grp = ((kt + 1) * 64) >> 8;
            if (grp & 1) {
                const int which = grp >> 1;
                scale_chunk(ra0, asc[lr * 2 + which]); scale_chunk(ra1, asc[(lr + 32) * 2 + which]);
                scale_chunk(ra2, asc[(lr + 64) * 2 + which]); scale_chunk(ra3, asc[(lr + 96) * 2 + which]);
            }
            G_STORE(cur ^ 1);
        }
        __syncthreads();
    }
#undef G_LOAD
#undef G_STORE
#undef D_STAGE
}

DI void tile_order(int L, int nM, int nN, int& pm, int& pn) {
    const int nwg = nM * nN;
    int wgid = L;
    { const int q = nwg / 8, r = nwg % 8, xcd = wgid % 8, off = wgid / 8; wgid = (xcd < r ? xcd * (q + 1) : r * (q + 1) + (xcd - r) * q) + off; }
    const int WGM = 8;
    const int nig = WGM * nN, gid = wgid / nig, fm = gid * WGM, gsz = (nM - fm) < WGM ? (nM - fm) : WGM;
    pm = fm + ((wgid % nig) % gsz); pn = (wgid % nig) / gsz;
}

DI void fill_rs(unsigned char* smem, const float* part, int npart, int row0, float inv_n) {
    float* rs = (float*)(smem + 65536);
    const int tid = tidx();
    if (tid < 128) {
        float s = 0.f;
        for (int i = 0; i < npart; ++i) s += part[(size_t)(row0 + tid) * npart + i];
        rs[tid] = __builtin_amdgcn_rsqf(s * inv_n + EPS);
    }
}

DI void epi_bf16(const f32x4 (&acc)[4][4], bf16_t* O, int ldo, int row0, int col0, const float* rs) {
    const int lane = tidx() & 63, w = tidx() >> 6, wr = w >> 1, wc = w & 1, l15 = lane & 15, quad = lane >> 4;
#pragma unroll
    for (int m = 0; m < 4; ++m) {
        const int rl = wr * 64 + m * 16 + l15;
        const float sc = rs ? rs[rl] : 1.f;
        bf16_t* rowp = O + (size_t)(row0 + rl) * ldo + col0 + wc * 64 + quad * 4;
#pragma unroll
        for (int n = 0; n < 4; ++n) {
            u32x2 v; v.x = cvt_pk(acc[m][n][0] * sc, acc[m][n][1] * sc); v.y = cvt_pk(acc[m][n][2] * sc, acc[m][n][3] * sc);
            *(u32x2*)(rowp + n * 16) = v;
        }
    }
}
DI void epi_resid(const f32x4 (&acc)[4][4], float* X, bf16_t* XB, float* rowsq, int row0, int col0) {
    const int lane = tidx() & 63, w = tidx() >> 6, wr = w >> 1, wc = w & 1, l15 = lane & 15, quad = lane >> 4;
    const int pn = col0 >> 7;
#pragma unroll
    for (int m = 0; m < 4; ++m) {
        const int row = row0 + wr * 64 + m * 16 + l15;
        float ss = 0.f;
#pragma unroll
        for (int n = 0; n < 4; ++n) {
            const int col = col0 + wc * 64 + n * 16 + quad * 4;
            float4* xp = (float4*)(X + (size_t)row * DM + col);
            float4 xv = *xp;
            xv.x += acc[m][n][0]; xv.y += acc[m][n][1]; xv.z += acc[m][n][2]; xv.w += acc[m][n][3];
            *xp = xv;
            u32x2 v; v.x = cvt_pk(xv.x, xv.y); v.y = cvt_pk(xv.z, xv.w);
            *(u32x2*)(XB + (size_t)row * DM + col) = v;
            ss += xv.x * xv.x + xv.y * xv.y + xv.z * xv.z + xv.w * xv.w;
        }
        ss += __shfl_xor(ss, 16); ss += __shfl_xor(ss, 32);
        if (quad == 0) rowsq[(size_t)row * 16 + pn * 2 + wc] = ss;
    }
}
DI void epi_swiglu(const f32x4 (&acc)[4][4], bf16_t* H, int row0, int col0, const float* rs) {
    const int lane = tidx() & 63, w = tidx() >> 6, wr = w >> 1, wc = w & 1, l15 = lane & 15, quad = lane >> 4;
#pragma unroll
    for (int m = 0; m < 4; ++m) {
        const int rl = wr * 64 + m * 16 + l15;
        const float sc = rs[rl];
        bf16_t* rowp = H + (size_t)(row0 + rl) * DFF + ((col0 + wc * 64) >> 1) + quad * 4;
#pragma unroll
        for (int np = 0; np < 2; ++np) {
            float h[4];
#pragma unroll
            for (int j = 0; j < 4; ++j) { const float a1 = acc[m][2 * np][j] * sc, a3 = acc[m][2 * np + 1][j] * sc; h[j] = a1 * sigmoidf_(a1) * a3; }
            u32x2 v; v.x = cvt_pk(h[0], h[1]); v.y = cvt_pk(h[2], h[3]);
            *(u32x2*)(rowp + np * 16) = v;
        }
    }
}

DI void conv_tile(const float* __restrict__ src, int K, int N, int Npad, const float* __restrict__ gain, int perm, bf16_t* __restrict__ dst, int tile, unsigned char* smem) {
    float* lds = (float*)smem;
    const int nkt = K >> 6, kt = tile % nkt, nt = tile / nkt, k0 = kt * 64, n0 = nt * 64;
    const int tid = tidx(), nl = tid & 63, kq = tid >> 6;
    const int R = n0 + nl;
    int sc = R;
    if (perm == 1) { const int g = R >> 5, j = R & 31; sc = (j < 16) ? (16 * g + j) : (DFF + 16 * g + j - 16); }
    const bool ok = R < N;
#pragma unroll
    for (int i = 0; i < 16; ++i) { const int kl = kq + 4 * i; lds[kl * 65 + nl] = ok ? src[(size_t)(k0 + kl) * N + sc] : 0.f; }
    __syncthreads();
    const int kc = tid & 7, nr = tid >> 3;
    int kd0 = k0;
    if (perm == 2) { const int g = k0 >> 8; const int gm = (g == 0) ? 2 : (g == 1) ? 0 : (g == 2) ? 3 : 1; kd0 = gm * 256 + (k0 & 255); }
    float g8[8];
#pragma unroll
    for (int j = 0; j < 8; ++j) g8[j] = gain ? gain[k0 + kc * 8 + j] : 1.f;
#pragma unroll
    for (int i = 0; i < 2; ++i) {
        const int nl2 = nr + 32 * i;
        float v[8];
#pragma unroll
        for (int j = 0; j < 8; ++j) v[j] = lds[(kc * 8 + j) * 65 + nl2] * g8[j];
        uint4 o; o.x = cvt_pk(v[0], v[1]); o.y = cvt_pk(v[2], v[3]); o.z = cvt_pk(v[4], v[5]); o.w = cvt_pk(v[6], v[7]);
        *(uint4*)(dst + (size_t)(n0 + nl2) * K + kd0 + kc * 8) = o;
    }
    __syncthreads();
}

constexpr int CONV_TILES = 768 + 256 + 24 + 16 + 64 + 64 + 1408 + 704;
DI void conv_layer_item(const Params& p, int l, int it, unsigned char* smem) {
    bf16_t* W = (bf16_t*)(p.ws + OFF_W);
    if (it < 768) { conv_tile(p.in[I_WIN] + (size_t)l * DM * INC, DM, INC, UC, p.in[I_GMIX] + l * DM, 0, W + W_IN, it, smem); return; } it -= 768;
    if (it < 256) { conv_tile(p.in[I_WOUT] + (size_t)l * DM * DM, DM, DM, DM, p.in[I_GBR] + l * DM, 2, W + W_OUT, it, smem); return; } it -= 256;
    if (it < 24) { conv_tile(p.in[I_MWUQ] + (size_t)l * 256 * 384, 256, 384, 384, p.in[I_MQAG] + l * 256, 0, W + W_UQ, it, smem); return; } it -= 24;
    if (it < 16) { conv_tile(p.in[I_MWUKV] + (size_t)l * 128 * 512, 128, 512, 512, p.in[I_MKVAG] + l * 128, 0, W + W_UKV, it, smem); return; } it -= 16;
    if (it < 64) { conv_tile(p.in[I_XWQ] + (size_t)l * DM * 256, DM, 256, 256, p.in[I_GXQ] + l * DM, 0, W + W_XQ, it, smem); return; } it -= 64;
    if (it < 64) { conv_tile(p.in[I_XWO] + (size_t)l * 256 * DM, 256, DM, DM, nullptr, 0, W + W_XO, it, smem); return; } it -= 64;
    if (it < 1408) { conv_tile(p.in[I_W13] + (size_t)l * DM * 2 * DFF, DM, 2 * DFF, 2 * DFF, p.in[I_GFFN] + l * DM, 1, W + W_13, it, smem); return; } it -= 1408;
    conv_tile(p.in[I_W2] + (size_t)l * DFF * DM, DFF, DM, DM, nullptr, 0, W + W_2, it, smem);
}

DI void pro_rows(const float* __restrict__ src, float* __restrict__ cpy, bf16_t* __restrict__ dstb, float* __restrict__ sq, int sqstride, int item) {
    const int w = tidx() >> 6, lane = tidx() & 63;
    for (int r = 0; r < 4; ++r) {
        const int row = item * 16 + w * 4 + r;
        const float4* s4 = (const float4*)(src + (size_t)row * DM);
        float s = 0.f;
#pragma unroll
        for (int i = 0; i < 4; ++i) {
            const float4 v = s4[lane + 64 * i];
            if (cpy) ((float4*)(cpy + (size_t)row * DM))[lane + 64 * i] = v;
            u32x2 o; o.x = cvt_pk(v.x, v.y); o.y = cvt_pk(v.z, v.w);
            *(u32x2*)(dstb + (size_t)row * DM + (lane + 64 * i) * 4) = o;
            s += v.x * v.x + v.y * v.y + v.z * v.z + v.w * v.w;
        }
        s = wave_sum(s);
        if (lane < sqstride) sq[(size_t)row * sqstride + lane] = (lane == 0) ? s : 0.f;
    }
}
DI void pro_rope(const Params& p, int item) {
    const int tok = item * 256 + tidx();
    const int* pos = (const int*)p.in[I_POS];
    float* cs = (float*)(p.ws + OFF_ROPE);
    float* sn = cs + (size_t)T_TOK * 16;
    const float pf = (float)pos[tok];
#pragma unroll
    for (int i = 0; i < 16; ++i) {
        const float inv = powf(10000.0f, -(float)(2 * i) / 32.0f);
        const float ang = pf * inv;
        cs[(size_t)tok * 16 + i] = cosf(ang);
        sn[(size_t)tok * 16 + i] = sinf(ang);
    }
}

DI void conformer_tile(const Params& p, int l, int tile, unsigned char* smem) {
    float* hs = (float*)smem;
    const bf16_t* U = (const bf16_t*)(p.ws + OFF_U);
    bf16_t* CAT = (bf16_t*)(p.ws + OFF_CAT);
    const int tid = tidx(), b = tile >> 7, t0 = (tile & 127) * 32;
    {
        const int c2 = (tid & 127) * 2, half = tid >> 7;
        for (int r0 = half; r0 < 62; r0 += 32) {
            unsigned av[16], gv[16];
#pragma unroll
            for (int k = 0; k < 16; ++k) {
                const int r = r0 + 2 * k, t = t0 - 15 + r;
                av[k] = 0u; gv[k] = 0u;
                if (r < 62 && t >= 0 && t < SEQ) {
                    const bf16_t* up = U + (size_t)(b * SEQ + t) * UC;
                    av[k] = *(const unsigned*)(up + c2); gv[k] = *(const unsigned*)(up + 256 + c2);
                }
            }
#pragma unroll
            for (int k = 0; k < 16; ++k) {
                const int r = r0 + 2 * k;
                if (r < 62) {
                    hs[r * 256 + c2] = bflo(av[k]) * sigmoidf_(bflo(gv[k]));
                    hs[r * 256 + c2 + 1] = bfhi(av[k]) * sigmoidf_(bfhi(gv[k]));
                }
            }
        }
    }
    __syncthreads();
    {
        const int c = tid;
        float wv[31];
        const float* wp = p.in[I_ADWW] + (size_t)l * 31 * 256 + c;
#pragma unroll
        for (int j = 0; j < 31; ++j) wv[j] = wp[j * 256];
        const float bias = p.in[I_ADWB][l * 256 + c];
        for (int t = 0; t < 32; ++t) {
            float y = bias;
#pragma unroll
            for (int j = 0; j < 31; ++j) y += wv[j] * hs[(t + j) * 256 + c];
            hs[t * 256 + c] = y;
        }
    }
    __syncthreads();
    {
        const int w = tid >> 6, lane = tid & 63;
        const float4 g4 = *(const float4*)(p.in[I_ALNG] + l * 256 + lane * 4), b4 = *(const float4*)(p.in[I_ALNB] + l * 256 + lane * 4);
        for (int r = 0; r < 8; ++r) {
            const int t = w * 8 + r;
            float4 v = *(const float4*)(hs + t * 256 + lane * 4);
            const float mu = wave_sum(v.x + v.y + v.z + v.w) * (1.f / 256.f);
            v.x -= mu; v.y -= mu; v.z -= mu; v.w -= mu;
            const float var = wave_sum(v.x * v.x + v.y * v.y + v.z * v.z + v.w * v.w) * (1.f / 256.f);
            const float rstd = __builtin_amdgcn_rsqf(var + EPS);
            float y0 = v.x * rstd * g4.x + b4.x, y1 = v.y * rstd * g4.y + b4.y, y2 = v.z * rstd * g4.z + b4.z, y3 = v.w * rstd * g4.w + b4.w;
            y0 *= sigmoidf_(y0); y1 *= sigmoidf_(y1); y2 *= sigmoidf_(y2); y3 *= sigmoidf_(y3);
            const float ss = wave_sum(y0 * y0 + y1 * y1 + y2 * y2 + y3 * y3);
            const float rb = __builtin_amdgcn_rsqf(ss * (1.f / 256.f) + EPS);
            u32x2 o; o.x = cvt_pk(y0 * rb, y1 * rb); o.y = cvt_pk(y2 * rb, y3 * rb);
            *(u32x2*)(CAT + (size_t)(b * SEQ + t0 + t) * DM + 512 + lane * 4) = o;
        }
    }
    __syncthreads();
}

DI void shortconv_tile(const Params& p, int l, int tile) {
    const bf16_t* U = (const bf16_t*)(p.ws + OFF_U);
    bf16_t* CAT = (bf16_t*)(p.ws + OFF_CAT);
    const int w = tidx() >> 6, lane = tidx() & 63, c = lane * 4;
    const float* wp = p.in[I_CDWW] + (size_t)l * 3 * 256 + c;
    const float4 w0 = *(const float4*)(wp), w1 = *(const float4*)(wp + 256), w2 = *(const float4*)(wp + 512);
    const float4 bb = *(const float4*)(p.in[I_CDWB] + l * 256 + c);
#pragma unroll 4
    for (int r = 0; r < 16; ++r) {
        const int tok = tile * 64 + w * 16 + r, s = tok & (SEQ - 1);
        float pr[3][4];
#pragma unroll
        for (int j = 0; j < 3; ++j) {
            const int sj = s + j - 1;
            if (sj >= 0 && sj < SEQ) {
                const bf16_t* up = U + (size_t)(tok + j - 1) * UC;
                const u32x2 gc = *(const u32x2*)(up + 2048 + c), xi = *(const u32x2*)(up + 2304 + c);
                pr[j][0] = bflo(gc.x) * bflo(xi.x); pr[j][1] = bfhi(gc.x) * bfhi(xi.x); pr[j][2] = bflo(gc.y) * bflo(xi.y); pr[j][3] = bfhi(gc.y) * bfhi(xi.y);
            } else { pr[j][0] = pr[j][1] = pr[j][2] = pr[j][3] = 0.f; }
        }
        const u32x2 gb = *(const u32x2*)(U + (size_t)tok * UC + 1792 + c);
        const float y0 = bflo(gb.x) * (bb.x + w0.x * pr[0][0] + w1.x * pr[1][0] + w2.x * pr[2][0]);
        const float y1 = bfhi(gb.x) * (bb.y + w0.y * pr[0][1] + w1.y * pr[1][1] + w2.y * pr[2][1]);
        const float y2 = bflo(gb.y) * (bb.z + w0.z * pr[0][2] + w1.z * pr[1][2] + w2.z * pr[2][2]);
        const float y3 = bfhi(gb.y) * (bb.w + w0.w * pr[0][3] + w1.w * pr[1][3] + w2.w * pr[2][3]);
        const float ss = wave_sum(y0 * y0 + y1 * y1 + y2 * y2 + y3 * y3);
        const float rb = __builtin_amdgcn_rsqf(ss * (1.f / 256.f) + EPS);
        u32x2 o; o.x = cvt_pk(y0 * rb, y1 * rb); o.y = cvt_pk(y2 * rb, y3 * rb);
        *(u32x2*)(CAT + (size_t)tok * DM + 768 + c) = o;
    }
}

DI float hgrn_lower(const Params& p, int l, int dir, int ch) {
    const float* g = p.in[I_HGAM] + (size_t)dir * NL * 256 + ch;
    const float g0 = g[0], g1 = g[256], g2 = g[512], g3 = g[768];
    const float mx = fmaxf(fmaxf(g0, g1), fmaxf(g2, g3));
    const float e0 = __expf(g0 - mx), e1 = __expf(g1 - mx), e2 = __expf(g2 - mx), e3 = __expf(g3 - mx);
    const float inv = 1.f / (e0 + e1 + e2 + e3);
    float lb = 0.f;
    if (l >= 1) lb += e1; if (l >= 2) lb += e2; if (l >= 3) lb += e3;
    return lb * inv;
}

DI void hgrn_local_tile(const Params& p, int l, int item, unsigned char* smem) {
    const bf16_t* U = (const bf16_t*)(p.ws + OFF_U);
    float* HST = (float*)(p.ws + OFF_HST);
    float* HDEC = (float*)(p.ws + OFF_HDEC);
    const int dir = item >> 9, b = (item >> 6) & 7, c = item & 63;
    const int h = tidx() >> 6, lane = tidx() & 63, l15 = lane & 15, quad = lane >> 4;
    bf16_t* kT = (bf16_t*)(smem + h * 18432);
    bf16_t* vT = kT + 64 * 72;
    const float lb = hgrn_lower(p, l, dir, h * 64 + lane);
    const int tokbase = b * SEQ + c * 64;
    const bf16_t* zp = U + (size_t)tokbase * UC + 768 + dir * 256 + h * 64 + lane;
    const bf16_t* vp = U + (size_t)tokbase * UC + 1280 + h * 64 + lane;
    float suf = 0.f;
    {
        const int step = dir ? UC : -UC, di = dir ? 1 : -1;
        int i = dir ? 0 : 63;
        zp += (size_t)i * UC; vp += (size_t)i * UC;
        bf16_t* kw = kT + lane * 72 + i; bf16_t* vw = vT + lane * 72 + i;
        for (int hb = 0; hb < 2; ++hb) {
            bf16_t zz[32], vv[32];
#pragma unroll
            for (int ii = 0; ii < 32; ++ii) { zz[ii] = zp[(ptrdiff_t)ii * step]; vv[ii] = vp[(ptrdiff_t)ii * step]; }
            zp += (ptrdiff_t)32 * step; vp += (ptrdiff_t)32 * step;
#pragma unroll
            for (int ii = 0; ii < 32; ++ii) {
                const float z = bf2f(zz[ii]);
                const float sg = sigmoidf_(z), f = sg + lb * (1.f - sg), kk = (1.f - lb) * (1.f - sg);
                kw[ii * di] = f2bf(kk * __expf(suf));
                vw[ii * di] = vv[ii];
                suf += __logf(f);
            }
            kw += 32 * di; vw += 32 * di;
        }
    }
    const int seq = (dir * 8 + b) * 4 + h, cs = dir ? 63 - c : c;
    HDEC[((size_t)seq * 64 + cs) * 64 + lane] = __expf(suf);
    __syncthreads();
    f32x4 acc[4][4];
#pragma unroll
    for (int et = 0; et < 4; ++et)
#pragma unroll
        for (int dt = 0; dt < 4; ++dt) acc[et][dt] = (f32x4){0.f, 0.f, 0.f, 0.f};
#pragma unroll
    for (int ks = 0; ks < 2; ++ks) {
        bf16x8 av[4], bk[4];
#pragma unroll
        for (int t = 0; t < 4; ++t) {
            av[t] = *(const bf16x8*)(vT + (t * 16 + l15) * 72 + ks * 32 + quad * 8);
            bk[t] = *(const bf16x8*)(kT + (t * 16 + l15) * 72 + ks * 32 + quad * 8);
        }
#pragma unroll
        for (int et = 0; et < 4; ++et)
#pragma unroll
            for (int dt = 0; dt < 4; ++dt) acc[et][dt] = MFMA16(av[et], bk[dt], acc[et][dt]);
    }
    float* sp = HST + ((size_t)seq * 64 + cs) * 4096;
#pragma unroll
    for (int et = 0; et < 4; ++et)
#pragma unroll
        for (int dt = 0; dt < 4; ++dt)
#pragma unroll
            for (int r = 0; r < 4; ++r) sp[(et * 16 + quad * 4 + r) * 64 + dt * 16 + l15] = acc[et][dt][r];
    __syncthreads();
}

DI void hgrn_scan_item(const Params& p, int item) {
    float* HST = (float*)(p.ws + OFF_HST);
    const float* HDEC = (const float*)(p.ws + OFF_HDEC);
    const int gid = item * 256 + tidx(), seq = gid >> 12, ed = gid & 4095, d = ed & 63;
    float* sp = HST + (size_t)seq * 64 * 4096 + ed;
    const float* dp = HDEC + (size_t)seq * 64 * 64 + d;
    float s = 0.f;
    for (int c0 = 0; c0 < 64; c0 += 8) {
        float loc[8], dec[8];
#pragma unroll
        for (int j = 0; j < 8; ++j) { loc[j] = sp[(size_t)(c0 + j) * 4096]; dec[j] = dp[(c0 + j) * 64]; }
#pragma unroll
        for (int j = 0; j < 8; ++j) { sp[(size_t)(c0 + j) * 4096] = s; s = dec[j] * s + loc[j]; }
    }
}

DI void hgrn_scan_dummy(const Params& p, int item) {
    float* HST = (float*)(p.ws + OFF_HST);
    const float* HDEC = (const float*)(p.ws + OFF_HDEC);
    const int gid = item * 256 + tidx(), seq = gid >> 12, ed = gid & 4095, d = ed & 63;
    float* sp = HST + (size_t)seq * 64 * 4096 + ed;
    const float* dp = HDEC + (size_t)seq * 64 * 64 + d;
    float s = 0.f;
    for (int c0 = 0; c0 < 64; c0 += 8) {
        float loc[8], dec[8];
#pragma unroll
        for (int j = 0; j < 8; ++j) { loc[j] = sp[(size_t)(c0 + j) * 4096]; dec[j] = dp[(c0 + j) * 64]; }
#pragma unroll
        for (int j = 0; j < 8; ++j) { s = dec[j] * s + loc[j]; sp[(size_t)(c0 + j) * 4096] = (s == 12345.678f) ? s : loc[j]; }
    }
}
DI bf16x8 hg_frag(const bf16_t* qk, const float* bc, const float* ref, bool qside) {
    const uint4 x = *(const uint4*)qk;
    const float4 b0 = *(const float4*)bc, b1 = *(const float4*)(bc + 4);
    float4 r0 = {0.f, 0.f, 0.f, 0.f}, r1 = {0.f, 0.f, 0.f, 0.f};
    if (ref) { r0 = *(const float4*)ref; r1 = *(const float4*)(ref + 4); }
    float e[8] = {b0.x - r0.x, b0.y - r0.y, b0.z - r0.z, b0.w - r0.w, b1.x - r1.x, b1.y - r1.y, b1.z - r1.z, b1.w - r1.w};
    if (!qside) {
#pragma unroll
        for (int j = 0; j < 8; ++j) e[j] = -e[j];
    }
    u32x4 o;
    o.x = cvt_pk(bflo(x.x) * __expf(e[0]), bfhi(x.x) * __expf(e[1]));
    o.y = cvt_pk(bflo(x.y) * __expf(e[2]), bfhi(x.y) * __expf(e[3]));
    o.z = cvt_pk(bflo(x.z) * __expf(e[4]), bfhi(x.z) * __expf(e[5]));
    o.w = cvt_pk(bflo(x.w) * __expf(e[6]), bfhi(x.w) * __expf(e[7]));
    return __builtin_bit_cast(bf16x8, o);
}

DI void hgrn_out_tile(const Params& p, int l, int item, unsigned char* smem) {
    const bf16_t* U = (const bf16_t*)(p.ws + OFF_U);
    const float* HST = (const float*)(p.ws + OFF_HST);
    bf16_t* CAT = (bf16_t*)(p.ws + OFF_CAT);
    float* SSQB = (float*)(p.ws + OFF_SSQB);
    const int h = item & 3, c = (item >> 2) & 63, b = item >> 8;
    const int w = tidx() >> 6, lane = tidx() & 63, l15 = lane & 15, quad = lane >> 4;
    float* bc = (float*)smem;
    bf16_t* kk = (bf16_t*)(smem + 34816);
    bf16_t* qq = (bf16_t*)(smem + 34816 + 18432);
    bf16_t* vT = (bf16_t*)(smem + 34816 + 18432 + 9216);
    const int tokbase = b * SEQ + c * 64;
    u32x4 sfr[2][4];
    {
        const int dirp = w & 1;
        const int seqp = (dirp * 8 + b) * 4 + h, csp = dirp ? 63 - c : c;
        const float* sinp = HST + ((size_t)seqp * 64 + csp) * 4096;
#pragma unroll
        for (int ks = 0; ks < 2; ++ks)
#pragma unroll
            for (int et = 0; et < 4; ++et) {
                const float* sp = sinp + (et * 16 + l15) * 64 + ks * 32 + quad * 8;
                const float4 s0 = *(const float4*)sp, s1 = *(const float4*)(sp + 4);
                sfr[ks][et].x = cvt_pk(s0.x, s0.y); sfr[ks][et].y = cvt_pk(s0.z, s0.w); sfr[ks][et].z = cvt_pk(s1.x, s1.y); sfr[ks][et].w = cvt_pk(s1.z, s1.w);
            }
    }
    if (w < 2) {
        const int dir = w;
        const float lb = hgrn_lower(p, l, dir, h * 64 + lane);
        const bf16_t* zp = U + (size_t)tokbase * UC + 768 + dir * 256 + h * 64 + lane;
        float run = 0.f;
        const int step = dir ? -UC : UC, di = dir ? -1 : 1;
        int i = dir ? 63 : 0;
        zp += (size_t)i * UC;
        float* bw = bc + (dir * 64 + i) * 68 + lane; bf16_t* kw = kk + (dir * 64 + i) * 72 + lane;
        {
            bf16_t zz[64];
#pragma unroll
            for (int ii = 0; ii < 64; ++ii) zz[ii] = zp[(ptrdiff_t)ii * step];
#pragma unroll
            for (int ii = 0; ii < 64; ++ii) {
                const float z = bf2f(zz[ii]);
                const float sg = sigmoidf_(z), f = sg + lb * (1.f - sg);
                run += __logf(f);
                bw[ii * di * 68] = run; kw[ii * di * 72] = f2bf((1.f - lb) * (1.f - sg));
            }
        }
    } else if (w == 2) {
        const bf16_t* qp = U + (size_t)tokbase * UC + 512 + h * 64 + lane;
        {
            bf16_t t[64];
#pragma unroll
            for (int i = 0; i < 64; ++i) t[i] = qp[(size_t)i * UC];
#pragma unroll
            for (int i = 0; i < 64; ++i) qq[i * 72 + lane] = t[i];
        }
    } else {
        const bf16_t* vp = U + (size_t)tokbase * UC + 1280 + h * 64 + lane;
        {
            bf16_t t[64];
#pragma unroll
            for (int i = 0; i < 64; ++i) t[i] = vp[(size_t)i * UC];
#pragma unroll
            for (int i = 0; i < 64; ++i) vT[lane * 72 + i] = t[i];
        }
    }
    __syncthreads();
    const int dir = w & 1, iset = w >> 1;
    const int seq = (dir * 8 + b) * 4 + h, cs = dir ? 63 - c : c;
    const float* bcd = bc + dir * 64 * 68;
    const bf16_t* kkd = kk + dir * 64 * 72;
    f32x4 o[4][2];
#pragma unroll
    for (int et = 0; et < 4; ++et) { o[et][0] = (f32x4){0.f, 0.f, 0.f, 0.f}; o[et][1] = (f32x4){0.f, 0.f, 0.f, 0.f}; }
#pragma unroll
    for (int ii = 0; ii < 2; ++ii) {
        const int I = iset == 0 ? (ii == 0 ? 0 : 3) : (ii == 0 ? 1 : 2);
        const int irow = 16 * I + l15;
#pragma unroll
        for (int ks = 0; ks < 2; ++ks) {
            const int d0 = ks * 32 + quad * 8;
            const bf16x8 bq = hg_frag(qq + irow * 72 + d0, bcd + irow * 68 + d0, nullptr, true);
#pragma unroll
            for (int et = 0; et < 4; ++et) o[et][ii] = MFMA16(__builtin_bit_cast(bf16x8, sfr[ks][et]), bq, o[et][ii]);
        }
#pragma unroll
        for (int kk2 = 0; kk2 < 2; ++kk2) {
            f32x4 at[2];
            bool any = false;
#pragma unroll
            for (int jj = 0; jj < 2; ++jj) {
                const int J = 2 * kk2 + jj;
                at[jj] = (f32x4){0.f, 0.f, 0.f, 0.f};
                const bool active = dir == 0 ? (J <= I) : (J >= I);
                if (active) {
                    any = true;
                    const float* ref = nullptr;
                    if (dir == 0) { if (J > 0) ref = bcd + (16 * J - 1) * 68; } else { if (J < 3) ref = bcd + (16 * J + 16) * 68; }
                    const int srow = 16 * J + l15;
#pragma unroll
                    for (int ks = 0; ks < 2; ++ks) {
                        const int d0 = ks * 32 + quad * 8;
                        const bf16x8 ak = hg_frag(kkd + srow * 72 + d0, bcd + srow * 68 + d0, ref ? ref + d0 : nullptr, false);
                        const bf16x8 bq = hg_frag(qq + irow * 72 + d0, bcd + irow * 68 + d0, ref ? ref + d0 : nullptr, true);
                        at[jj] = MFMA16(ak, bq, at[jj]);
                    }
                    if (J == I) {
#pragma unroll
                        for (int r = 0; r < 4; ++r) {
                            const int sl = quad * 4 + r;
                            const bool keep = dir == 0 ? (sl <= l15) : (sl >= l15);
                            if (!keep) at[jj][r] = 0.f;
                        }
                    }
                }
            }
            if (any) {
                u32x4 pbw; pbw.x = cvt_pk(at[0][0], at[0][1]); pbw.y = cvt_pk(at[0][2], at[0][3]); pbw.z = cvt_pk(at[1][0], at[1][1]); pbw.w = cvt_pk(at[1][2], at[1][3]);
                const bf16x8 pb = __builtin_bit_cast(bf16x8, pbw);
#pragma unroll
                for (int et = 0; et < 4; ++et) {
                    const bf16_t* vp = vT + (et * 16 + l15) * 72 + kk2 * 32 + quad * 4;
                    const u32x2 lo = *(const u32x2*)vp, hi = *(const u32x2*)(vp + 16);
                    u32x4 a; a.x = lo.x; a.y = lo.y; a.z = hi.x; a.w = hi.y;
                    o[et][ii] = MFMA16(__builtin_bit_cast(bf16x8, a), pb, o[et][ii]);
                }
            }
        }
    }
    __syncthreads();
    float* ob = (float*)smem;
    if (dir == 1) {
#pragma unroll
        for (int ii = 0; ii < 2; ++ii) {
            const int I = iset == 0 ? (ii == 0 ? 0 : 3) : (ii == 0 ? 1 : 2);
#pragma unroll
            for (int et = 0; et < 4; ++et) *(f32x4*)(ob + (16 * I + l15) * 68 + et * 16 + quad * 4) = o[et][ii];
        }
    }
    __syncthreads();
    if (dir == 0) {
#pragma unroll
        for (int ii = 0; ii < 2; ++ii) {
            const int I = iset == 0 ? (ii == 0 ? 0 : 3) : (ii == 0 ? 1 : 2);
            const int tok = tokbase + 16 * I + l15;
            float ss = 0.f;
#pragma unroll
            for (int et = 0; et < 4; ++et) {
                o[et][ii] += *(const f32x4*)(ob + (16 * I + l15) * 68 + et * 16 + quad * 4);
                ss += o[et][ii][0] * o[et][ii][0] + o[et][ii][1] * o[et][ii][1] + o[et][ii][2] * o[et][ii][2] + o[et][ii][3] * o[et][ii][3];
            }
            ss += __shfl_xor(ss, 16); ss += __shfl_xor(ss, 32);
            const float rh = __builtin_amdgcn_rsqf(ss * (1.f / 64.f) + EPS);
            float ssy = 0.f;
#pragma unroll
            for (int et = 0; et < 4; ++et) {
                const int e = et * 16 + quad * 4;
                const u32x2 gg = *(const u32x2*)(U + (size_t)tok * UC + 1536 + h * 64 + e);
                const float4 og = *(const float4*)(p.in[I_HONG] + l * 256 + h * 64 + e);
                const float g0 = bflo(gg.x), g1 = bfhi(gg.x), g2 = bflo(gg.y), g3 = bfhi(gg.y);
                const float y0 = o[et][ii][0] * rh * og.x * g0 * sigmoidf_(g0), y1 = o[et][ii][1] * rh * og.y * g1 * sigmoidf_(g1);
                const float y2 = o[et][ii][2] * rh * og.z * g2 * sigmoidf_(g2), y3 = o[et][ii][3] * rh * og.w * g3 * sigmoidf_(g3);
                ssy += y0 * y0 + y1 * y1 + y2 * y2 + y3 * y3;
                u32x2 ov; ov.x = cvt_pk(y0, y1); ov.y = cvt_pk(y2, y3);
                *(u32x2*)(CAT + (size_t)tok * DM + h * 64 + e) = ov;
            }
            ssy += __shfl_xor(ssy, 16); ssy += __shfl_xor(ssy, 32);
            if (quad == 0) SSQB[(size_t)tok * 4 + h] = ssy;
        }
    }
    __syncthreads();
}

DI void mla_finish_tile(const Params& p, int l, int item, unsigned char* smem) {
    const bf16_t* U = (const bf16_t*)(p.ws + OFF_U);
    const bf16_t* QR = (const bf16_t*)((const unsigned char*)p.out + QRAW_IN_OUT);
    const bf16_t* KVR = (const bf16_t*)((const unsigned char*)p.out + KVRAW_IN_OUT);
    bf16_t* MQ = (bf16_t*)(p.ws + OFF_MQ);
    bf16_t* MK = (bf16_t*)(p.ws + OFF_MK);
    bf16_t* MVT = (bf16_t*)(p.ws + OFF_MVT);
    const float* CS = (const float*)(p.ws + OFF_ROPE);
    const float* SN = CS + (size_t)T_TOK * 16;
    bf16_t* vbuf = (bf16_t*)smem;
    const int w = tidx() >> 6, lane = tidx() & 63, h = lane >> 4, j = lane & 15;
    const float4 qg = *(const float4*)(p.in[I_MQNG] + l * 96 + 4 * j), kg = *(const float4*)(p.in[I_MKNG] + l * 96 + 4 * j);
    const float qg1 = p.in[I_MQNG][l * 96 + 64 + j], qg2 = p.in[I_MQNG][l * 96 + 80 + j];
    const float kg1 = p.in[I_MKNG][l * 96 + 64 + j], kg2 = p.in[I_MKNG][l * 96 + 80 + j];
#pragma unroll 4
    for (int r = 0; r < 16; ++r) {
        const int tl = w * 16 + r, tok = item * 64 + tl;
        const bf16_t* up = U + (size_t)tok * UC;
        float sq, skv;
        { const u32x2 a = *(const u32x2*)(up + 2560 + lane * 4);
          const float a0 = bflo(a.x), a1 = bfhi(a.x), a2 = bflo(a.y), a3 = bfhi(a.y);
          sq = __builtin_amdgcn_rsqf(wave_sum(a0 * a0 + a1 * a1 + a2 * a2 + a3 * a3) * (1.f / 256.f) + EPS);
          const unsigned c = *(const unsigned*)(up + 2816 + lane * 2);
          const float c0 = bflo(c), c1 = bfhi(c);
          skv = __builtin_amdgcn_rsqf(wave_sum(c0 * c0 + c1 * c1) * (1.f / 128.f) + EPS); }
        const float cs = CS[(size_t)tok * 16 + j], sn = SN[(size_t)tok * 16 + j];
        {
            const bf16_t* qp = QR + (size_t)tok * 384 + h * 96;
            const u32x2 a = *(const u32x2*)(qp + 4 * j);
            float q0 = bflo(a.x) * sq, q1 = bfhi(a.x) * sq, q2 = bflo(a.y) * sq, q3 = bfhi(a.y) * sq;
            float x1 = bf2f(qp[64 + j]) * sq, x2 = bf2f(qp[80 + j]) * sq;
            float ss = q0 * q0 + q1 * q1 + q2 * q2 + q3 * q3 + x1 * x1 + x2 * x2;
            ss += __shfl_xor(ss, 1); ss += __shfl_xor(ss, 2); ss += __shfl_xor(ss, 4); ss += __shfl_xor(ss, 8);
            const float rn = __builtin_amdgcn_rsqf(ss * (1.f / 96.f) + EPS);
            q0 *= rn * qg.x; q1 *= rn * qg.y; q2 *= rn * qg.z; q3 *= rn * qg.w; x1 *= rn * qg1; x2 *= rn * qg2;
            bf16_t* op = MQ + (size_t)tok * 384 + h * 96;
            u32x2 ov; ov.x = cvt_pk(q0, q1); ov.y = cvt_pk(q2, q3);
            *(u32x2*)(op + 4 * j) = ov;
            op[64 + j] = f2bf(x1 * cs - x2 * sn); op[80 + j] = f2bf(x2 * cs + x1 * sn);
        }
        {
            const bf16_t* kp = KVR + (size_t)tok * 512 + h * 128;
            const u32x2 a = *(const u32x2*)(kp + 4 * j);
            float k0 = bflo(a.x) * skv, k1 = bfhi(a.x) * skv, k2 = bflo(a.y) * skv, k3 = bfhi(a.y) * skv;
            float x1 = bf2f(up[2944 + j]), x2 = bf2f(up[2960 + j]);
            float ss = k0 * k0 + k1 * k1 + k2 * k2 + k3 * k3 + x1 * x1 + x2 * x2;
            ss += __shfl_xor(ss, 1); ss += __shfl_xor(ss, 2); ss += __shfl_xor(ss, 4); ss += __shfl_xor(ss, 8);
            const float rn = __builtin_amdgcn_rsqf(ss * (1.f / 96.f) + EPS);
            k0 *= rn * kg.x; k1 *= rn * kg.y; k2 *= rn * kg.z; k3 *= rn * kg.w; x1 *= rn * kg1; x2 *= rn * kg2;
            bf16_t* op = MK + (size_t)tok * 384 + h * 96;
            u32x2 ov; ov.x = cvt_pk(k0, k1); ov.y = cvt_pk(k2, k3);
            *(u32x2*)(op + 4 * j) = ov;
            op[64 + j] = f2bf(x1 * cs - x2 * sn); op[80 + j] = f2bf(x2 * cs + x1 * sn);
            const u32x2 vv = *(const u32x2*)(kp + 64 + 4 * j);
            u32x2 vo; vo.x = cvt_pk(bflo(vv.x) * skv, bfhi(vv.x) * skv); vo.y = cvt_pk(bflo(vv.y) * skv, bfhi(vv.y) * skv);
            *(u32x2*)(vbuf + tl * 256 + h * 64 + 4 * j) = vo;
        }
    }
    __syncthreads();
    {
        const int tid = tidx(), b = (item * 64) / SEQ, s0 = (item * 64) % SEQ, hh = tid >> 6, e = tid & 63;
        bf16_t* dst = MVT + ((size_t)(b * 4 + hh) * 64 + e) * SEQ + s0;
#pragma unroll
        for (int c8 = 0; c8 < 8; ++c8) {
            unsigned wds[4];
#pragma unroll
            for (int k = 0; k < 4; ++k) wds[k] = (unsigned)vbuf[(c8 * 8 + 2 * k) * 256 + tid] | ((unsigned)vbuf[(c8 * 8 + 2 * k + 1) * 256 + tid] << 16);
            uint4 o; o.x = wds[0]; o.y = wds[1]; o.z = wds[2]; o.w = wds[3];
            *(uint4*)(dst + c8 * 8) = o;
        }
    }
    __syncthreads();
}

DI void memkv_finish_tile(const Params& p, int item, unsigned char* smem) {
    const bf16_t* KVM = (const bf16_t*)(p.ws + OFF_KVMEM);
    bf16_t* XK = (bf16_t*)(p.ws + OFF_XK);
    bf16_t* XVT = (bf16_t*)(p.ws + OFF_XVT);
    bf16_t* vbuf = (bf16_t*)smem;
    const int l = item >> 5, b = (item >> 2) & 7, h = item & 3;
    const int w = tidx() >> 6, lane = tidx() & 63;
    const float kg = p.in[I_XKNG][l * 64 + lane];
    for (int r = 0; r < 64; ++r) {
        const int m = w * 64 + r;
        const bf16_t* src = KVM + ((size_t)l * 2048 + b * 256 + m) * 512 + h * 128;
        const float k = bf2f(src[lane]);
        const float rn = __builtin_amdgcn_rsqf(wave_sum(k * k) * (1.f / 64.f) + EPS);
        XK[(((size_t)(l * 8 + b) * 4 + h) * 256 + m) * 64 + lane] = f2bf(k * rn * kg);
        vbuf[m * 64 + lane] = src[64 + lane];
    }
    __syncthreads();
    {
        const int tid = tidx(), e = tid & 63, mq = tid >> 6;
        bf16_t* dst = XVT + (((size_t)(l * 8 + b) * 4 + h) * 64 + e) * 256 + mq * 64;
#pragma unroll
        for (int c8 = 0; c8 < 8; ++c8) {
            unsigned wds[4];
#pragma unroll
            for (int k = 0; k < 4; ++k) wds[k] = (unsigned)vbuf[(mq * 64 + c8 * 8 + 2 * k) * 64 + e] | ((unsigned)vbuf[(mq * 64 + c8 * 8 + 2 * k + 1) * 64 + e] << 16);
            uint4 o; o.x = wds[0]; o.y = wds[1]; o.z = wds[2]; o.w = wds[3];
            *(uint4*)(dst + c8 * 8) = o;
        }
    }
    __syncthreads();
}

template <int DQK, bool QNORM>
DI void attn_tile(const bf16_t* __restrict__ Q, int qs, const bf16_t* __restrict__ Kp, int kstr, const bf16_t* __restrict__ Vt, int vstr, int nkeys,
                  float c2, float mbound, const float* __restrict__ qgain, bf16_t* __restrict__ O, int os, float* __restrict__ ssq, int ssq_stride, unsigned char* smem) {
    constexpr int NKS = DQK / 32, KP = DQK * 2 + 16, KCH = DQK / 8, KB = 64 * KP, VB = 64 * 144, STG = KB + VB, NKL = (64 * KCH) / 256;
    const int tid = tidx(), w = tid >> 6, lane = tid & 63, l15 = lane & 15, quad = lane >> 4;
    bf16x8 bq[2][NKS];
#pragma unroll
    for (int qt = 0; qt < 2; ++qt) {
        const bf16_t* qp = Q + (size_t)(w * 32 + qt * 16 + l15) * qs + quad * 8;
        if (QNORM) {
            float v[NKS][8]; float ss = 0.f;
#pragma unroll
            for (int ks = 0; ks < NKS; ++ks) {
                const uint4 x = *(const uint4*)(qp + ks * 32);
                v[ks][0] = bflo(x.x); v[ks][1] = bfhi(x.x); v[ks][2] = bflo(x.y); v[ks][3] = bfhi(x.y); v[ks][4] = bflo(x.z); v[ks][5] = bfhi(x.z); v[ks][6] = bflo(x.w); v[ks][7] = bfhi(x.w);
#pragma unroll
                for (int j = 0; j < 8; ++j) ss += v[ks][j] * v[ks][j];
            }
            ss += __shfl_xor(ss, 16); ss += __shfl_xor(ss, 32);
            const float rn = __builtin_amdgcn_rsqf(ss * (1.f / DQK) + EPS);
#pragma unroll
            for (int ks = 0; ks < NKS; ++ks) {
                const float* gp = qgain + ks * 32 + quad * 8;
                u32x4 o;
                o.x = cvt_pk(v[ks][0] * rn * gp[0], v[ks][1] * rn * gp[1]); o.y = cvt_pk(v[ks][2] * rn * gp[2], v[ks][3] * rn * gp[3]);
                o.z = cvt_pk(v[ks][4] * rn * gp[4], v[ks][5] * rn * gp[5]); o.w = cvt_pk(v[ks][6] * rn * gp[6], v[ks][7] * rn * gp[7]);
                bq[qt][ks] = __builtin_bit_cast(bf16x8, o);
            }
        } else {
#pragma unroll
            for (int ks = 0; ks < NKS; ++ks) bq[qt][ks] = *(const bf16x8*)(qp + ks * 32);
        }
    }
    f32x4 o[4][2];
    float lrun[2];
#pragma unroll
    for (int qt = 0; qt < 2; ++qt) {
        lrun[qt] = 0.f;
#pragma unroll
        for (int et = 0; et < 4; ++et) o[et][qt] = (f32x4){0.f, 0.f, 0.f, 0.f};
    }
    uint4 ak0, ak1, ak2, av0, av1, bk0, bk1, bk2, bv0, bv1;
    ak2 = make_uint4(0u, 0u, 0u, 0u); bk2 = ak2;
    const int kr0 = tid / KCH, kc0 = tid % KCH, kr1 = (tid + 256) / KCH, kc1 = (tid + 256) % KCH, kr2 = (tid + 512) / KCH, kc2 = (tid + 512) % KCH;
    const int vr0 = tid >> 3, vc0 = tid & 7, vr1 = vr0 + 32;
#define A_LOAD(S, key0) do { S##k0 = *(const uint4*)(Kp + (size_t)((key0) + kr0) * kstr + kc0 * 8); S##k1 = *(const uint4*)(Kp + (size_t)((key0) + kr1) * kstr + kc1 * 8); \
                          if (NKL > 2) S##k2 = *(const uint4*)(Kp + (size_t)((key0) + kr2) * kstr + kc2 * 8); \
                          S##v0 = *(const uint4*)(Vt + (size_t)vr0 * vstr + (key0) + vc0 * 8); S##v1 = *(const uint4*)(Vt + (size_t)vr1 * vstr + (key0) + vc0 * 8); } while (0)
#define A_STORE(S, buf) do { unsigned char* kb_ = smem + (buf) * STG; unsigned char* vb_ = kb_ + KB; \
                          *(uint4*)(kb_ + kr0 * KP + kc0 * 16) = S##k0; *(uint4*)(kb_ + kr1 * KP + kc1 * 16) = S##k1; if (NKL > 2) *(uint4*)(kb_ + kr2 * KP + kc2 * 16) = S##k2; \
                          *(uint4*)(vb_ + vr0 * 144 + vc0 * 16) = S##v0; *(uint4*)(vb_ + vr1 * 144 + vc0 * 16) = S##v1; } while (0)
    const int nkb = nkeys >> 6;
    A_LOAD(a, 0); A_STORE(a, 0);
    A_LOAD(b, 64);
    if (2 < nkb) A_LOAD(a, 128);
    __syncthreads();
#define A_COMPUTE(cur) do { \
        const unsigned char* kb = smem + cur * STG; const unsigned char* vb = kb + KB; \
        f32x4 s[4][2]; \
_Pragma("unroll")         for (int kt = 0; kt < 4; ++kt) { s[kt][0] = (f32x4){0.f, 0.f, 0.f, 0.f}; s[kt][1] = (f32x4){0.f, 0.f, 0.f, 0.f}; } \
_Pragma("unroll")         for (int ks = 0; ks < NKS; ++ks) { \
            bf16x8 ak[4]; \
_Pragma("unroll")             for (int kt = 0; kt < 4; ++kt) ak[kt] = *(const bf16x8*)(kb + (kt * 16 + l15) * KP + ks * 64 + quad * 16); \
_Pragma("unroll")             for (int kt = 0; kt < 4; ++kt) { s[kt][0] = MFMA16(ak[kt], bq[0][ks], s[kt][0]); s[kt][1] = MFMA16(ak[kt], bq[1][ks], s[kt][1]); } \
        } \
        bf16x8 pb[2][2]; \
_Pragma("unroll")         for (int qt = 0; qt < 2; ++qt) { \
            float ls = 0.f; \
            float pv[4][4]; \
_Pragma("unroll")             for (int kt = 0; kt < 4; ++kt) \
_Pragma("unroll")                 for (int r = 0; r < 4; ++r) { pv[kt][r] = __builtin_amdgcn_exp2f(s[kt][qt][r] * c2 - mbound); ls += pv[kt][r]; } \
            lrun[qt] += ls; \
_Pragma("unroll")             for (int k2 = 0; k2 < 2; ++k2) { \
                u32x4 pw; pw.x = cvt_pk(pv[2 * k2][0], pv[2 * k2][1]); pw.y = cvt_pk(pv[2 * k2][2], pv[2 * k2][3]); \
                pw.z = cvt_pk(pv[2 * k2 + 1][0], pv[2 * k2 + 1][1]); pw.w = cvt_pk(pv[2 * k2 + 1][2], pv[2 * k2 + 1][3]); \
                pb[qt][k2] = __builtin_bit_cast(bf16x8, pw); \
            } \
        } \
_Pragma("unroll")         for (int k2 = 0; k2 < 2; ++k2) \
_Pragma("unroll")             for (int et = 0; et < 4; ++et) { \
                const unsigned char* vp = vb + (et * 16 + l15) * 144 + k2 * 64 + quad * 8; \
                const u32x2 lo = *(const u32x2*)vp, hi = *(const u32x2*)(vp + 32); \
                u32x4 a; a.x = lo.x; a.y = lo.y; a.z = hi.x; a.w = hi.y; \
                const bf16x8 av = __builtin_bit_cast(bf16x8, a); \
                o[et][0] = MFMA16(av, pb[0][k2], o[et][0]); \
                o[et][1] = MFMA16(av, pb[1][k2], o[et][1]); \
            } \
    } while (0)
#pragma unroll 1
    for (int jb = 0; jb < nkb; jb += 2) {
        A_STORE(b, 1);
        if (jb + 3 < nkb) A_LOAD(b, (jb + 3) * 64);
        __builtin_amdgcn_sched_barrier(0);
        A_COMPUTE(0);
        __syncthreads();
        if (jb + 2 < nkb) A_STORE(a, 0);
        if (jb + 4 < nkb) A_LOAD(a, (jb + 4) * 64);
        __builtin_amdgcn_sched_barrier(0);
        A_COMPUTE(1);
        __syncthreads();
    }
#undef A_COMPUTE
#undef A_LOAD
#undef A_STORE
#pragma unroll
    for (int qt = 0; qt < 2; ++qt) {
        float lt = lrun[qt]; lt += __shfl_xor(lt, 16); lt += __shfl_xor(lt, 32);
        const float inv = 1.f / lt;
        const int q = w * 32 + qt * 16 + l15;
        float ss = 0.f;
#pragma unroll
        for (int et = 0; et < 4; ++et) {
            const float y0 = o[et][qt][0] * inv, y1 = o[et][qt][1] * inv, y2 = o[et][qt][2] * inv, y3 = o[et][qt][3] * inv;
            ss += y0 * y0 + y1 * y1 + y2 * y2 + y3 * y3;
            u32x2 ov; ov.x = cvt_pk(y0, y1); ov.y = cvt_pk(y2, y3);
            *(u32x2*)(O + (size_t)q * os + et * 16 + quad * 4) = ov;
        }
        if (ssq) { ss += __shfl_xor(ss, 16); ss += __shfl_xor(ss, 32); if (quad == 0) ssq[(size_t)q * ssq_stride] = ss; }
    }
}

namespace pg8 {
#define PG8_LAS __attribute__((address_space(3)))
constexpr int BM = 256, BK = 64, HALF = 128, HTB = HALF * BK * 2, STAGE_BYTES = 8 * HTB, NXCD = 8, WGM = 8;
DI int lds_byte(int r, int c) { const int st = (r >> 4) * 2 + (c >> 5), rr = r & 15, cc = c & 31, ob = rr * 64 + cc * 2; return st * 1024 + (ob ^ (((ob >> 9) & 1) << 5)); }
DI void stage_rc(int b, int& R, int& C) { const int st = b / 1024, sb = b % 1024, swz = sb ^ (((sb >> 9) & 1) << 5); R = (st >> 1) * 16 + swz / 64; C = (st & 1) * 32 + (swz % 64) / 2; }
struct Unit { int pm, pn; };
struct Gemm { const bf16_t* A; const bf16_t* Bt; int M, N, K; };
struct StaticOrder {
    int nM, nN, nwg, G, c;
    DI void init(int M, int N, int G_, int c_) { nM = M / BM; nN = N / BM; nwg = nM * nN; G = G_; c = c_; }
    DI bool next(int i, Unit& u) const {
        const long L = (long)i * G + c; if (L >= nwg) return false;
        int wgid = (int)L; { const int q = nwg / NXCD, r = nwg % NXCD, xcd = wgid % NXCD, off = wgid / NXCD; wgid = (xcd < r ? xcd * (q + 1) : r * (q + 1) + (xcd - r) * q) + off; }
        const int nig = WGM * nN, gid = wgid / nig, fm = gid * WGM, gsz = (nM - fm) < WGM ? (nM - fm) : WGM;
        u.pm = fm + ((wgid % nig) % gsz); u.pn = (wgid % nig) / gsz; return true;
    }
};
DI float row_rstd(const float* part, int row) {
    const float4* p4 = (const float4*)(part + (size_t)row * 16);
    const float4 a = p4[0], b = p4[1], c = p4[2], d = p4[3];
    const float s = (a.x + a.y + a.z + a.w) + (b.x + b.y + b.z + b.w) + (c.x + c.y + c.z + c.w) + (d.x + d.y + d.z + d.w);
    return __builtin_amdgcn_rsqf(s * (1.f / DM) + EPS);
}
struct EpiScaled {
    bf16_t* O; int ldo; const float* part;
    DI void operator()(const f32x4 (&acc)[2][2][4][2], const Unit& u, int wr, int wc, int fr, int fq) const {
#pragma unroll
        for (int ai = 0; ai < 2; ++ai)
#pragma unroll
            for (int m = 0; m < 4; ++m) {
                const int row = u.pm * BM + ai * HALF + wr * 64 + m * 16 + fr;
                const float sc = row_rstd(part, row);
                bf16_t* rowp = O + (size_t)row * ldo + u.pn * BM + wc * 32 + fq * 4;
#pragma unroll
                for (int bj = 0; bj < 2; ++bj)
#pragma unroll
                    for (int n = 0; n < 2; ++n) {
                        u32x2 v; v.x = cvt_pk(acc[ai][bj][m][n][0] * sc, acc[ai][bj][m][n][1] * sc); v.y = cvt_pk(acc[ai][bj][m][n][2] * sc, acc[ai][bj][m][n][3] * sc);
                        *(u32x2*)(rowp + bj * HALF + n * 16) = v;
                    }
            }
    }
};
struct EpiSwiglu {
    bf16_t* H; const float* part;
    DI void operator()(const f32x4 (&acc)[2][2][4][2], const Unit& u, int wr, int wc, int fr, int fq) const {
#pragma unroll
        for (int ai = 0; ai < 2; ++ai)
#pragma unroll
            for (int m = 0; m < 4; ++m) {
                const int row = u.pm * BM + ai * HALF + wr * 64 + m * 16 + fr;
                const float sc = row_rstd(part, row);
                bf16_t* rowp = H + (size_t)row * DFF + ((u.pn * BM + wc * 32) >> 1) + fq * 4;
#pragma unroll
                for (int bj = 0; bj < 2; ++bj) {
                    float h[4];
#pragma unroll
                    for (int j = 0; j < 4; ++j) { const float a1 = acc[ai][bj][m][0][j] * sc, a3 = acc[ai][bj][m][1][j] * sc; h[j] = a1 * sigmoidf_(a1) * a3; }
                    u32x2 v; v.x = cvt_pk(h[0], h[1]); v.y = cvt_pk(h[2], h[3]);
                    *(u32x2*)(rowp + bj * (HALF / 2)) = v;
                }
            }
    }
};
struct EpiResid {
    bf16_t* XB; float* rowsq; float* OUT;
    DI void operator()(const f32x4 (&acc)[2][2][4][2], const Unit& u, int wr, int wc, int fr, int fq) const {
#pragma unroll
        for (int ai = 0; ai < 2; ++ai)
#pragma unroll
            for (int m = 0; m < 4; ++m) {
                const int row = u.pm * BM + ai * HALF + wr * 64 + m * 16 + fr;
                float ss = 0.f;
#pragma unroll
                for (int bj = 0; bj < 2; ++bj)
#pragma unroll
                    for (int n = 0; n < 2; ++n) {
                        const int col = u.pn * BM + bj * HALF + wc * 32 + n * 16 + fq * 4;
                        u32x2* xp = (u32x2*)(XB + (size_t)row * DM + col);
                        const u32x2 xo = *xp;
                        const float x0 = bflo(xo.x) + acc[ai][bj][m][n][0], x1 = bfhi(xo.x) + acc[ai][bj][m][n][1];
                        const float x2 = bflo(xo.y) + acc[ai][bj][m][n][2], x3 = bfhi(xo.y) + acc[ai][bj][m][n][3];
                        u32x2 v; v.x = cvt_pk(x0, x1); v.y = cvt_pk(x2, x3);
                        *xp = v;
                        if (OUT) *(f32x4*)(OUT + (size_t)row * DM + col) = (f32x4){x0, x1, x2, x3};
                        ss += x0 * x0 + x1 * x1 + x2 * x2 + x3 * x3;
                    }
                ss += __shfl_xor(ss, 16); ss += __shfl_xor(ss, 32);
                if (fq == 0) rowsq[(size_t)row * 16 + u.pn * 4 + wc] = ss;
            }
    }
};

template <class Epi, bool SCALED = false>
DI void gemm_phase(PG8_LAS unsigned char* lds, const Gemm g, const StaticOrder& S, const Epi& E, const float* ssq0 = nullptr, const float* ssq1 = nullptr) {
    int tid = threadIdx.x; asm volatile("" : "+v"(tid));
    const int wid = __builtin_amdgcn_readfirstlane(tid >> 6), lane = tid & 63, wr = wid >> 2, wc = wid & 3, fr = lane & 15, fq = lane >> 4;
    const int K = g.K, nt = K / BK;
    unsigned voffA[2];
#pragma unroll
    for (int i = 0; i < 2; ++i) { int R, C; stage_rc(tid * 16 + i * 8192, R, C); voffA[i] = (unsigned)(R * K + C) * 2u; }
    const size_t kstep = (size_t)(BK * 2);
    const size_t hstep = (size_t)HALF * K * 2;
    const size_t tstep = 2 * hstep;
    const unsigned ldsw = (unsigned)wid * 1024u;
    const int aoff = lds_byte(wr * 64 + fr, fq * 8), boff = lds_byte(wc * 32 + fr, fq * 8);
#define PG8_SA(b, h) (((b) * 2 + (h)) * HTB)
#define PG8_SB(b, h) ((4 + (b) * 2 + (h)) * HTB)
#define PG8_STAGE(bufoff, gbase) do { _Pragma("unroll") for (int _i = 0; _i < 2; ++_i) \
        __builtin_amdgcn_global_load_lds((const unsigned*)((const char*)(gbase) + voffA[_i]), (PG8_LAS unsigned*)(lds + (bufoff) + ldsw + _i * 8192), 16, 0, 0); } while (0)
#define PG8_LDA(dst, b, h) do { _Pragma("unroll") for (int m = 0; m < 4; ++m) _Pragma("unroll") for (int k = 0; k < 2; ++k) dst[m][k] = *(const PG8_LAS bf16x8*)(lds + PG8_SA(b, h) + aoff + m * 2048 + k * 1024); } while (0)
#define PG8_LDB(dst, b, h) do { _Pragma("unroll") for (int n = 0; n < 2; ++n) _Pragma("unroll") for (int k = 0; k < 2; ++k) dst[n][k] = *(const PG8_LAS bf16x8*)(lds + PG8_SB(b, h) + boff + n * 2048 + k * 1024); } while (0)
#define PG8_MMA(ai, bj, At, Bt) do { __builtin_amdgcn_s_setprio(1); _Pragma("unroll") for (int m = 0; m < 4; ++m) _Pragma("unroll") for (int n = 0; n < 2; ++n) _Pragma("unroll") for (int k = 0; k < 2; ++k) \
        acc[ai][bj][m][n] = __builtin_amdgcn_mfma_f32_16x16x32_bf16(Bt[n][k], At[m][k], acc[ai][bj][m][n], 0, 0, 0); __builtin_amdgcn_s_setprio(0); } while (0)
#define PG8_WAIT_V(n) asm volatile("s_waitcnt vmcnt(" #n ")" ::: "memory")
#define PG8_WAIT_L(n) asm volatile("s_waitcnt lgkmcnt(" #n ")" ::: "memory")
#define PG8_BAR __builtin_amdgcn_s_barrier()
#define PG8_SCHED __builtin_amdgcn_sched_barrier(0)
    Unit cur, nxt; int ui = 0;
    if (!S.next(0, cur)) return;
    f32x4 acc[2][2][4][2];
#pragma unroll
    for (int a = 0; a < 2; ++a)
#pragma unroll
        for (int b = 0; b < 2; ++b)
#pragma unroll
            for (int m = 0; m < 4; ++m)
#pragma unroll
                for (int n = 0; n < 2; ++n) acc[a][b][m][n] = (f32x4){0.f, 0.f, 0.f, 0.f};
    bf16x8 At[4][2], B0[2][2], B1[2][2];
    const char* cA = (const char*)g.A + (size_t)cur.pm * tstep; const char* cB = (const char*)g.Bt + (size_t)cur.pn * tstep;
#define PG8_FTAB(unit) do { if (SCALED && tid < 256) { const int row_ = (unit).pm * BM + tid; \
        const float4 sb_ = *(const float4*)(ssq0 + (size_t)row_ * 4), sd_ = *(const float4*)(ssq1 + (size_t)row_ * 4); \
        const float rB_ = __builtin_amdgcn_rsqf((sb_.x + sb_.y + sb_.z + sb_.w) * (1.f / 256.f) + EPS), rD_ = __builtin_amdgcn_rsqf((sd_.x + sd_.y + sd_.z + sd_.w) * (1.f / 256.f) + EPS); \
        PG8_LAS float* ft_ = (PG8_LAS float*)(lds + STAGE_BYTES); ft_[tid] = rB_ / rD_; ft_[256 + tid] = rD_; } } while (0)
    PG8_FTAB(cur);
    PG8_STAGE(PG8_SB(0, 0), cB); PG8_STAGE(PG8_SB(0, 1), cB + hstep); PG8_STAGE(PG8_SA(0, 0), cA); PG8_STAGE(PG8_SA(0, 1), cA + hstep);
    if (wr == 1) PG8_BAR;
    PG8_WAIT_V(2); PG8_BAR;
    PG8_STAGE(PG8_SB(1, 0), cB + kstep); PG8_STAGE(PG8_SA(1, 0), cA + kstep); PG8_STAGE(PG8_SB(1, 1), cB + hstep + kstep);
    PG8_WAIT_V(6); PG8_BAR;
    for (;;) {
        const bool has_next = S.next(ui + 1, nxt);
        const char* nA = has_next ? (const char*)g.A + (size_t)nxt.pm * tstep : cA; const char* nB = has_next ? (const char*)g.Bt + (size_t)nxt.pn * tstep : cB;
        for (int t = 0; t < nt; t += 2) {
            const bool last = (t == nt - 2);
            const char* a1 = cA + (size_t)(t + 1) * kstep;
            const char* a2 = last ? nA : cA + (size_t)(t + 2) * kstep; const char* b2 = last ? nB : cB + (size_t)(t + 2) * kstep;
            const char* a3 = a2 + kstep; const char* b3 = b2 + kstep;
            if (SCALED && (t == 4 || t == 8)) {
                const PG8_LAS float* ft = (const PG8_LAS float*)(lds + STAGE_BYTES) + (t == 8 ? 256 : 0);
#pragma unroll
                for (int ai = 0; ai < 2; ++ai)
#pragma unroll
                    for (int m = 0; m < 4; ++m) {
                        const float f = ft[ai * HALF + wr * 64 + m * 16 + fr];
#pragma unroll
                        for (int bj = 0; bj < 2; ++bj)
#pragma unroll
                            for (int n = 0; n < 2; ++n) acc[ai][bj][m][n] *= f;
                    }
            }
            PG8_LDB(B0, 0, 0); PG8_LDB(B1, 0, 1); PG8_SCHED; PG8_LDA(At, 0, 0); PG8_STAGE(PG8_SA(1, 1), a1 + hstep);
            PG8_WAIT_V(8); PG8_WAIT_L(0); PG8_BAR; PG8_MMA(0, 0, At, B0); PG8_MMA(0, 1, At, B1); PG8_BAR; PG8_SCHED;
            PG8_LDA(At, 0, 1); PG8_STAGE(PG8_SB(0, 0), b2); PG8_STAGE(PG8_SB(0, 1), b2 + hstep); PG8_STAGE(PG8_SA(0, 0), a2);
            PG8_WAIT_V(8); PG8_WAIT_L(0); PG8_BAR; PG8_MMA(1, 0, At, B0); PG8_MMA(1, 1, At, B1); PG8_BAR; PG8_SCHED;
            PG8_LDB(B0, 1, 0); PG8_LDB(B1, 1, 1); PG8_SCHED; PG8_LDA(At, 1, 0); PG8_STAGE(PG8_SA(0, 1), a2 + hstep);
            PG8_WAIT_V(8); PG8_WAIT_L(0); PG8_BAR; PG8_MMA(0, 0, At, B0); PG8_MMA(0, 1, At, B1); PG8_BAR; PG8_SCHED;
            PG8_LDA(At, 1, 1); PG8_STAGE(PG8_SB(1, 0), b3); PG8_STAGE(PG8_SB(1, 1), b3 + hstep); PG8_STAGE(PG8_SA(1, 0), a3);
            PG8_WAIT_V(8); PG8_WAIT_L(0); PG8_BAR; PG8_MMA(1, 0, At, B0); PG8_MMA(1, 1, At, B1); PG8_BAR; PG8_SCHED;
        }
        if (wr == 0) PG8_BAR;
        E(acc, cur, wr, wc, fr, fq);
        if (!has_next) break;
#pragma unroll
        for (int a = 0; a < 2; ++a)
#pragma unroll
            for (int b = 0; b < 2; ++b)
#pragma unroll
                for (int m = 0; m < 4; ++m)
#pragma unroll
                    for (int n = 0; n < 2; ++n) acc[a][b][m][n] = (f32x4){0.f, 0.f, 0.f, 0.f};
        cur = nxt; cA = nA; cB = nB; ++ui;
        if (wr == 1) PG8_BAR;
        PG8_FTAB(cur);
    }
    PG8_WAIT_V(0);
    PG8_BAR;
#undef PG8_FTAB
#undef PG8_SA
#undef PG8_SB
#undef PG8_STAGE
#undef PG8_LDA
#undef PG8_LDB
#undef PG8_MMA
#undef PG8_WAIT_V
#undef PG8_WAIT_L
#undef PG8_BAR
#undef PG8_SCHED
}
}

enum { PH_PRO = 0, PH_CONV, PH_P1, PH_P2, PH_P3, PH_P4, PH_P5, PH_P6, PH_P7, PH_P8, PH_P9, PH_P10, PH_COUNT };

DI void gemm_item_bf16(const bf16_t* A, int lda, const bf16_t* Bt, int K, int nM, int nN, int L, bf16_t* O, int ldo, const float* part, int npart, float inv_n, unsigned char* smem) {
    int pm, pn; tile_order(L, nM, nN, pm, pn);
    if (part) fill_rs(smem, part, npart, pm * 128, inv_n);
    f32x4 acc[4][4];
    gemm_mainloop<false>(A, lda, Bt, K, pm * 128, pn * 128, smem, acc);
    epi_bf16(acc, O, ldo, pm * 128, pn * 128, part ? (const float*)(smem + 65536) : nullptr);
    __syncthreads();
}
template <bool ASC>
DI void gemm_item_resid(const Params& p, const bf16_t* A, int lda, const bf16_t* Bt, int K, int L, unsigned char* smem) {
    int pm, pn; tile_order(L, 256, 8, pm, pn);
    if (ASC) {
        float* asc = (float*)(smem + 66048);
        const float* sb = (const float*)(p.ws + OFF_SSQB); const float* sd = (const float*)(p.ws + OFF_SSQD);
        const int tid = tidx();
        if (tid < 128) {
            const float4 a = *(const float4*)(sb + (size_t)(pm * 128 + tid) * 4), d = *(const float4*)(sd + (size_t)(pm * 128 + tid) * 4);
            asc[tid * 2] = __builtin_amdgcn_rsqf((a.x + a.y + a.z + a.w) * (1.f / 256.f) + EPS);
            asc[tid * 2 + 1] = __builtin_amdgcn_rsqf((d.x + d.y + d.z + d.w) * (1.f / 256.f) + EPS);
        }
    }
    f32x4 acc[4][4];
    gemm_mainloop<ASC>(A, lda, Bt, K, pm * 128, pn * 128, smem, acc);
    epi_resid(acc, p.out, (bf16_t*)(p.ws + OFF_XB), (float*)(p.ws + OFF_ROWSQ), pm * 128, pn * 128);
    __syncthreads();
}

DI void run_phase(const Params& p, int ph, int l, unsigned char* smem0) {
    const int vb = __builtin_amdgcn_readfirstlane((int)(threadIdx.x >> 8));
    unsigned char* smem = smem0 + vb * LDS_BYTES;
    const int G = gridDim.x * 2, bid = blockIdx.x * 2 + vb;
    const bf16_t* W = (const bf16_t*)(p.ws + OFF_W);
    const bf16_t* XB = (const bf16_t*)(p.ws + OFF_XB);
    bf16_t* U = (bf16_t*)(p.ws + OFF_U);
    const float* ROWSQ = (const float*)(p.ws + OFF_ROWSQ);
#ifdef ONLY_PH
    if (ph != ONLY_PH) return;
#endif
    switch (ph) {
    case PH_PRO: {
        for (int i = bid; i < 2048; i += G) pro_rows(p.in[I_X], nullptr, (bf16_t*)(p.ws + OFF_XB), (float*)(p.ws + OFF_ROWSQ), 16, i);
        for (int i = bid; i < 128; i += G) pro_rows(p.in[I_MEM], nullptr, (bf16_t*)(p.ws + OFF_MEMB), (float*)(p.ws + OFF_MEMSQ), 1, i);
        for (int i = bid; i < 128; i += G) pro_rope(p, i);
        for (int i = bid; i < 512; i += G) { const int ll = i >> 7; conv_tile(p.in[I_XWKV] + (size_t)ll * DM * 512, DM, 512, 512, p.in[I_GMEM] + ll * DM, 0, (bf16_t*)(p.ws + OFF_XWKV) + (size_t)ll * 512 * DM, i & 127, smem); }
        for (int i = bid; i < CONV_TILES; i += G) conv_layer_item(p, 0, i, smem);
    } break;
    case PH_CONV: {
        for (int it = bid; it < CONV_TILES; it += G) conv_layer_item(p, l, it, smem);
    } break;
    case PH_P1: {
        { pg8::Gemm g{XB, W + W_IN, T_TOK, UC, DM}; pg8::StaticOrder S; S.init(T_TOK, UC, gridDim.x, blockIdx.x);
          pg8::EpiScaled E{U, UC, ROWSQ};
          pg8::gemm_phase<pg8::EpiScaled>((PG8_LAS unsigned char*)smem0, g, S, E); }
        if (l == 0) {
            for (int i = bid; i < 256; i += G) {
                const int ll = i >> 6;
                gemm_item_bf16((const bf16_t*)(p.ws + OFF_MEMB), DM, (const bf16_t*)(p.ws + OFF_XWKV) + (size_t)ll * 512 * DM, DM, 16, 4, i & 63,
                               (bf16_t*)(p.ws + OFF_KVMEM) + (size_t)ll * 2048 * 512, 512, (const float*)(p.ws + OFF_MEMSQ), 1, 1.f / DM, smem);
            }
        }
    } break;
    case PH_P2: {
        for (int i = bid; i < 1024; i += G) hgrn_local_tile(p, l, i, smem);
#ifdef RP2_HL
        for (int i = bid; i < 1024; i += G) hgrn_local_tile(p, l, i, smem);
#endif
        for (int i = bid; i < 1024; i += G) conformer_tile(p, l, i, smem);
#ifdef RP2_CF
        for (int i = bid; i < 1024; i += G) conformer_tile(p, l, i, smem);
#endif
#ifdef RP2_G
        for (int i = bid; i < 768; i += G) gemm_item_bf16(U + 2560, UC, W + W_UQ, 256, 256, 3, i, (bf16_t*)((unsigned char*)p.out + QRAW_IN_OUT), 384, nullptr, 0, 0.f, smem);
        for (int i = bid; i < 1024; i += G) gemm_item_bf16(U + 2816, UC, W + W_UKV, 128, 256, 4, i, (bf16_t*)((unsigned char*)p.out + KVRAW_IN_OUT), 512, nullptr, 0, 0.f, smem);
#endif
#ifdef RP2_SC
        for (int i = bid; i < 512; i += G) shortconv_tile(p, l, i);
#endif
        for (int i = bid; i < 768; i += G) gemm_item_bf16(U + 2560, UC, W + W_UQ, 256, 256, 3, i, (bf16_t*)((unsigned char*)p.out + QRAW_IN_OUT), 384, nullptr, 0, 0.f, smem);
        for (int i = bid; i < 1024; i += G) gemm_item_bf16(U + 2816, UC, W + W_UKV, 128, 256, 4, i, (bf16_t*)((unsigned char*)p.out + KVRAW_IN_OUT), 512, nullptr, 0, 0.f, smem);
        for (int i = bid; i < 512; i += G) shortconv_tile(p, l, i);
        if (l == 0) { for (int i = bid; i < 128; i += G) memkv_finish_tile(p, i, smem); }
    } break;
    case PH_P3: {
        for (int i = bid; i < 1024; i += G) hgrn_scan_item(p, i);
        for (int i = bid; i < 512; i += G) mla_finish_tile(p, l, i, smem);
#ifdef RP3_MF
        for (int i = bid; i < 512; i += G) mla_finish_tile(p, l, i, smem);
#endif
#ifdef RP3_SC
        for (int i = bid; i < 1024; i += G) hgrn_scan_dummy(p, i);
#endif
    } break;
    case PH_P4: {
        const float c2 = 0.10206207261596575f * 1.4426950408889634f;
        float mb;
        {
            const int ln = tidx() & 63;
            float gq = fmaxf(fabsf(p.in[I_MQNG][l * 96 + ln]), ln < 32 ? fabsf(p.in[I_MQNG][l * 96 + 64 + ln]) : 0.f);
            float gk = fmaxf(fabsf(p.in[I_MKNG][l * 96 + ln]), ln < 32 ? fabsf(p.in[I_MKNG][l * 96 + 64 + ln]) : 0.f);
#pragma unroll
            for (int o = 32; o > 0; o >>= 1) { gq = fmaxf(gq, __shfl_xor(gq, o)); gk = fmaxf(gk, __shfl_xor(gk, o)); }
            mb = 96.f * gq * gk * c2;
        }
        for (int it0 = bid; it0 < 1024; it0 += G) {
            const int xcd = blockIdx.x & 7, jx = ((blockIdx.x >> 3) << 1) + vb, loc = (it0 / G) * 64 + jx;
            const int it = (G == 512) ? (xcd * 128 + loc) : it0;
            const int bh = it >> 5, qt = it & 31, b = bh >> 2, h = bh & 3;
            const size_t tok0 = (size_t)b * SEQ + qt * 128;
            attn_tile<96, false>((const bf16_t*)(p.ws + OFF_MQ) + tok0 * 384 + h * 96, 384, (const bf16_t*)(p.ws + OFF_MK) + (size_t)b * SEQ * 384 + h * 96, 384,
                                 (const bf16_t*)(p.ws + OFF_MVT) + (size_t)bh * 64 * SEQ, SEQ, SEQ, c2, mb, nullptr,
                                 (bf16_t*)(p.ws + OFF_CAT) + tok0 * DM + 256 + h * 64, DM, (float*)(p.ws + OFF_SSQD) + tok0 * 4 + h, 4, smem);
        }
        for (int i = bid; i < 2048; i += G) hgrn_out_tile(p, l, i, smem);
#ifdef REPEAT_HGOUT
        for (int i = bid; i < 2048; i += G) hgrn_out_tile(p, l, i, smem);
#endif
    } break;
    case PH_P5: {
        pg8::Gemm g{(const bf16_t*)(p.ws + OFF_CAT), W + W_OUT, T_TOK, DM, DM}; pg8::StaticOrder S; S.init(T_TOK, DM, gridDim.x, blockIdx.x);
        pg8::EpiResid E{(bf16_t*)(p.ws + OFF_XB), (float*)(p.ws + OFF_ROWSQ), nullptr};
        pg8::gemm_phase<pg8::EpiResid, true>((PG8_LAS unsigned char*)smem0, g, S, E, (const float*)(p.ws + OFF_SSQB), (const float*)(p.ws + OFF_SSQD));
    } break;
    case PH_P6: {
        for (int it = bid; it < 512; it += G) gemm_item_bf16(XB, DM, W + W_XQ, DM, 256, 2, it, (bf16_t*)(p.ws + OFF_XQ), 256, ROWSQ, 16, 1.f / DM, smem);
    } break;
    case PH_P7: {
        const float c2 = 0.125f * 1.4426950408889634f;
        float mb;
        {
            const int ln = tidx() & 63;
            float gq = fabsf(p.in[I_XQNG][l * 64 + ln]), gk = fabsf(p.in[I_XKNG][l * 64 + ln]);
#pragma unroll
            for (int o = 32; o > 0; o >>= 1) { gq = fmaxf(gq, __shfl_xor(gq, o)); gk = fmaxf(gk, __shfl_xor(gk, o)); }
            mb = 64.f * gq * gk * c2;
        }
        for (int it0 = bid; it0 < 1024; it0 += G) {
            const int xcd = blockIdx.x & 7, jx = ((blockIdx.x >> 3) << 1) + vb, loc = (it0 / G) * 64 + jx;
            const int it = (G == 512) ? (xcd * 128 + loc) : it0;
            const int bh = it >> 5, qt = it & 31, b = bh >> 2, h = bh & 3;
            const size_t tok0 = (size_t)b * SEQ + qt * 128;
            attn_tile<64, true>((const bf16_t*)(p.ws + OFF_XQ) + tok0 * 256 + h * 64, 256, (const bf16_t*)(p.ws + OFF_XK) + ((size_t)(l * 8 + b) * 4 + h) * 256 * 64, 64,
                                (const bf16_t*)(p.ws + OFF_XVT) + ((size_t)(l * 8 + b) * 4 + h) * 64 * 256, 256, 256, c2, mb, p.in[I_XQNG] + l * 64,
                                (bf16_t*)(p.ws + OFF_XO) + tok0 * 256 + h * 64, 256, nullptr, 0, smem);
        }
    } break;
    case PH_P8: {
        pg8::Gemm g{(const bf16_t*)(p.ws + OFF_XO), W + W_XO, T_TOK, DM, 256}; pg8::StaticOrder S; S.init(T_TOK, DM, gridDim.x, blockIdx.x);
        pg8::EpiResid E{(bf16_t*)(p.ws + OFF_XB), (float*)(p.ws + OFF_ROWSQ), nullptr};
        pg8::gemm_phase<pg8::EpiResid>((PG8_LAS unsigned char*)smem0, g, S, E);
    } break;
    case PH_P9: {
        pg8::Gemm g{XB, W + W_13, T_TOK, 2 * DFF, DM}; pg8::StaticOrder S; S.init(T_TOK, 2 * DFF, gridDim.x, blockIdx.x);
        pg8::EpiSwiglu E{(bf16_t*)(p.ws + OFF_HFF), ROWSQ};
        pg8::gemm_phase<pg8::EpiSwiglu>((PG8_LAS unsigned char*)smem0, g, S, E);
    } break;
    case PH_P10: {
        pg8::Gemm g{(const bf16_t*)(p.ws + OFF_HFF), W + W_2, T_TOK, DM, DFF}; pg8::StaticOrder S; S.init(T_TOK, DM, gridDim.x, blockIdx.x);
        pg8::EpiResid E{(bf16_t*)(p.ws + OFF_XB), (float*)(p.ws + OFF_ROWSQ), (l == NL - 1) ? p.out : nullptr};
        pg8::gemm_phase<pg8::EpiResid>((PG8_LAS unsigned char*)smem0, g, S, E);
    } break;
    }
}

#define XB_TMO      128
#define XB_XCNT(j)  (256  + 64 * (j))
#define XB_XSUB(j)  (1280 + 64 * (j))
#define XB_XGEN(j)  (2304 + 64 * (j))
#define XB_TOP      3328
#define XB_TOPGEN   3392
#define XCD_BAR_WORDS 3456
#define XB_SPIN_CAP (1u << 22)
#define LAS __attribute__((address_space(3)))
DI unsigned xb_ld(unsigned* p)              { return __hip_atomic_load(p, __ATOMIC_RELAXED, __HIP_MEMORY_SCOPE_AGENT); }
DI unsigned xb_add(unsigned* p, unsigned v) { return __hip_atomic_fetch_add(p, v, __ATOMIC_RELAXED, __HIP_MEMORY_SCOPE_AGENT); }
DI unsigned xb_xcc_id() { return (unsigned)__builtin_amdgcn_s_getreg((3 << 11) | 20) & 0xFu; }
#define XB_SPIN(cond, bar) do { unsigned _sp = 0; while (cond) { __builtin_amdgcn_s_sleep(1); \
    if ((++_sp & 255u) == 0u) { if (xb_ld(&(bar)[XB_TMO])) break; if (_sp > XB_SPIN_CAP) { atomicAdd(&(bar)[XB_TMO], 1u); break; } } } } while (0)
struct XcdBarrier { unsigned* bar; unsigned x; volatile LAS unsigned* st; };
DI XcdBarrier xcd_barrier_post(unsigned* bar, volatile LAS unsigned* st) {
    XcdBarrier b; b.bar = bar; b.x = xb_xcc_id(); b.st = st;
    if (threadIdx.x == 0) (void)xb_add(&bar[XB_XCNT(b.x)], 1u);
    return b;
}
DI void xcd_barrier_complete(unsigned* bar, unsigned x, unsigned& nloc, unsigned& nx) {
    const unsigned G = gridDim.x * gridDim.y * gridDim.z;
    unsigned sum, cnt, mine, sp = 0u;
    for (;;) {
        sum = 0u; cnt = 0u; mine = 0u;
#pragma unroll
        for (unsigned j = 0; j < 16; ++j) { const unsigned c = xb_ld(&bar[XB_XCNT(j)]); sum += c; cnt += (c > 0u) ? 1u : 0u; mine = (j == x) ? c : mine; }
        if (sum == G) break;
        __builtin_amdgcn_s_sleep(1);
        if ((++sp & 255u) == 0u) { if (xb_ld(&bar[XB_TMO])) break; if (sp > XB_SPIN_CAP) { atomicAdd(&bar[XB_TMO], 1u); break; } }
    }
    nloc = mine > 0u ? mine : 1u; nx = cnt > 0u ? cnt : 1u;
}
DI void xcd_barrier(const XcdBarrier& b) {
    asm volatile("s_waitcnt vmcnt(0)" ::: "memory");
    __syncthreads();
    if (threadIdx.x == 0) {
        unsigned* bar = b.bar;
        __builtin_amdgcn_s_waitcnt(0);
        unsigned nloc = b.st[0], nx = b.st[1];
        if (nloc == 0u) { xcd_barrier_complete(bar, b.x, nloc, nx); b.st[0] = nloc; b.st[1] = nx; }
        const unsigned old = xb_add(&bar[XB_XSUB(b.x)], 1u);
        const unsigned gen = old / nloc;
        if (old + 1u == (gen + 1u) * nloc) {
            __builtin_amdgcn_fence(__ATOMIC_RELEASE, "agent");
            asm volatile("s_waitcnt vmcnt(0)" ::: "memory");
            const unsigned og = xb_add(&bar[XB_TOP], 1u);
            const unsigned tg = og / nx;
            if (og + 1u == (tg + 1u) * nx) xb_add(&bar[XB_TOPGEN], 1u);
            else XB_SPIN(xb_ld(&bar[XB_TOPGEN]) == tg, bar);
            __builtin_amdgcn_fence(__ATOMIC_ACQUIRE, "agent");
            xb_add(&bar[XB_XGEN(b.x)], 1u);
            asm volatile("s_waitcnt vmcnt(0)" ::: "memory");
        } else {
            XB_SPIN(xb_ld(&bar[XB_XGEN(b.x)]) == gen, bar);
            __builtin_amdgcn_fence(__ATOMIC_ACQUIRE, "agent");
            asm volatile("s_waitcnt vmcnt(0)" ::: "memory");
        }
    }
    __syncthreads();
}

extern __shared__ __attribute__((aligned(16))) unsigned char dyn_smem[];

__global__ void __launch_bounds__(512, 2) mega_kernel(Params p) {
    cg::grid_group grid = cg::this_grid();
    volatile LAS unsigned* st = (volatile LAS unsigned*)(dyn_smem + 2 * LDS_BYTES);
    if (threadIdx.x == 0) { st[0] = 0u; st[1] = 0u; st[2] = 0u; st[3] = 0u; }
    __syncthreads();
    XcdBarrier xb = xcd_barrier_post((unsigned*)(p.ws + WS_BAR), st);
    const int nsteps = p.ph_hi;
    const bool single = (p.ph_hi - p.ph_lo) == 1;
    for (int step = p.ph_lo; step < nsteps; ++step) {
        int ph, l;
        if (step == 0) { ph = PH_PRO; l = 0; }
        else { l = (step - 1) / 11; ph = PH_CONV + (step - 1) % 11; }
        if (ph == PH_CONV && l == 0) continue;
        run_phase(p, ph, l, dyn_smem);
#ifdef REPEAT_PH
        if (ph == REPEAT_PH) { xcd_barrier(xb); run_phase(p, ph, l, dyn_smem); }
#endif
        if (single) break;
        if (p.pad == 0x5eed) grid.sync();
        if (step + 1 < nsteps) xcd_barrier(xb);
    }
}

extern "C" void kernel_launch(void* const* d_in, const int* in_sizes, int n_in, void* d_out, int out_size, void* d_ws, size_t ws_size, hipStream_t stream) {
    static int grid = 0;
    if (grid == 0) {
        if (n_in != N_IN || ws_size < WS_END + 256 || out_size != T_TOK * DM) { fprintf(stderr, "kernel_launch: unexpected sizes n_in %d ws %zu (need %zu) out %d\n", n_in, ws_size, (size_t)WS_END, out_size); grid = -1; return; }
        int dev = 0, cus = 0, per_cu = 0;
        (void)hipGetDevice(&dev);
        (void)hipDeviceGetAttribute(&cus, hipDeviceAttributeMultiprocessorCount, dev);
        (void)hipFuncSetAttribute((const void*)mega_kernel, hipFuncAttributeMaxDynamicSharedMemorySize, LDS_ALLOC);
        (void)hipOccupancyMaxActiveBlocksPerMultiprocessor(&per_cu, (const void*)mega_kernel, 512, LDS_ALLOC);
        if (per_cu < 1) fprintf(stderr, "kernel_launch: occupancy query says %d blocks per CU\n", per_cu);
        grid = cus;
        (void)hipGetLastError();
    }
    if (grid < 0) return;
    Params p{};
    for (int i = 0; i < N_IN; ++i) p.in[i] = (const float*)d_in[i];
    p.out = (float*)d_out; p.ws = (unsigned char*)d_ws;
    (void)hipMemsetAsync((unsigned char*)d_ws + WS_BAR, 0, XCD_BAR_WORDS * 4, stream);
    p.ph_lo = 0; p.ph_hi = 1 + NL * 11;
    void* args[] = {&p};
    hipError_t e = hipLaunchCooperativeKernel((const void*)mega_kernel, dim3(grid), dim3(512), args, LDS_ALLOC, stream);
    if (e != hipSuccess) fprintf(stderr, "cooperative launch failed: %s (grid %d)\n", hipGetErrorString(e), grid);
}
```

```cpp
#include <hip/hip_runtime.h>
#include <hip/hip_cooperative_groups.h>
#include <cstdio>
#include <cstdint>
namespace cg = cooperative_groups;

#ifndef MEGA
#define MEGA 1
#endif

typedef unsigned short bf16_t;
typedef short bf16x8 __attribute__((ext_vector_type(8)));
typedef float f32x4 __attribute__((ext_vector_type(4)));
typedef unsigned u32x4 __attribute__((ext_vector_type(4)));
typedef unsigned u32x2 __attribute__((ext_vector_type(2)));

#define DI __device__ __forceinline__
#define MFMA16(a, b, c) __builtin_amdgcn_mfma_f32_16x16x32_bf16((a), (b), (c), 0, 0, 0)

constexpr int T_TOK = 32768, SEQ = 4096, NB = 8, DM = 1024, NL = 4;
constexpr int UC = 3072;
constexpr int INC = 2976;
constexpr int DFF = 2816;
constexpr float EPS = 1e-6f;
constexpr int LDS_BYTES = 73728;
constexpr int LDS_ALLOC = 2 * LDS_BYTES + 16;

constexpr size_t SZ_W = 13533184ull * 2;
constexpr size_t OFF_W = 0;
constexpr size_t OFF_XWKV = OFF_W + SZ_W;
constexpr size_t OFF_XB = OFF_XWKV + 4ull * 512 * 1024 * 2;
constexpr size_t OFF_MEMB = OFF_XB + (size_t)T_TOK * 1024 * 2;
constexpr size_t OFF_U = OFF_MEMB + 2048ull * 1024 * 2;
constexpr size_t OFF_CAT = OFF_U + (size_t)T_TOK * UC * 2;
constexpr size_t OFF_MQ = OFF_CAT + (size_t)T_TOK * 1024 * 2;
constexpr size_t OFF_MK = OFF_MQ + (size_t)T_TOK * 384 * 2;
constexpr size_t OFF_MVT = OFF_MK + (size_t)T_TOK * 384 * 2;
constexpr size_t OFF_HST = OFF_MVT + (size_t)T_TOK * 256 * 2;
constexpr size_t OFF_HDEC = OFF_HST + 64ull * 64 * 4096 * 4;
constexpr size_t OFF_XK = OFF_HDEC + 64ull * 64 * 64 * 4;
constexpr size_t OFF_XVT = OFF_XK + 4ull * 8 * 4 * 256 * 64 * 2;
constexpr size_t OFF_ROPE = OFF_XVT + 4ull * 8 * 4 * 256 * 64 * 2;
constexpr size_t OFF_ROWSQ = OFF_ROPE + (size_t)T_TOK * 16 * 2 * 4;
constexpr size_t OFF_MEMSQ = OFF_ROWSQ + (size_t)T_TOK * 16 * 4;
constexpr size_t OFF_SSQB = OFF_MEMSQ + 2048 * 4;
constexpr size_t OFF_SSQD = OFF_SSQB + (size_t)T_TOK * 4 * 4;
constexpr size_t WS_BAR = OFF_SSQD + (size_t)T_TOK * 4 * 4;
constexpr size_t WS_END = WS_BAR + 16384;
constexpr size_t QRAW_IN_OUT = 0;
constexpr size_t KVRAW_IN_OUT = (size_t)T_TOK * 384 * 2;
constexpr size_t OFF_KVMEM = OFF_MQ;
constexpr size_t OFF_XQ = OFF_U;
constexpr size_t OFF_XO = OFF_U + (size_t)T_TOK * 256 * 2;
constexpr size_t OFF_HFF = OFF_U;
constexpr size_t W_IN = 0, W_OUT = 3145728, W_UQ = 4194304, W_UKV = 4292608, W_XQ = 4358144, W_XO = 4620288, W_13 = 4882432, W_2 = 10649600;

enum { I_X = 0, I_MEM, I_POS, I_GMIX, I_WIN, I_ADWW, I_ADWB, I_ALNG, I_ALNB, I_HGAM, I_HONG, I_CDWW, I_CDWB, I_MQAG, I_MWUQ, I_MKVAG,
       I_MWUKV, I_MQNG, I_MKNG, I_GBR, I_WOUT, I_GXQ, I_GMEM, I_XWQ, I_XWKV, I_XQNG, I_XKNG, I_XWO, I_GFFN, I_W13, I_W2, N_IN };

struct Params {
    const float* in[N_IN];
    float* out;
    unsigned char* ws;
    int ph_lo, ph_hi;
    int layer, pad;
};

typedef __bf16 bf2_t __attribute__((ext_vector_type(2)));
typedef float f2_t __attribute__((ext_vector_type(2)));
DI unsigned cvt_pk(float lo, float hi) { f2_t v = {lo, hi}; bf2_t b = __builtin_convertvector(v, bf2_t); return __builtin_bit_cast(unsigned, b); }
DI bf16_t f2bf(float x) { return (bf16_t)(cvt_pk(x, 0.f) & 0xffffu); }
DI float bf2f(bf16_t h) { return __uint_as_float(((unsigned)h) << 16); }
DI float bflo(unsigned w) { return __uint_as_float(w << 16); }
DI float bfhi(unsigned w) { return __uint_as_float(w & 0xffff0000u); }
DI float sigmoidf_(float x) { return __builtin_amdgcn_rcpf(1.f + __expf(-x)); }
DI int tidx() { int t = threadIdx.x & 255; asm volatile("" : "+v"(t)); return t; }
DI float wave_sum(float v) {
#pragma unroll
    for (int o = 32; o > 0; o >>= 1) v += __shfl_xor(v, o);
    return v;
}

DI int sw_off(int row, int chunk) { return row * 128 + ((chunk ^ ((row >> 1) & 7)) << 4); }

DI void scale_chunk(uint4& v, float s) {
    v.x = cvt_pk(bflo(v.x) * s, bfhi(v.x) * s); v.y = cvt_pk(bflo(v.y) * s, bfhi(v.y) * s);
    v.z = cvt_pk(bflo(v.z) * s, bfhi(v.z) * s); v.w = cvt_pk(bflo(v.w) * s, bfhi(v.w) * s);
}

template <bool ASC>
DI void gemm_mainloop(const bf16_t* __restrict__ A, int lda, const bf16_t* __restrict__ Bt, int K, int row0, int col0,
                      unsigned char* smem, f32x4 (&acc)[4][4]) {
    const int tid = tidx(), lane = tid & 63, w = tid >> 6, wr = w >> 1, wc = w & 1, l15 = lane & 15, quad = lane >> 4;
    const int lr = tid >> 3, lc = tid & 7;
    const bf16_t* Ap = A + (size_t)(row0 + lr) * lda + lc * 8;
    const bf16_t* Bp = Bt + (size_t)(col0 + lr) * K + lc * 8;
    const size_t as1 = (size_t)32 * lda, bs1 = (size_t)32 * K;
    const float* asc = (const float*)(smem + 66048);
    uint4 ra0, ra1, ra2, ra3, rb0, rb1, rb2, rb3;
#define G_LOAD(ko) do { ra0 = *(const uint4*)(Ap + (ko)); ra1 = *(const uint4*)(Ap + as1 + (ko)); ra2 = *(const uint4*)(Ap + 2 * as1 + (ko)); ra3 = *(const uint4*)(Ap + 3 * as1 + (ko)); \
                        rb0 = *(const uint4*)(Bp + (ko)); rb1 = *(const uint4*)(Bp + bs1 + (ko)); rb2 = *(const uint4*)(Bp + 2 * bs1 + (ko)); rb3 = *(const uint4*)(Bp + 3 * bs1 + (ko)); } while (0)
#define G_STORE(buf) do { unsigned char* Ad_ = smem + (buf) * 16384; unsigned char* Bd_ = smem + 32768 + (buf) * 16384; const int o_ = sw_off(lr, lc); \
                          *(uint4*)(Ad_ + o_) = ra0; *(uint4*)(Ad_ + o_ + 4096) = ra1; *(uint4*)(Ad_ + o_ + 8192) = ra2; *(uint4*)(Ad_ + o_ + 12288) = ra3; \
                          *(uint4*)(Bd_ + o_) = rb0; *(uint4*)(Bd_ + o_ + 4096) = rb1; *(uint4*)(Bd_ + o_ + 8192) = rb2; *(uint4*)(Bd_ + o_ + 12288) = rb3; } while (0)
    const int plc = (tid & 7) ^ ((tid >> 4) & 7);
    const bf16_t* Adp = A + (size_t)(row0 + lr) * lda + plc * 8;
    const bf16_t* Bdp = Bt + (size_t)(col0 + lr) * K + plc * 8;
#define D_STAGE(buf, ko) do { _Pragma("unroll") for (int i_ = 0; i_ < 4; ++i_) { \
        __builtin_amdgcn_global_load_lds((const unsigned*)(Adp + i_ * as1 + (ko)), (unsigned*)(smem + (buf) * 16384 + i_ * 4096 + tid * 16), 16, 0, 0); \
        __builtin_amdgcn_global_load_lds((const unsigned*)(Bdp + i_ * bs1 + (ko)), (unsigned*)(smem + 32768 + (buf) * 16384 + i_ * 4096 + tid * 16), 16, 0, 0); } } while (0)
    if (ASC) { G_LOAD(0); } else { D_STAGE(0, 0); }
#pragma unroll
    for (int m = 0; m < 4; ++m)
#pragma unroll
        for (int n = 0; n < 4; ++n) acc[m][n] = (f32x4){0.f, 0.f, 0.f, 0.f};
    if (ASC) { G_STORE(0); }
    __syncthreads();
    const int nk = K >> 6;
    for (int kt = 0; kt < nk; ++kt) {
        const int cur = kt & 1;
        const bool more = (kt + 1 < nk);
        if (more) { const int ko = (kt + 1) * 64; if (ASC) { G_LOAD(ko); } else { D_STAGE(cur ^ 1, ko); } }
        __builtin_amdgcn_sched_barrier(0);
        const unsigned char* As = smem + cur * 16384;
        const unsigned char* Bs = smem + 32768 + cur * 16384;
#pragma unroll
        for (int ks = 0; ks < 2; ++ks) {
            bf16x8 af[4], bfv[4];
#pragma unroll
            for (int m = 0; m < 4; ++m) af[m] = *(const bf16x8*)(As + sw_off(wr * 64 + m * 16 + l15, ks * 4 + quad));
#pragma unroll
            for (int n = 0; n < 4; ++n) bfv[n] = *(const bf16x8*)(Bs + sw_off(wc * 64 + n * 16 + l15, ks * 4 + quad));
#pragma unroll
            for (int m = 0; m < 4; ++m)
#pragma unroll
                for (int n = 0; n < 4; ++n) acc[m][n] = MFMA16(bfv[n], af[m], acc[m][n]);
        }
        __builtin_amdgcn_sched_barrier(0);
        if (ASC && more) {
            const int grp = ((kt + 1) * 64) >> 8;
            if (grp & 1) {
                const int which = grp >> 1;
                scale_chunk(ra0, asc[lr * 2 + which]); scale_chunk(ra1, asc[(lr + 32) * 2 + which]);
                scale_chunk(ra2, asc[(lr + 64) * 2 + which]); scale_chunk(ra3, asc[(lr + 96) * 2 + which]);
            }
            G_STORE(cur ^ 1);
        }
        __syncthreads();
    }
#undef G_LOAD
#undef G_STORE
#undef D_STAGE
}

DI void tile_order(int L, int nM, int nN, int& pm, int& pn) {
    const int nwg = nM * nN;
    int wgid = L;
    { const int q = nwg / 8, r = nwg % 8, xcd = wgid % 8, off = wgid / 8; wgid = (xcd < r ? xcd * (q + 1) : r * (q + 1) + (xcd - r) * q) + off; }
    const int WGM = 8;
    const int nig = WGM * nN, gid = wgid / nig, fm = gid * WGM, gsz = (nM - fm) < WGM ? (nM - fm) : WGM;
    pm = fm + ((wgid % nig) % gsz); pn = (wgid % nig) / gsz;
}

DI void fill_rs(unsigned char* smem, const float* part, int npart, int row0, float inv_n) {
    float* rs = (float*)(smem + 65536);
    const int tid = tidx();
    if (tid < 128) {
        float s = 0.f;
        for (int i = 0; i < npart; ++i) s += part[(size_t)(row0 + tid) * npart + i];
        rs[tid] = __builtin_amdgcn_rsqf(s * inv_n + EPS);
    }
}

DI void epi_bf16(const f32x4 (&acc)[4][4], bf16_t* O, int ldo, int row0, int col0, const float* rs) {
    const int lane = tidx() & 63, w = tidx() >> 6, wr = w >> 1, wc = w & 1, l15 = lane & 15, quad = lane >> 4;
#pragma unroll
    for (int m = 0; m < 4; ++m) {
        const int rl = wr * 64 + m * 16 + l15;
        const float sc = rs ? rs[rl] : 1.f;
        bf16_t* rowp = O + (size_t)(row0 + rl) * ldo + col0 + wc * 64 + quad * 4;
#pragma unroll
        for (int n = 0; n < 4; ++n) {
            u32x2 v; v.x = cvt_pk(acc[m][n][0] * sc, acc[m][n][1] * sc); v.y = cvt_pk(acc[m][n][2] * sc, acc[m][n][3] * sc);
            *(u32x2*)(rowp + n * 16) = v;
        }
    }
}
DI void epi_resid(const f32x4 (&acc)[4][4], float* X, bf16_t* XB, float* rowsq, int row0, int col0) {
    const int lane = tidx() & 63, w = tidx() >> 6, wr = w >> 1, wc = w & 1, l15 = lane & 15, quad = lane >> 4;
    const int pn = col0 >> 7;
#pragma unroll
    for (int m = 0; m < 4; ++m) {
        const int row = row0 + wr * 64 + m * 16 + l15;
        float ss = 0.f;
#pragma unroll
        for (int n = 0; n < 4; ++n) {
            const int col = col0 + wc * 64 + n * 16 + quad * 4;
            float4* xp = (float4*)(X + (size_t)row * DM + col);
            float4 xv = *xp;
            xv.x += acc[m][n][0]; xv.y += acc[m][n][1]; xv.z += acc[m][n][2]; xv.w += acc[m][n][3];
            *xp = xv;
            u32x2 v; v.x = cvt_pk(xv.x, xv.y); v.y = cvt_pk(xv.z, xv.w);
            *(u32x2*)(XB + (size_t)row * DM + col) = v;
            ss += xv.x * xv.x + xv.y * xv.y + xv.z * xv.z + xv.w * xv.w;
        }
        ss += __shfl_xor(ss, 16); ss += __shfl_xor(ss, 32);
        if (quad == 0) rowsq[(size_t)row * 16 + pn * 2 + wc] = ss;
    }
}
DI void epi_swiglu(const f32x4 (&acc)[4][4], bf16_t* H, int row0, int col0, const float* rs) {
    const int lane = tidx() & 63, w = tidx() >> 6, wr = w >> 1, wc = w & 1, l15 = lane & 15, quad = lane >> 4;
#pragma unroll
    for (int m = 0; m < 4; ++m) {
        const int rl = wr * 64 + m * 16 + l15;
        const float sc = rs[rl];
        bf16_t* rowp = H + (size_t)(row0 + rl) * DFF + ((col0 + wc * 64) >> 1) + quad * 4;
#pragma unroll
        for (int np = 0; np < 2; ++np) {
            float h[4];
#pragma unroll
            for (int j = 0; j < 4; ++j) { const float a1 = acc[m][2 * np][j] * sc, a3 = acc[m][2 * np + 1][j] * sc; h[j] = a1 * sigmoidf_(a1) * a3; }
            u32x2 v; v.x = cvt_pk(h[0], h[1]); v.y = cvt_pk(h[2], h[3]);
            *(u32x2*)(rowp + np * 16) = v;
        }
    }
}

DI void conv_tile(const float* __restrict__ src, int K, int N, int Npad, const float* __restrict__ gain, int perm, bf16_t* __restrict__ dst, int tile, unsigned char* smem) {
    float* lds = (float*)smem;
    const int nkt = K >> 6, kt = tile % nkt, nt = tile / nkt, k0 = kt * 64, n0 = nt * 64;
    const int tid = tidx(), nl = tid & 63, kq = tid >> 6;
    const int R = n0 + nl;
    int sc = R;
    if (perm == 1) { const int g = R >> 5, j = R & 31; sc = (j < 16) ? (16 * g + j) : (DFF + 16 * g + j - 16); }
    const bool ok = R < N;
#pragma unroll
    for (int i = 0; i < 16; ++i) { const int kl = kq + 4 * i; lds[kl * 65 + nl] = ok ? src[(size_t)(k0 + kl) * N + sc] : 0.f; }
    __syncthreads();
    const int kc = tid & 7, nr = tid >> 3;
    int kd0 = k0;
    if (perm == 2) { const int g = k0 >> 8; const int gm = (g == 0) ? 2 : (g == 1) ? 0 : (g == 2) ? 3 : 1; kd0 = gm * 256 + (k0 & 255); }
    float g8[8];
#pragma unroll
    for (int j = 0; j < 8; ++j) g8[j] = gain ? gain[k0 + kc * 8 + j] : 1.f;
#pragma unroll
    for (int i = 0; i < 2; ++i) {
        const int nl2 = nr + 32 * i;
        float v[8];
#pragma unroll
        for (int j = 0; j < 8; ++j) v[j] = lds[(kc * 8 + j) * 65 + nl2] * g8[j];
        uint4 o; o.x = cvt_pk(v[0], v[1]); o.y = cvt_pk(v[2], v[3]); o.z = cvt_pk(v[4], v[5]); o.w = cvt_pk(v[6], v[7]);
        *(uint4*)(dst + (size_t)(n0 + nl2) * K + kd0 + kc * 8) = o;
    }
    __syncthreads();
}

constexpr int CONV_TILES = 768 + 256 + 24 + 16 + 64 + 64 + 1408 + 704;
DI void conv_layer_item(const Params& p, int l, int it, unsigned char* smem) {
    bf16_t* W = (bf16_t*)(p.ws + OFF_W);
    if (it < 768) { conv_tile(p.in[I_WIN] + (size_t)l * DM * INC, DM, INC, UC, p.in[I_GMIX] + l * DM, 0, W + W_IN, it, smem); return; } it -= 768;
    if (it < 256) { conv_tile(p.in[I_WOUT] + (size_t)l * DM * DM, DM, DM, DM, p.in[I_GBR] + l * DM, 2, W + W_OUT, it, smem); return; } it -= 256;
    if (it < 24) { conv_tile(p.in[I_MWUQ] + (size_t)l * 256 * 384, 256, 384, 384, p.in[I_MQAG] + l * 256, 0, W + W_UQ, it, smem); return; } it -= 24;
    if (it < 16) { conv_tile(p.in[I_MWUKV] + (size_t)l * 128 * 512, 128, 512, 512, p.in[I_MKVAG] + l * 128, 0, W + W_UKV, it, smem); return; } it -= 16;
    if (it < 64) { conv_tile(p.in[I_XWQ] + (size_t)l * DM * 256, DM, 256, 256, p.in[I_GXQ] + l * DM, 0, W + W_XQ, it, smem); return; } it -= 64;
    if (it < 64) { conv_tile(p.in[I_XWO] + (size_t)l * 256 * DM, 256, DM, DM, nullptr, 0, W + W_XO, it, smem); return; } it -= 64;
    if (it < 1408) { conv_tile(p.in[I_W13] + (size_t)l * DM * 2 * DFF, DM, 2 * DFF, 2 * DFF, p.in[I_GFFN] + l * DM, 1, W + W_13, it, smem); return; } it -= 1408;
    conv_tile(p.in[I_W2] + (size_t)l * DFF * DM, DFF, DM, DM, nullptr, 0, W + W_2, it, smem);
}

DI void pro_rows(const float* __restrict__ src, float* __restrict__ cpy, bf16_t* __restrict__ dstb, float* __restrict__ sq, int sqstride, int item) {
    const int w = tidx() >> 6, lane = tidx() & 63;
    for (int r = 0; r < 4; ++r) {
        const int row = item * 16 + w * 4 + r;
        const float4* s4 = (const float4*)(src + (size_t)row * DM);
        float s = 0.f;
#pragma unroll
        for (int i = 0; i < 4; ++i) {
            const float4 v = s4[lane + 64 * i];
            if (cpy) ((float4*)(cpy + (size_t)row * DM))[lane + 64 * i] = v;
            u32x2 o; o.x = cvt_pk(v.x, v.y); o.y = cvt_pk(v.z, v.w);
            *(u32x2*)(dstb + (size_t)row * DM + (lane + 64 * i) * 4) = o;
            s += v.x * v.x + v.y * v.y + v.z * v.z + v.w * v.w;
        }
        s = wave_sum(s);
        if (lane < sqstride) sq[(size_t)row * sqstride + lane] = (lane == 0) ? s : 0.f;
    }
}
DI void pro_rope(const Params& p, int item) {
    const int tok = item * 256 + tidx();
    const int* pos = (const int*)p.in[I_POS];
    float* cs = (float*)(p.ws + OFF_ROPE);
    float* sn = cs + (size_t)T_TOK * 16;
    const float pf = (float)pos[tok];
#pragma unroll
    for (int i = 0; i < 16; ++i) {
        const float inv = powf(10000.0f, -(float)(2 * i) / 32.0f);
        const float ang = pf * inv;
        cs[(size_t)tok * 16 + i] = cosf(ang);
        sn[(size_t)tok * 16 + i] = sinf(ang);
    }
}

DI void conformer_tile(const Params& p, int l, int tile, unsigned char* smem) {
    float* hs = (float*)smem;
    const bf16_t* U = (const bf16_t*)(p.ws + OFF_U);
    bf16_t* CAT = (bf16_t*)(p.ws + OFF_CAT);
    const int tid = tidx(), b = tile >> 7, t0 = (tile & 127) * 32;
    {
        const int c2 = (tid & 127) * 2, half = tid >> 7;
        for (int r0 = half; r0 < 62; r0 += 32) {
            unsigned av[16], gv[16];
#pragma unroll
            for (int k = 0; k < 16; ++k) {
                const int r = r0 + 2 * k, t = t0 - 15 + r;
                av[k] = 0u; gv[k] = 0u;
                if (r < 62 && t >= 0 && t < SEQ) {
                    const bf16_t* up = U + (size_t)(b * SEQ + t) * UC;
                    av[k] = *(const unsigned*)(up + c2); gv[k] = *(const unsigned*)(up + 256 + c2);
                }
            }
#pragma unroll
            for (int k = 0; k < 16; ++k) {
                const int r = r0 + 2 * k;
                if (r < 62) {
                    hs[r * 256 + c2] = bflo(av[k]) * sigmoidf_(bflo(gv[k]));
                    hs[r * 256 + c2 + 1] = bfhi(av[k]) * sigmoidf_(bfhi(gv[k]));
                }
            }
        }
    }
    __syncthreads();
    {
        const int c = tid;
        float wv[31];
        const float* wp = p.in[I_ADWW] + (size_t)l * 31 * 256 + c;
#pragma unroll
        for (int j = 0; j < 31; ++j) wv[j] = wp[j * 256];
        const float bias = p.in[I_ADWB][l * 256 + c];
        for (int t = 0; t < 32; ++t) {
            float y = bias;
#pragma unroll
            for (int j = 0; j < 31; ++j) y += wv[j] * hs[(t + j) * 256 + c];
            hs[t * 256 + c] = y;
        }
    }
    __syncthreads();
    {
        const int w = tid >> 6, lane = tid & 63;
        const float4 g4 = *(const float4*)(p.in[I_ALNG] + l * 256 + lane * 4), b4 = *(const float4*)(p.in[I_ALNB] + l * 256 + lane * 4);
        for (int r = 0; r < 8; ++r) {
            const int t = w * 8 + r;
            float4 v = *(const float4*)(hs + t * 256 + lane * 4);
            const float mu = wave_sum(v.x + v.y + v.z + v.w) * (1.f / 256.f);
            v.x -= mu; v.y -= mu; v.z -= mu; v.w -= mu;
            const float var = wave_sum(v.x * v.x + v.y * v.y + v.z * v.z + v.w * v.w) * (1.f / 256.f);
            const float rstd = __builtin_amdgcn_rsqf(var + EPS);
            float y0 = v.x * rstd * g4.x + b4.x, y1 = v.y * rstd * g4.y + b4.y, y2 = v.z * rstd * g4.z + b4.z, y3 = v.w * rstd * g4.w + b4.w;
            y0 *= sigmoidf_(y0); y1 *= sigmoidf_(y1); y2 *= sigmoidf_(y2); y3 *= sigmoidf_(y3);
            const float ss = wave_sum(y0 * y0 + y1 * y1 + y2 * y2 + y3 * y3);
            const float rb = __builtin_amdgcn_rsqf(ss * (1.f / 256.f) + EPS);
            u32x2 o; o.x = cvt_pk(y0 * rb, y1 * rb); o.y = cvt_pk(y2 * rb, y3 * rb);
            *(u32x2*)(CAT + (size_t)(b * SEQ + t0 + t) * DM + 512 + lane * 4) = o;
        }
    }
    __syncthreads();
}

DI void shortconv_tile(const Params& p, int l, int tile) {
    const bf16_t* U = (const bf16_t*)(p.ws + OFF_U);
    bf16_t* CAT = (bf16_t*)(p.ws + OFF_CAT);
    const int w = tidx() >> 6, lane = tidx() & 63, c = lane * 4;
    const float* wp = p.in[I_CDWW] + (size_t)l * 3 * 256 + c;
    const float4 w0 = *(const float4*)(wp), w1 = *(const float4*)(wp + 256), w2 = *(const float4*)(wp + 512);
    const float4 bb = *(const float4*)(p.in[I_CDWB] + l * 256 + c);
#pragma unroll 4
    for (int r = 0; r < 16; ++r) {
        const int tok = tile * 64 + w * 16 + r, s = tok & (SEQ - 1);
        float pr[3][4];
#pragma unroll
        for (int j = 0; j < 3; ++j) {
            const int sj = s + j - 1;
            if (sj >= 0 && sj < SEQ) {
                const bf16_t* up = U + (size_t)(tok + j - 1) * UC;
                const u32x2 gc = *(const u32x2*)(up + 2048 + c), xi = *(const u32x2*)(up + 2304 + c);
                pr[j][0] = bflo(gc.x) * bflo(xi.x); pr[j][1] = bfhi(gc.x) * bfhi(xi.x); pr[j][2] = bflo(gc.y) * bflo(xi.y); pr[j][3] = bfhi(gc.y) * bfhi(xi.y);
            } else { pr[j][0] = pr[j][1] = pr[j][2] = pr[j][3] = 0.f; }
        }
        const u32x2 gb = *(const u32x2*)(U + (size_t)tok * UC + 1792 + c);
        const float y0 = bflo(gb.x) * (bb.x + w0.x * pr[0][0] + w1.x * pr[1][0] + w2.x * pr[2][0]);
        const float y1 = bfhi(gb.x) * (bb.y + w0.y * pr[0][1] + w1.y * pr[1][1] + w2.y * pr[2][1]);
        const float y2 = bflo(gb.y) * (bb.z + w0.z * pr[0][2] + w1.z * pr[1][2] + w2.z * pr[2][2]);
        const float y3 = bfhi(gb.y) * (bb.w + w0.w * pr[0][3] + w1.w * pr[1][3] + w2.w * pr[2][3]);
        const float ss = wave_sum(y0 * y0 + y1 * y1 + y2 * y2 + y3 * y3);
        const float rb = __builtin_amdgcn_rsqf(ss * (1.f / 256.f) + EPS);
        u32x2 o; o.x = cvt_pk(y0 * rb, y1 * rb); o.y = cvt_pk(y2 * rb, y3 * rb);
        *(u32x2*)(CAT + (size_t)tok * DM + 768 + c) = o;
    }
}

DI float hgrn_lower(const Params& p, int l, int dir, int ch) {
    const float* g = p.in[I_HGAM] + (size_t)dir * NL * 256 + ch;
    const float g0 = g[0], g1 = g[256], g2 = g[512], g3 = g[768];
    const float mx = fmaxf(fmaxf(g0, g1), fmaxf(g2, g3));
    const float e0 = __expf(g0 - mx), e1 = __expf(g1 - mx), e2 = __expf(g2 - mx), e3 = __expf(g3 - mx);
    const float inv = 1.f / (e0 + e1 + e2 + e3);
    float lb = 0.f;
    if (l >= 1) lb += e1; if (l >= 2) lb += e2; if (l >= 3) lb += e3;
    return lb * inv;
}

DI void hgrn_local_tile(const Params& p, int l, int item, unsigned char* smem) {
    const bf16_t* U = (const bf16_t*)(p.ws + OFF_U);
    float* HST = (float*)(p.ws + OFF_HST);
    float* HDEC = (float*)(p.ws + OFF_HDEC);
    const int dir = item >> 9, b = (item >> 6) & 7, c = item & 63;
    const int h = tidx() >> 6, lane = tidx() & 63, l15 = lane & 15, quad = lane >> 4;
    bf16_t* kT = (bf16_t*)(smem + h * 18432);
    bf16_t* vT = kT + 64 * 72;
    const float lb = hgrn_lower(p, l, dir, h * 64 + lane);
    const int tokbase = b * SEQ + c * 64;
    const bf16_t* zp = U + (size_t)tokbase * UC + 768 + dir * 256 + h * 64 + lane;
    const bf16_t* vp = U + (size_t)tokbase * UC + 1280 + h * 64 + lane;
    float suf = 0.f;
    {
        const int step = dir ? UC : -UC, di = dir ? 1 : -1;
        int i = dir ? 0 : 63;
        zp += (size_t)i * UC; vp += (size_t)i * UC;
        bf16_t* kw = kT + lane * 72 + i; bf16_t* vw = vT + lane * 72 + i;
        for (int hb = 0; hb < 2; ++hb) {
            bf16_t zz[32], vv[32];
#pragma unroll
            for (int ii = 0; ii < 32; ++ii) { zz[ii] = zp[(ptrdiff_t)ii * step]; vv[ii] = vp[(ptrdiff_t)ii * step]; }
            zp += (ptrdiff_t)32 * step; vp += (ptrdiff_t)32 * step;
#pragma unroll
            for (int ii = 0; ii < 32; ++ii) {
                const float z = bf2f(zz[ii]);
                const float sg = sigmoidf_(z), f = sg + lb * (1.f - sg), kk = (1.f - lb) * (1.f - sg);
                kw[ii * di] = f2bf(kk * __expf(suf));
                vw[ii * di] = vv[ii];
                suf += __logf(f);
            }
            kw += 32 * di; vw += 32 * di;
        }
    }
    const int seq = (dir * 8 + b) * 4 + h, cs = dir ? 63 - c : c;
    HDEC[((size_t)seq * 64 + cs) * 64 + lane] = __expf(suf);
    __syncthreads();
    f32x4 acc[4][4];
#pragma unroll
    for (int et = 0; et < 4; ++et)
#pragma unroll
        for (int dt = 0; dt < 4; ++dt) acc[et][dt] = (f32x4){0.f, 0.f, 0.f, 0.f};
#pragma unroll
    for (int ks = 0; ks < 2; ++ks) {
        bf16x8 av[4], bk[4];
#pragma unroll
        for (int t = 0; t < 4; ++t) {
            av[t] = *(const bf16x8*)(vT + (t * 16 + l15) * 72 + ks * 32 + quad * 8);
            bk[t] = *(const bf16x8*)(kT + (t * 16 + l15) * 72 + ks * 32 + quad * 8);
        }
#pragma unroll
        for (int et = 0; et < 4; ++et)
#pragma unroll
            for (int dt = 0; dt < 4; ++dt) acc[et][dt] = MFMA16(av[et], bk[dt], acc[et][dt]);
    }
    float* sp = HST + ((size_t)seq * 64 + cs) * 4096;
#pragma unroll
    for (int et = 0; et < 4; ++et)
#pragma unroll
        for (int dt = 0; dt < 4; ++dt)
#pragma unroll
            for (int r = 0; r < 4; ++r) sp[(et * 16 + quad * 4 + r) * 64 + dt * 16 + l15] = acc[et][dt][r];
    __syncthreads();
}

DI void hgrn_scan_item(const Params& p, int item) {
    float* HST = (float*)(p.ws + OFF_HST);
    const float* HDEC = (const float*)(p.ws + OFF_HDEC);
    const int gid = item * 256 + tidx(), seq = gid >> 12, ed = gid & 4095, d = ed & 63;
    float* sp = HST + (size_t)seq * 64 * 4096 + ed;
    const float* dp = HDEC + (size_t)seq * 64 * 64 + d;
    float s = 0.f;
    for (int c0 = 0; c0 < 64; c0 += 8) {
        float loc[8], dec[8];
#pragma unroll
        for (int j = 0; j < 8; ++j) { loc[j] = sp[(size_t)(c0 + j) * 4096]; dec[j] = dp[(c0 + j) * 64]; }
#pragma unroll
        for (int j = 0; j < 8; ++j) { sp[(size_t)(c0 + j) * 4096] = s; s = dec[j] * s + loc[j]; }
    }
}

DI void hgrn_scan_dummy(const Params& p, int item) {
    float* HST = (float*)(p.ws + OFF_HST);
    const float* HDEC = (const float*)(p.ws + OFF_HDEC);
    const int gid = item * 256 + tidx(), seq = gid >> 12, ed = gid & 4095, d = ed & 63;
    float* sp = HST + (size_t)seq * 64 * 4096 + ed;
    const float* dp = HDEC + (size_t)seq * 64 * 64 + d;
    float s = 0.f;
    for (int c0 = 0; c0 < 64; c0 += 8) {
        float loc[8], dec[8];
#pragma unroll
        for (int j = 0; j < 8; ++j) { loc[j] = sp[(size_t)(c0 + j) * 4096]; dec[j] = dp[(c0 + j) * 64]; }
#pragma unroll
        for (int j = 0; j < 8; ++j) { s = dec[j] * s + loc[j]; sp[(size_t)(c0 + j) * 4096] = (s == 12345.678f) ? s : loc[j]; }
    }
}
DI bf16x8 hg_frag(const bf16_t* qk, const float* bc, const float* ref, bool qside) {
    const uint4 x = *(const uint4*)qk;
    const float4 b0 = *(const float4*)bc, b1 = *(const float4*)(bc + 4);
    float4 r0 = {0.f, 0.f, 0.f, 0.f}, r1 = {0.f, 0.f, 0.f, 0.f};
    if (ref) { r0 = *(const float4*)ref; r1 = *(const float4*)(ref + 4); }
    float e[8] = {b0.x - r0.x, b0.y - r0.y, b0.z - r0.z, b0.w - r0.w, b1.x - r1.x, b1.y - r1.y, b1.z - r1.z, b1.w - r1.w};
    if (!qside) {
#pragma unroll
        for (int j = 0; j < 8; ++j) e[j] = -e[j];
    }
    u32x4 o;
    o.x = cvt_pk(bflo(x.x) * __expf(e[0]), bfhi(x.x) * __expf(e[1]));
    o.y = cvt_pk(bflo(x.y) * __expf(e[2]), bfhi(x.y) * __expf(e[3]));
    o.z = cvt_pk(bflo(x.z) * __expf(e[4]), bfhi(x.z) * __expf(e[5]));
    o.w = cvt_pk(bflo(x.w) * __expf(e[6]), bfhi(x.w) * __expf(e[7]));
    return __builtin_bit_cast(bf16x8, o);
}

DI void hgrn_out_tile(const Params& p, int l, int item, unsigned char* smem) {
    const bf16_t* U = (const bf16_t*)(p.ws + OFF_U);
    const float* HST = (const float*)(p.ws + OFF_HST);
    bf16_t* CAT = (bf16_t*)(p.ws + OFF_CAT);
    float* SSQB = (float*)(p.ws + OFF_SSQB);
    const int h = item & 3, c = (item >> 2) & 63, b = item >> 8;
    const int w = tidx() >> 6, lane = tidx() & 63, l15 = lane & 15, quad = lane >> 4;
    float* bc = (float*)smem;
    bf16_t* kk = (bf16_t*)(smem + 34816);
    bf16_t* qq = (bf16_t*)(smem + 34816 + 18432);
    bf16_t* vT = (bf16_t*)(smem + 34816 + 18432 + 9216);
    const int tokbase = b * SEQ + c * 64;
    u32x4 sfr[2][4];
    {
        const int dirp = w & 1;
        const int seqp = (dirp * 8 + b) * 4 + h, csp = dirp ? 63 - c : c;
        const float* sinp = HST + ((size_t)seqp * 64 + csp) * 4096;
#pragma unroll
        for (int ks = 0; ks < 2; ++ks)
#pragma unroll
            for (int et = 0; et < 4; ++et) {
                const float* sp = sinp + (et * 16 + l15) * 64 + ks * 32 + quad * 8;
                const float4 s0 = *(const float4*)sp, s1 = *(const float4*)(sp + 4);
                sfr[ks][et].x = cvt_pk(s0.x, s0.y); sfr[ks][et].y = cvt_pk(s0.z, s0.w); sfr[ks][et].z = cvt_pk(s1.x, s1.y); sfr[ks][et].w = cvt_pk(s1.z, s1.w);
            }
    }
    if (w < 2) {
        const int dir = w;
        const float lb = hgrn_lower(p, l, dir, h * 64 + lane);
        const bf16_t* zp = U + (size_t)tokbase * UC + 768 + dir * 256 + h * 64 + lane;
        float run = 0.f;
        const int step = dir ? -UC : UC, di = dir ? -1 : 1;
        int i = dir ? 63 : 0;
        zp += (size_t)i * UC;
        float* bw = bc + (dir * 64 + i) * 68 + lane; bf16_t* kw = kk + (dir * 64 + i) * 72 + lane;
        {
            bf16_t zz[64];
#pragma unroll
            for (int ii = 0; ii < 64; ++ii) zz[ii] = zp[(ptrdiff_t)ii * step];
#pragma unroll
            for (int ii = 0; ii < 64; ++ii) {
                const float z = bf2f(zz[ii]);
                const float sg = sigmoidf_(z), f = sg + lb * (1.f - sg);
                run += __logf(f);
                bw[ii * di * 68] = run; kw[ii * di * 72] = f2bf((1.f - lb) * (1.f - sg));
            }
        }
    } else if (w == 2) {
        const bf16_t* qp = U + (size_t)tokbase * UC + 512 + h * 64 + lane;
        {
            bf16_t t[64];
#pragma unroll
            for (int i = 0; i < 64; ++i) t[i] = qp[(size_t)i * UC];
#pragma unroll
            for (int i = 0; i < 64; ++i) qq[i * 72 + lane] = t[i];
        }
    } else {
        const bf16_t* vp = U + (size_t)tokbase * UC + 1280 + h * 64 + lane;
        {
            bf16_t t[64];
#pragma unroll
            for (int i = 0; i < 64; ++i) t[i] = vp[(size_t)i * UC];
#pragma unroll
            for (int i = 0; i < 64; ++i) vT[lane * 72 + i] = t[i];
        }
    }
    __syncthreads();
    const int dir = w & 1, iset = w >> 1;
    const int seq = (dir * 8 + b) * 4 + h, cs = dir ? 63 - c : c;
    const float* bcd = bc + dir * 64 * 68;
    const bf16_t* kkd = kk + dir * 64 * 72;
    f32x4 o[4][2];
#pragma unroll
    for (int et = 0; et < 4; ++et) { o[et][0] = (f32x4){0.f, 0.f, 0.f, 0.f}; o[et][1] = (f32x4){0.f, 0.f, 0.f, 0.f}; }
#pragma unroll
    for (int ii = 0; ii < 2; ++ii) {
        const int I = iset == 0 ? (ii == 0 ? 0 : 3) : (ii == 0 ? 1 : 2);
        const int irow = 16 * I + l15;
#pragma unroll
        for (int ks = 0; ks < 2; ++ks) {
            const int d0 = ks * 32 + quad * 8;
            const bf16x8 bq = hg_frag(qq + irow * 72 + d0, bcd + irow * 68 + d0, nullptr, true);
#pragma unroll
            for (int et = 0; et < 4; ++et) o[et][ii] = MFMA16(__builtin_bit_cast(bf16x8, sfr[ks][et]), bq, o[et][ii]);
        }
#pragma unroll
        for (int kk2 = 0; kk2 < 2; ++kk2) {
            f32x4 at[2];
            bool any = false;
#pragma unroll
            for (int jj = 0; jj < 2; ++jj) {
                const int J = 2 * kk2 + jj;
                at[jj] = (f32x4){0.f, 0.f, 0.f, 0.f};
                const bool active = dir == 0 ? (J <= I) : (J >= I);
                if (active) {
                    any = true;
                    const float* ref = nullptr;
                    if (dir == 0) { if (J > 0) ref = bcd + (16 * J - 1) * 68; } else { if (J < 3) ref = bcd + (16 * J + 16) * 68; }
                    const int srow = 16 * J + l15;
#pragma unroll
                    for (int ks = 0; ks < 2; ++ks) {
                        const int d0 = ks * 32 + quad * 8;
                        const bf16x8 ak = hg_frag(kkd + srow * 72 + d0, bcd + srow * 68 + d0, ref ? ref + d0 : nullptr, false);
                        const bf16x8 bq = hg_frag(qq + irow * 72 + d0, bcd + irow * 68 + d0, ref ? ref + d0 : nullptr, true);
                        at[jj] = MFMA16(ak, bq, at[jj]);
                    }
                    if (J == I) {
#pragma unroll
                        for (int r = 0; r < 4; ++r) {
                            const int sl = quad * 4 + r;
                            const bool keep = dir == 0 ? (sl <= l15) : (sl >= l15);
                            if (!keep) at[jj][r] = 0.f;
                        }
                    }
                }
            }
            if (any) {
                u32x4 pbw; pbw.x = cvt_pk(at[0][0], at[0][1]); pbw.y = cvt_pk(at[0][2], at[0][3]); pbw.z = cvt_pk(at[1][0], at[1][1]); pbw.w = cvt_pk(at[1][2], at[1][3]);
                const bf16x8 pb = __builtin_bit_cast(bf16x8, pbw);
#pragma unroll
                for (int et = 0; et < 4; ++et) {
                    const bf16_t* vp = vT + (et * 16 + l15) * 72 + kk2 * 32 + quad * 4;
                    const u32x2 lo = *(const u32x2*)vp, hi = *(const u32x2*)(vp + 16);
                    u32x4 a; a.x = lo.x; a.y = lo.y; a.z = hi.x; a.w = hi.y;
                    o[et][ii] = MFMA16(__builtin_bit_cast(bf16x8, a), pb, o[et][ii]);
                }
            }
        }
    }
    __syncthreads();
    float* ob = (float*)smem;
    if (dir == 1) {
#pragma unroll
        for (int ii = 0; ii < 2; ++ii) {
            const int I = iset == 0 ? (ii == 0 ? 0 : 3) : (ii == 0 ? 1 : 2);
#pragma unroll
            for (int et = 0; et < 4; ++et) *(f32x4*)(ob + (16 * I + l15) * 68 + et * 16 + quad * 4) = o[et][ii];
        }
    }
    __syncthreads();
    if (dir == 0) {
#pragma unroll
        for (int ii = 0; ii < 2; ++ii) {
            const int I = iset == 0 ? (ii == 0 ? 0 : 3) : (ii == 0 ? 1 : 2);
            const int tok = tokbase + 16 * I + l15;
            float ss = 0.f;
#pragma unroll
            for (int et = 0; et < 4; ++et) {
                o[et][ii] += *(const f32x4*)(ob + (16 * I + l15) * 68 + et * 16 + quad * 4);
                ss += o[et][ii][0] * o[et][ii][0] + o[et][ii][1] * o[et][ii][1] + o[et][ii][2] * o[et][ii][2] + o[et][ii][3] * o[et][ii][3];
            }
            ss += __shfl_xor(ss, 16); ss += __shfl_xor(ss, 32);
            const float rh = __builtin_amdgcn_rsqf(ss * (1.f / 64.f) + EPS);
            float ssy = 0.f;
#pragma unroll
            for (int et = 0; et < 4; ++et) {
                const int e = et * 16 + quad * 4;
                const u32x2 gg = *(const u32x2*)(U + (size_t)tok * UC + 1536 + h * 64 + e);
                const float4 og = *(const float4*)(p.in[I_HONG] + l * 256 + h * 64 + e);
                const float g0 = bflo(gg.x), g1 = bfhi(gg.x), g2 = bflo(gg.y), g3 = bfhi(gg.y);
                const float y0 = o[et][ii][0] * rh * og.x * g0 * sigmoidf_(g0), y1 = o[et][ii][1] * rh * og.y * g1 * sigmoidf_(g1);
                const float y2 = o[et][ii][2] * rh * og.z * g2 * sigmoidf_(g2), y3 = o[et][ii][3] * rh * og.w * g3 * sigmoidf_(g3);
                ssy += y0 * y0 + y1 * y1 + y2 * y2 + y3 * y3;
                u32x2 ov; ov.x = cvt_pk(y0, y1); ov.y = cvt_pk(y2, y3);
                *(u32x2*)(CAT + (size_t)tok * DM + h * 64 + e) = ov;
            }
            ssy += __shfl_xor(ssy, 16); ssy += __shfl_xor(ssy, 32);
            if (quad == 0) SSQB[(size_t)tok * 4 + h] = ssy;
        }
    }
    __syncthreads();
}

DI void mla_finish_tile(const Params& p, int l, int item, unsigned char* smem) {
    const bf16_t* U = (const bf16_t*)(p.ws + OFF_U);
    const bf16_t* QR = (const bf16_t*)((const unsigned char*)p.out + QRAW_IN_OUT);
    const bf16_t* KVR = (const bf16_t*)((const unsigned char*)p.out + KVRAW_IN_OUT);
    bf16_t* MQ = (bf16_t*)(p.ws + OFF_MQ);
    bf16_t* MK = (bf16_t*)(p.ws + OFF_MK);
    bf16_t* MVT = (bf16_t*)(p.ws + OFF_MVT);
    const float* CS = (const float*)(p.ws + OFF_ROPE);
    const float* SN = CS + (size_t)T_TOK * 16;
    bf16_t* vbuf = (bf16_t*)smem;
    const int w = tidx() >> 6, lane = tidx() & 63, h = lane >> 4, j = lane & 15;
    const float4 qg = *(const float4*)(p.in[I_MQNG] + l * 96 + 4 * j), kg = *(const float4*)(p.in[I_MKNG] + l * 96 + 4 * j);
    const float qg1 = p.in[I_MQNG][l * 96 + 64 + j], qg2 = p.in[I_MQNG][l * 96 + 80 + j];
    const float kg1 = p.in[I_MKNG][l * 96 + 64 + j], kg2 = p.in[I_MKNG][l * 96 + 80 + j];
#pragma unroll 4
    for (int r = 0; r < 16; ++r) {
        const int tl = w * 16 + r, tok = item * 64 + tl;
        const bf16_t* up = U + (size_t)tok * UC;
        float sq, skv;
        { const u32x2 a = *(const u32x2*)(up + 2560 + lane * 4);
          const float a0 = bflo(a.x), a1 = bfhi(a.x), a2 = bflo(a.y), a3 = bfhi(a.y);
          sq = __builtin_amdgcn_rsqf(wave_sum(a0 * a0 + a1 * a1 + a2 * a2 + a3 * a3) * (1.f / 256.f) + EPS);
          const unsigned c = *(const unsigned*)(up + 2816 + lane * 2);
          const float c0 = bflo(c), c1 = bfhi(c);
          skv = __builtin_amdgcn_rsqf(wave_sum(c0 * c0 + c1 * c1) * (1.f / 128.f) + EPS); }
        const float cs = CS[(size_t)tok * 16 + j], sn = SN[(size_t)tok * 16 + j];
        {
            const bf16_t* qp = QR + (size_t)tok * 384 + h * 96;
            const u32x2 a = *(const u32x2*)(qp + 4 * j);
            float q0 = bflo(a.x) * sq, q1 = bfhi(a.x) * sq, q2 = bflo(a.y) * sq, q3 = bfhi(a.y) * sq;
            float x1 = bf2f(qp[64 + j]) * sq, x2 = bf2f(qp[80 + j]) * sq;
            float ss = q0 * q0 + q1 * q1 + q2 * q2 + q3 * q3 + x1 * x1 + x2 * x2;
            ss += __shfl_xor(ss, 1); ss += __shfl_xor(ss, 2); ss += __shfl_xor(ss, 4); ss += __shfl_xor(ss, 8);
            const float rn = __builtin_amdgcn_rsqf(ss * (1.f / 96.f) + EPS);
            q0 *= rn * qg.x; q1 *= rn * qg.y; q2 *= rn * qg.z; q3 *= rn * qg.w; x1 *= rn * qg1; x2 *= rn * qg2;
            bf16_t* op = MQ + (size_t)tok * 384 + h * 96;
            u32x2 ov; ov.x = cvt_pk(q0, q1); ov.y = cvt_pk(q2, q3);
            *(u32x2*)(op + 4 * j) = ov;
            op[64 + j] = f2bf(x1 * cs - x2 * sn); op[80 + j] = f2bf(x2 * cs + x1 * sn);
        }
        {
            const bf16_t* kp = KVR + (size_t)tok * 512 + h * 128;
            const u32x2 a = *(const u32x2*)(kp + 4 * j);
            float k0 = bflo(a.x) * skv, k1 = bfhi(a.x) * skv, k2 = bflo(a.y) * skv, k3 = bfhi(a.y) * skv;
            float x1 = bf2f(up[2944 + j]), x2 = bf2f(up[2960 + j]);
            float ss = k0 * k0 + k1 * k1 + k2 * k2 + k3 * k3 + x1 * x1 + x2 * x2;
            ss += __shfl_xor(ss, 1); ss += __shfl_xor(ss, 2); ss += __shfl_xor(ss, 4); ss += __shfl_xor(ss, 8);
            const float rn = __builtin_amdgcn_rsqf(ss * (1.f / 96.f) + EPS);
            k0 *= rn * kg.x; k1 *= rn * kg.y; k2 *= rn * kg.z; k3 *= rn * kg.w; x1 *= rn * kg1; x2 *= rn * kg2;
            bf16_t* op = MK + (size_t)tok * 384 + h * 96;
            u32x2 ov; ov.x = cvt_pk(k0, k1); ov.y = cvt_pk(k2, k3);
            *(u32x2*)(op + 4 * j) = ov;
            op[64 + j] = f2bf(x1 * cs - x2 * sn); op[80 + j] = f2bf(x2 * cs + x1 * sn);
            const u32x2 vv = *(const u32x2*)(kp + 64 + 4 * j);
            u32x2 vo; vo.x = cvt_pk(bflo(vv.x) * skv, bfhi(vv.x) * skv); vo.y = cvt_pk(bflo(vv.y) * skv, bfhi(vv.y) * skv);
            *(u32x2*)(vbuf + tl * 256 + h * 64 + 4 * j) = vo;
        }
    }
    __syncthreads();
    {
        const int tid = tidx(), b = (item * 64) / SEQ, s0 = (item * 64) % SEQ, hh = tid >> 6, e = tid & 63;
        bf16_t* dst = MVT + ((size_t)(b * 4 + hh) * 64 + e) * SEQ + s0;
#pragma unroll
        for (int c8 = 0; c8 < 8; ++c8) {
            unsigned wds[4];
#pragma unroll
            for (int k = 0; k < 4; ++k) wds[k] = (unsigned)vbuf[(c8 * 8 + 2 * k) * 256 + tid] | ((unsigned)vbuf[(c8 * 8 + 2 * k + 1) * 256 + tid] << 16);
            uint4 o; o.x = wds[0]; o.y = wds[1]; o.z = wds[2]; o.w = wds[3];
            *(uint4*)(dst + c8 * 8) = o;
        }
    }
    __syncthreads();
}

DI void memkv_finish_tile(const Params& p, int item, unsigned char* smem) {
    const bf16_t* KVM = (const bf16_t*)(p.ws + OFF_KVMEM);
    bf16_t* XK = (bf16_t*)(p.ws + OFF_XK);
    bf16_t* XVT = (bf16_t*)(p.ws + OFF_XVT);
    bf16_t* vbuf = (bf16_t*)smem;
    const int l = item >> 5, b = (item >> 2) & 7, h = item & 3;
    const int w = tidx() >> 6, lane = tidx() & 63;
    const float kg = p.in[I_XKNG][l * 64 + lane];
    for (int r = 0; r < 64; ++r) {
        const int m = w * 64 + r;
        const bf16_t* src = KVM + ((size_t)l * 2048 + b * 256 + m) * 512 + h * 128;
        const float k = bf2f(src[lane]);
        const float rn = __builtin_amdgcn_rsqf(wave_sum(k * k) * (1.f / 64.f) + EPS);
        XK[(((size_t)(l * 8 + b) * 4 + h) * 256 + m) * 64 + lane] = f2bf(k * rn * kg);
        vbuf[m * 64 + lane] = src[64 + lane];
    }
    __syncthreads();
    {
        const int tid = tidx(), e = tid & 63, mq = tid >> 6;
        bf16_t* dst = XVT + (((size_t)(l * 8 + b) * 4 + h) * 64 + e) * 256 + mq * 64;
#pragma unroll
        for (int c8 = 0; c8 < 8; ++c8) {
            unsigned wds[4];
#pragma unroll
            for (int k = 0; k < 4; ++k) wds[k] = (unsigned)vbuf[(mq * 64 + c8 * 8 + 2 * k) * 64 + e] | ((unsigned)vbuf[(mq * 64 + c8 * 8 + 2 * k + 1) * 64 + e] << 16);
            uint4 o; o.x = wds[0]; o.y = wds[1]; o.z = wds[2]; o.w = wds[3];
            *(uint4*)(dst + c8 * 8) = o;
        }
    }
    __syncthreads();
}

template <int DQK, bool QNORM>
DI void attn_tile(const bf16_t* __restrict__ Q, int qs, const bf16_t* __restrict__ Kp, int kstr, const bf16_t* __restrict__ Vt, int vstr, int nkeys,
                  float c2, float mbound, const float* __restrict__ qgain, bf16_t* __restrict__ O, int os, float* __restrict__ ssq, int ssq_stride, unsigned char* smem) {
    constexpr int NKS = DQK / 32, KP = DQK * 2 + 16, KCH = DQK / 8, KB = 64 * KP, VB = 64 * 144, STG = KB + VB, NKL = (64 * KCH) / 256;
    const int tid = tidx(), w = tid >> 6, lane = tid & 63, l15 = lane & 15, quad = lane >> 4;
    bf16x8 bq[2][NKS];
#pragma unroll
    for (int qt = 0; qt < 2; ++qt) {
        const bf16_t* qp = Q + (size_t)(w * 32 + qt * 16 + l15) * qs + quad * 8;
        if (QNORM) {
            float v[NKS][8]; float ss = 0.f;
#pragma unroll
            for (int ks = 0; ks < NKS; ++ks) {
                const uint4 x = *(const uint4*)(qp + ks * 32);
                v[ks][0] = bflo(x.x); v[ks][1] = bfhi(x.x); v[ks][2] = bflo(x.y); v[ks][3] = bfhi(x.y); v[ks][4] = bflo(x.z); v[ks][5] = bfhi(x.z); v[ks][6] = bflo(x.w); v[ks][7] = bfhi(x.w);
#pragma unroll
                for (int j = 0; j < 8; ++j) ss += v[ks][j] * v[ks][j];
            }
            ss += __shfl_xor(ss, 16); ss += __shfl_xor(ss, 32);
            const float rn = __builtin_amdgcn_rsqf(ss * (1.f / DQK) + EPS);
#pragma unroll
            for (int ks = 0; ks < NKS; ++ks) {
                const float* gp = qgain + ks * 32 + quad * 8;
                u32x4 o;
                o.x = cvt_pk(v[ks][0] * rn * gp[0], v[ks][1] * rn * gp[1]); o.y = cvt_pk(v[ks][2] * rn * gp[2], v[ks][3] * rn * gp[3]);
                o.z = cvt_pk(v[ks][4] * rn * gp[4], v[ks][5] * rn * gp[5]); o.w = cvt_pk(v[ks][6] * rn * gp[6], v[ks][7] * rn * gp[7]);
                bq[qt][ks] = __builtin_bit_cast(bf16x8, o);
            }
        } else {
#pragma unroll
            for (int ks = 0; ks < NKS; ++ks) bq[qt][ks] = *(const bf16x8*)(qp + ks * 32);
        }
    }
    f32x4 o[4][2];
    float lrun[2];
#pragma unroll
    for (int qt = 0; qt < 2; ++qt) {
        lrun[qt] = 0.f;
#pragma unroll
        for (int et = 0; et < 4; ++et) o[et][qt] = (f32x4){0.f, 0.f, 0.f, 0.f};
    }
    uint4 ak0, ak1, ak2, av0, av1, bk0, bk1, bk2, bv0, bv1;
    ak2 = make_uint4(0u, 0u, 0u, 0u); bk2 = ak2;
    const int kr0 = tid / KCH, kc0 = tid % KCH, kr1 = (tid + 256) / KCH, kc1 = (tid + 256) % KCH, kr2 = (tid + 512) / KCH, kc2 = (tid + 512) % KCH;
    const int vr0 = tid >> 3, vc0 = tid & 7, vr1 = vr0 + 32;
#define A_LOAD(S, key0) do { S##k0 = *(const uint4*)(Kp + (size_t)((key0) + kr0) * kstr + kc0 * 8); S##k1 = *(const uint4*)(Kp + (size_t)((key0) + kr1) * kstr + kc1 * 8); \
                          if (NKL > 2) S##k2 = *(const uint4*)(Kp + (size_t)((key0) + kr2) * kstr + kc2 * 8); \
                          S##v0 = *(const uint4*)(Vt + (size_t)vr0 * vstr + (key0) + vc0 * 8); S##v1 = *(const uint4*)(Vt + (size_t)vr1 * vstr + (key0) + vc0 * 8); } while (0)
#define A_STORE(S, buf) do { unsigned char* kb_ = smem + (buf) * STG; unsigned char* vb_ = kb_ + KB; \
                          *(uint4*)(kb_ + kr0 * KP + kc0 * 16) = S##k0; *(uint4*)(kb_ + kr1 * KP + kc1 * 16) = S##k1; if (NKL > 2) *(uint4*)(kb_ + kr2 * KP + kc2 * 16) = S##k2; \
                          *(uint4*)(vb_ + vr0 * 144 + vc0 * 16) = S##v0; *(uint4*)(vb_ + vr1 * 144 + vc0 * 16) = S##v1; } while (0)
    const int nkb = nkeys >> 6;
    A_LOAD(a, 0); A_STORE(a, 0);
    A_LOAD(b, 64);
    if (2 < nkb) A_LOAD(a, 128);
    __syncthreads();
#define A_COMPUTE(cur) do { \
        const unsigned char* kb = smem + cur * STG; const unsigned char* vb = kb + KB; \
        f32x4 s[4][2]; \
_Pragma("unroll")         for (int kt = 0; kt < 4; ++kt) { s[kt][0] = (f32x4){0.f, 0.f, 0.f, 0.f}; s[kt][1] = (f32x4){0.f, 0.f, 0.f, 0.f}; } \
_Pragma("unroll")         for (int ks = 0; ks < NKS; ++ks) { \
            bf16x8 ak[4]; \
_Pragma("unroll")             for (int kt = 0; kt < 4; ++kt) ak[kt] = *(const bf16x8*)(kb + (kt * 16 + l15) * KP + ks * 64 + quad * 16); \
_Pragma("unroll")             for (int kt = 0; kt < 4; ++kt) { s[kt][0] = MFMA16(ak[kt], bq[0][ks], s[kt][0]); s[kt][1] = MFMA16(ak[kt], bq[1][ks], s[kt][1]); } \
        } \
        bf16x8 pb[2][2]; \
_Pragma("unroll")         for (int qt = 0; qt < 2; ++qt) { \
            float ls = 0.f; \
            float pv[4][4]; \
_Pragma("unroll")             for (int kt = 0; kt < 4; ++kt) \
_Pragma("unroll")                 for (int r = 0; r < 4; ++r) { pv[kt][r] = __builtin_amdgcn_exp2f(s[kt][qt][r] * c2 - mbound); ls += pv[kt][r]; } \
            lrun[qt] += ls; \
_Pragma("unroll")             for (int k2 = 0; k2 < 2; ++k2) { \
                u32x4 pw; pw.x = cvt_pk(pv[2 * k2][0], pv[2 * k2][1]); pw.y = cvt_pk(pv[2 * k2][2], pv[2 * k2][3]); \
                pw.z = cvt_pk(pv[2 * k2 + 1][0], pv[2 * k2 + 1][1]); pw.w = cvt_pk(pv[2 * k2 + 1][2], pv[2 * k2 + 1][3]); \
                pb[qt][k2] = __builtin_bit_cast(bf16x8, pw); \
            } \
        } \
_Pragma("unroll")         for (int k2 = 0; k2 < 2; ++k2) \
_Pragma("unroll")             for (int et = 0; et < 4; ++et) { \
                const unsigned char* vp = vb + (et * 16 + l15) * 144 + k2 * 64 + quad * 8; \
                const u32x2 lo = *(const u32x2*)vp, hi = *(const u32x2*)(vp + 32); \
                u32x4 a; a.x = lo.x; a.y = lo.y; a.z = hi.x; a.w = hi.y; \
                const bf16x8 av = __builtin_bit_cast(bf16x8, a); \
                o[et][0] = MFMA16(av, pb[0][k2], o[et][0]); \
                o[et][1] = MFMA16(av, pb[1][k2], o[et][1]); \
            } \
    } while (0)
#pragma unroll 1
    for (int jb = 0; jb < nkb; jb += 2) {
        A_STORE(b, 1);
        if (jb + 3 < nkb) A_LOAD(b, (jb + 3) * 64);
        __builtin_amdgcn_sched_barrier(0);
        A_COMPUTE(0);
        __syncthreads();
        if (jb + 2 < nkb) A_STORE(a, 0);
        if (jb + 4 < nkb) A_LOAD(a, (jb + 4) * 64);
        __builtin_amdgcn_sched_barrier(0);
        A_COMPUTE(1);
        __syncthreads();
    }
#undef A_COMPUTE
#undef A_LOAD
#undef A_STORE
#pragma unroll
    for (int qt = 0; qt < 2; ++qt) {
        float lt = lrun[qt]; lt += __shfl_xor(lt, 16); lt += __shfl_xor(lt, 32);
        const float inv = 1.f / lt;
        const int q = w * 32 + qt * 16 + l15;
        float ss = 0.f;
#pragma unroll
        for (int et = 0; et < 4; ++et) {
            const float y0 = o[et][qt][0] * inv, y1 = o[et][qt][1] * inv, y2 = o[et][qt][2] * inv, y3 = o[et][qt][3] * inv;
            ss += y0 * y0 + y1 * y1 + y2 * y2 + y3 * y3;
            u32x2 ov; ov.x = cvt_pk(y0, y1); ov.y = cvt_pk(y2, y3);
            *(u32x2*)(O + (size_t)q * os + et * 16 + quad * 4) = ov;
        }
        if (ssq) { ss += __shfl_xor(ss, 16); ss += __shfl_xor(ss, 32); if (quad == 0) ssq[(size_t)q * ssq_stride] = ss; }
    }
}

namespace pg8 {
#define PG8_LAS __attribute__((address_space(3)))
constexpr int BM = 256, BK = 64, HALF = 128, HTB = HALF * BK * 2, STAGE_BYTES = 8 * HTB, NXCD = 8, WGM = 8;
DI int lds_byte(int r, int c) { const int st = (r >> 4) * 2 + (c >> 5), rr = r & 15, cc = c & 31, ob = rr * 64 + cc * 2; return st * 1024 + (ob ^ (((ob >> 9) & 1) << 5)); }
DI void stage_rc(int b, int& R, int& C) { const int st = b / 1024, sb = b % 1024, swz = sb ^ (((sb >> 9) & 1) << 5); R = (st >> 1) * 16 + swz / 64; C = (st & 1) * 32 + (swz % 64) / 2; }
struct Unit { int pm, pn; };
struct Gemm { const bf16_t* A; const bf16_t* Bt; int M, N, K; };
struct StaticOrder {
    int nM, nN, nwg, G, c;
    DI void init(int M, int N, int G_, int c_) { nM = M / BM; nN = N / BM; nwg = nM * nN; G = G_; c = c_; }
    DI bool next(int i, Unit& u) const {
        const long L = (long)i * G + c; if (L >= nwg) return false;
        int wgid = (int)L; { const int q = nwg / NXCD, r = nwg % NXCD, xcd = wgid % NXCD, off = wgid / NXCD; wgid = (xcd < r ? xcd * (q + 1) : r * (q + 1) + (xcd - r) * q) + off; }
        const int nig = WGM * nN, gid = wgid / nig, fm = gid * WGM, gsz = (nM - fm) < WGM ? (nM - fm) : WGM;
        u.pm = fm + ((wgid % nig) % gsz); u.pn = (wgid % nig) / gsz; return true;
    }
};
DI float row_rstd(const float* part, int row) {
    const float4* p4 = (const float4*)(part + (size_t)row * 16);
    const float4 a = p4[0], b = p4[1], c = p4[2], d = p4[3];
    const float s = (a.x + a.y + a.z + a.w) + (b.x + b.y + b.z + b.w) + (c.x + c.y + c.z + c.w) + (d.x + d.y + d.z + d.w);
    return __builtin_amdgcn_rsqf(s * (1.f / DM) + EPS);
}
struct EpiScaled {
    bf16_t* O; int ldo; const float* part; int ncols;
    DI void operator()(const f32x4 (&acc)[2][2][4][2], const Unit& u, int wr, int wc, int fr, int fq) const {
#pragma unroll
        for (int ai = 0; ai < 2; ++ai)
#pragma unroll
            for (int m = 0; m < 4; ++m) {
                const int row = u.pm * BM + ai * HALF + wr * 64 + m * 16 + fr;
                const float sc = row_rstd(part, row);
                bf16_t* rowp = O + (size_t)row * ldo + u.pn * BM + wc * 32 + fq * 4;
#pragma unroll
                for (int bj = 0; bj < 2; ++bj) {
                    if (u.pn * BM + bj * HALF + wc * 32 >= ncols) continue;
#pragma unroll
                    for (int n = 0; n < 2; ++n) {
                        u32x2 v; v.x = cvt_pk(acc[ai][bj][m][n][0] * sc, acc[ai][bj][m][n][1] * sc); v.y = cvt_pk(acc[ai][bj][m][n][2] * sc, acc[ai][bj][m][n][3] * sc);
                        *(u32x2*)(rowp + bj * HALF + n * 16) = v;
                    }
                }
            }
    }
};
struct EpiSwiglu {
    bf16_t* H; const float* part;
    DI void operator()(const f32x4 (&acc)[2][2][4][2], const Unit& u, int wr, int wc, int fr, int fq) const {
#pragma unroll
        for (int ai = 0; ai < 2; ++ai)
#pragma unroll
            for (int m = 0; m < 4; ++m) {
                const int row = u.pm * BM + ai * HALF + wr * 64 + m * 16 + fr;
                const float sc = row_rstd(part, row);
                bf16_t* rowp = H + (size_t)row * DFF + ((u.pn * BM + wc * 32) >> 1) + fq * 4;
#pragma unroll
                for (int bj = 0; bj < 2; ++bj) {
                    float h[4];
#pragma unroll
                    for (int j = 0; j < 4; ++j) { const float a1 = acc[ai][bj][m][0][j] * sc, a3 = acc[ai][bj][m][1][j] * sc; h[j] = a1 * sigmoidf_(a1) * a3; }
                    u32x2 v; v.x = cvt_pk(h[0], h[1]); v.y = cvt_pk(h[2], h[3]);
                    *(u32x2*)(rowp + bj * (HALF / 2)) = v;
                }
            }
    }
};
struct EpiResid {
    bf16_t* XB; float* rowsq; float* OUT;
    DI void operator()(const f32x4 (&acc)[2][2][4][2], const Unit& u, int wr, int wc, int fr, int fq) const {
#pragma unroll
        for (int ai = 0; ai < 2; ++ai)
#pragma unroll
            for (int m = 0; m < 4; ++m) {
                const int row = u.pm * BM + ai * HALF + wr * 64 + m * 16 + fr;
                float ss = 0.f;
#pragma unroll
                for (int bj = 0; bj < 2; ++bj)
#pragma unroll
                    for (int n = 0; n < 2; ++n) {
                        const int col = u.pn * BM + bj * HALF + wc * 32 + n * 16 + fq * 4;
                        u32x2* xp = (u32x2*)(XB + (size_t)row * DM + col);
                        const u32x2 xo = *xp;
                        const float x0 = bflo(xo.x) + acc[ai][bj][m][n][0], x1 = bfhi(xo.x) + acc[ai][bj][m][n][1];
                        const float x2 = bflo(xo.y) + acc[ai][bj][m][n][2], x3 = bfhi(xo.y) + acc[ai][bj][m][n][3];
                        if (OUT) *(f32x4*)(OUT + (size_t)row * DM + col) = (f32x4){x0, x1, x2, x3};
                        else { u32x2 v; v.x = cvt_pk(x0, x1); v.y = cvt_pk(x2, x3); *xp = v; }
                        ss += x0 * x0 + x1 * x1 + x2 * x2 + x3 * x3;
                    }
                ss += __shfl_xor(ss, 16); ss += __shfl_xor(ss, 32);
                if (fq == 0 && !OUT) rowsq[(size_t)row * 16 + u.pn * 4 + wc] = ss;
            }
    }
};

template <class Epi, bool SCALED = false>
DI void gemm_phase(PG8_LAS unsigned char* lds, const Gemm g, const StaticOrder& S, const Epi& E, const float* ssq0 = nullptr, const float* ssq1 = nullptr) {
    int tid = threadIdx.x; asm volatile("" : "+v"(tid));
    const int wid = __builtin_amdgcn_readfirstlane(tid >> 6), lane = tid & 63, wr = wid >> 2, wc = wid & 3, fr = lane & 15, fq = lane >> 4;
    const int K = g.K, nt = K / BK;
    unsigned voffA[2];
#pragma unroll
    for (int i = 0; i < 2; ++i) { int R, C; stage_rc(tid * 16 + i * 8192, R, C); voffA[i] = (unsigned)(R * K + C) * 2u; }
    const size_t kstep = (size_t)(BK * 2);
    const size_t hstep = (size_t)HALF * K * 2;
    const size_t tstep = 2 * hstep;
    const unsigned ldsw = (unsigned)wid * 1024u;
    const int aoff = lds_byte(wr * 64 + fr, fq * 8), boff = lds_byte(wc * 32 + fr, fq * 8);
#define PG8_SA(b, h) (((b) * 2 + (h)) * HTB)
#define PG8_SB(b, h) ((4 + (b) * 2 + (h)) * HTB)
#define PG8_STAGE(bufoff, gbase) do { _Pragma("unroll") for (int _i = 0; _i < 2; ++_i) \
        __builtin_amdgcn_global_load_lds((const unsigned*)((const char*)(gbase) + voffA[_i]), (PG8_LAS unsigned*)(lds + (bufoff) + ldsw + _i * 8192), 16, 0, 0); } while (0)
#define PG8_LDA(dst, b, h) do { _Pragma("unroll") for (int m = 0; m < 4; ++m) _Pragma("unroll") for (int k = 0; k < 2; ++k) dst[m][k] = *(const PG8_LAS bf16x8*)(lds + PG8_SA(b, h) + aoff + m * 2048 + k * 1024); } while (0)
#define PG8_LDB(dst, b, h) do { _Pragma("unroll") for (int n = 0; n < 2; ++n) _Pragma("unroll") for (int k = 0; k < 2; ++k) dst[n][k] = *(const PG8_LAS bf16x8*)(lds + PG8_SB(b, h) + boff + n * 2048 + k * 1024); } while (0)
#define PG8_MMA(ai, bj, At, Bt) do { __builtin_amdgcn_s_setprio(1); _Pragma("unroll") for (int m = 0; m < 4; ++m) _Pragma("unroll") for (int n = 0; n < 2; ++n) _Pragma("unroll") for (int k = 0; k < 2; ++k) \
        acc[ai][bj][m][n] = __builtin_amdgcn_mfma_f32_16x16x32_bf16(Bt[n][k], At[m][k], acc[ai][bj][m][n], 0, 0, 0); __builtin_amdgcn_s_setprio(0); } while (0)
#define PG8_WAIT_V(n) asm volatile("s_waitcnt vmcnt(" #n ")" ::: "memory")
#define PG8_WAIT_L(n) asm volatile("s_waitcnt lgkmcnt(" #n ")" ::: "memory")
#define PG8_BAR __builtin_amdgcn_s_barrier()
#define PG8_SCHED __builtin_amdgcn_sched_barrier(0)
    Unit cur, nxt; int ui = 0;
    if (!S.next(0, cur)) return;
    f32x4 acc[2][2][4][2];
#pragma unroll
    for (int a = 0; a < 2; ++a)
#pragma unroll
        for (int b = 0; b < 2; ++b)
#pragma unroll
            for (int m = 0; m < 4; ++m)
#pragma unroll
                for (int n = 0; n < 2; ++n) acc[a][b][m][n] = (f32x4){0.f, 0.f, 0.f, 0.f};
    bf16x8 At[4][2], B0[2][2], B1[2][2];
    const char* cA = (const char*)g.A + (size_t)cur.pm * tstep; const char* cB = (const char*)g.Bt + (size_t)cur.pn * tstep;
#define PG8_FTAB(unit) do { if (SCALED && tid < 256) { const int row_ = (unit).pm * BM + tid; \
        const float4 sb_ = *(const float4*)(ssq0 + (size_t)row_ * 4), sd_ = *(const float4*)(ssq1 + (size_t)row_ * 4); \
        const float rB_ = __builtin_amdgcn_rsqf((sb_.x + sb_.y + sb_.z + sb_.w) * (1.f / 256.f) + EPS), rD_ = __builtin_amdgcn_rsqf((sd_.x + sd_.y + sd_.z + sd_.w) * (1.f / 256.f) + EPS); \
        PG8_LAS float* ft_ = (PG8_LAS float*)(lds + STAGE_BYTES); ft_[tid] = rB_ / rD_; ft_[256 + tid] = rD_; } } while (0)
    PG8_FTAB(cur);
    PG8_STAGE(PG8_SB(0, 0), cB); PG8_STAGE(PG8_SB(0, 1), cB + hstep); PG8_STAGE(PG8_SA(0, 0), cA); PG8_STAGE(PG8_SA(0, 1), cA + hstep);
    if (wr == 1) PG8_BAR;
    PG8_WAIT_V(2); PG8_BAR;
    PG8_STAGE(PG8_SB(1, 0), cB + kstep); PG8_STAGE(PG8_SA(1, 0), cA + kstep); PG8_STAGE(PG8_SB(1, 1), cB + hstep + kstep);
    PG8_WAIT_V(6); PG8_BAR;
    for (;;) {
        const bool has_next = S.next(ui + 1, nxt);
        const char* nA = has_next ? (const char*)g.A + (size_t)nxt.pm * tstep : cA; const char* nB = has_next ? (const char*)g.Bt + (size_t)nxt.pn * tstep : cB;
        for (int t = 0; t < nt; t += 2) {
            const bool last = (t == nt - 2);
            const char* a1 = cA + (size_t)(t + 1) * kstep;
            const char* a2 = last ? nA : cA + (size_t)(t + 2) * kstep; const char* b2 = last ? nB : cB + (size_t)(t + 2) * kstep;
            const char* a3 = a2 + kstep; const char* b3 = b2 + kstep;
            if (SCALED && (t == 4 || t == 8)) {
                const PG8_LAS float* ft = (const PG8_LAS float*)(lds + STAGE_BYTES) + (t == 8 ? 256 : 0);
#pragma unroll
                for (int ai = 0; ai < 2; ++ai)
#pragma unroll
                    for (int m = 0; m < 4; ++m) {
                        const float f = ft[ai * HALF + wr * 64 + m * 16 + fr];
#pragma unroll
                        for (int bj = 0; bj < 2; ++bj)
#pragma unroll
                            for (int n = 0; n < 2; ++n) acc[ai][bj][m][n] *= f;
                    }
            }
            PG8_LDB(B0, 0, 0); PG8_LDB(B1, 0, 1); PG8_SCHED; PG8_LDA(At, 0, 0); PG8_STAGE(PG8_SA(1, 1), a1 + hstep);
            PG8_WAIT_V(8); PG8_WAIT_L(0); PG8_BAR; PG8_MMA(0, 0, At, B0); PG8_MMA(0, 1, At, B1); PG8_BAR; PG8_SCHED;
            PG8_LDA(At, 0, 1); PG8_STAGE(PG8_SB(0, 0), b2); PG8_STAGE(PG8_SB(0, 1), b2 + hstep); PG8_STAGE(PG8_SA(0, 0), a2);
            PG8_WAIT_V(8); PG8_WAIT_L(0); PG8_BAR; PG8_MMA(1, 0, At, B0); PG8_MMA(1, 1, At, B1); PG8_BAR; PG8_SCHED;
            PG8_LDB(B0, 1, 0); PG8_LDB(B1, 1, 1); PG8_SCHED; PG8_LDA(At, 1, 0); PG8_STAGE(PG8_SA(0, 1), a2 + hstep);
            PG8_WAIT_V(8); PG8_WAIT_L(0); PG8_BAR; PG8_MMA(0, 0, At, B0); PG8_MMA(0, 1, At, B1); PG8_BAR; PG8_SCHED;
            PG8_LDA(At, 1, 1); PG8_STAGE(PG8_SB(1, 0), b3); PG8_STAGE(PG8_SB(1, 1), b3 + hstep); PG8_STAGE(PG8_SA(1, 0), a3);
            PG8_WAIT_V(8); PG8_WAIT_L(0); PG8_BAR; PG8_MMA(1, 0, At, B0); PG8_MMA(1, 1, At, B1); PG8_BAR; PG8_SCHED;
        }
        if (wr == 0) PG8_BAR;
        E(acc, cur, wr, wc, fr, fq);
        if (!has_next) break;
#pragma unroll
        for (int a = 0; a < 2; ++a)
#pragma unroll
            for (int b = 0; b < 2; ++b)
#pragma unroll
                for (int m = 0; m < 4; ++m)
#pragma unroll
                    for (int n = 0; n < 2; ++n) acc[a][b][m][n] = (f32x4){0.f, 0.f, 0.f, 0.f};
        cur = nxt; cA = nA; cB = nB; ++ui;
        if (wr == 1) PG8_BAR;
        PG8_FTAB(cur);
    }
    PG8_WAIT_V(0);
    PG8_BAR;
#undef PG8_FTAB
#undef PG8_SA
#undef PG8_SB
#undef PG8_STAGE
#undef PG8_LDA
#undef PG8_LDB
#undef PG8_MMA
#undef PG8_WAIT_V
#undef PG8_WAIT_L
#undef PG8_BAR
#undef PG8_SCHED
}
}

enum { PH_PRO = 0, PH_CONV, PH_P1, PH_P2, PH_P3, PH_P4, PH_P5, PH_P6, PH_P7, PH_P8, PH_P9, PH_P10, PH_COUNT };

DI void gemm_item_bf16(const bf16_t* A, int lda, const bf16_t* Bt, int K, int nM, int nN, int L, bf16_t* O, int ldo, const float* part, int npart, float inv_n, unsigned char* smem) {
    int pm, pn; tile_order(L, nM, nN, pm, pn);
    if (part) fill_rs(smem, part, npart, pm * 128, inv_n);
    f32x4 acc[4][4];
    gemm_mainloop<false>(A, lda, Bt, K, pm * 128, pn * 128, smem, acc);
    epi_bf16(acc, O, ldo, pm * 128, pn * 128, part ? (const float*)(smem + 65536) : nullptr);
    __syncthreads();
}
template <bool ASC>
DI void gemm_item_resid(const Params& p, const bf16_t* A, int lda, const bf16_t* Bt, int K, int L, unsigned char* smem) {
    int pm, pn; tile_order(L, 256, 8, pm, pn);
    if (ASC) {
        float* asc = (float*)(smem + 66048);
        const float* sb = (const float*)(p.ws + OFF_SSQB); const float* sd = (const float*)(p.ws + OFF_SSQD);
        const int tid = tidx();
        if (tid < 128) {
            const float4 a = *(const float4*)(sb + (size_t)(pm * 128 + tid) * 4), d = *(const float4*)(sd + (size_t)(pm * 128 + tid) * 4);
            asc[tid * 2] = __builtin_amdgcn_rsqf((a.x + a.y + a.z + a.w) * (1.f / 256.f) + EPS);
            asc[tid * 2 + 1] = __builtin_amdgcn_rsqf((d.x + d.y + d.z + d.w) * (1.f / 256.f) + EPS);
        }
    }
    f32x4 acc[4][4];
    gemm_mainloop<ASC>(A, lda, Bt, K, pm * 128, pn * 128, smem, acc);
    epi_resid(acc, p.out, (bf16_t*)(p.ws + OFF_XB), (float*)(p.ws + OFF_ROWSQ), pm * 128, pn * 128);
    __syncthreads();
}

DI void run_phase(const Params& p, int ph, int l, unsigned char* smem0) {
    const int vb = __builtin_amdgcn_readfirstlane((int)(threadIdx.x >> 8));
    unsigned char* smem = smem0 + vb * LDS_BYTES;
    const int G = gridDim.x * 2, bid = blockIdx.x * 2 + vb;
    const bf16_t* W = (const bf16_t*)(p.ws + OFF_W);
    const bf16_t* XB = (const bf16_t*)(p.ws + OFF_XB);
    bf16_t* U = (bf16_t*)(p.ws + OFF_U);
    const float* ROWSQ = (const float*)(p.ws + OFF_ROWSQ);
#ifdef ONLY_PH
    if (ph != ONLY_PH) return;
#endif
    switch (ph) {
    case PH_PRO: {
        for (int i = bid; i < 2048; i += G) pro_rows(p.in[I_X], nullptr, (bf16_t*)(p.ws + OFF_XB), (float*)(p.ws + OFF_ROWSQ), 16, i);
        for (int i = bid; i < 128; i += G) pro_rows(p.in[I_MEM], nullptr, (bf16_t*)(p.ws + OFF_MEMB), (float*)(p.ws + OFF_MEMSQ), 1, i);
        for (int i = bid; i < 128; i += G) pro_rope(p, i);
        for (int i = bid; i < 512; i += G) { const int ll = i >> 7; conv_tile(p.in[I_XWKV] + (size_t)ll * DM * 512, DM, 512, 512, p.in[I_GMEM] + ll * DM, 0, (bf16_t*)(p.ws + OFF_XWKV) + (size_t)ll * 512 * DM, i & 127, smem); }
        for (int i = bid; i < CONV_TILES; i += G) conv_layer_item(p, 0, i, smem);
    } break;
    case PH_CONV: {
        for (int it = bid; it < CONV_TILES; it += G) conv_layer_item(p, l, it, smem);
    } break;
    case PH_P1: {
        { pg8::Gemm g{XB, W + W_IN, T_TOK, UC, DM}; pg8::StaticOrder S; S.init(T_TOK, UC, gridDim.x, blockIdx.x);
          pg8::EpiScaled E{U, UC, ROWSQ, INC};
          pg8::gemm_phase<pg8::EpiScaled>((PG8_LAS unsigned char*)smem0, g, S, E); }
        if (l == 0) {
            for (int i = bid; i < 256; i += G) {
                const int ll = i >> 6;
                gemm_item_bf16((const bf16_t*)(p.ws + OFF_MEMB), DM, (const bf16_t*)(p.ws + OFF_XWKV) + (size_t)ll * 512 * DM, DM, 16, 4, i & 63,
                               (bf16_t*)(p.ws + OFF_KVMEM) + (size_t)ll * 2048 * 512, 512, (const float*)(p.ws + OFF_MEMSQ), 1, 1.f / DM, smem);
            }
        }
    } break;
    case PH_P2: {
        for (int i = bid; i < 1024; i += G) hgrn_local_tile(p, l, i, smem);
#ifdef RP2_HL
        for (int i = bid; i < 1024; i += G) hgrn_local_tile(p, l, i, smem);
#endif
        for (int i = bid; i < 1024; i += G) conformer_tile(p, l, i, smem);
#ifdef RP2_CF
        for (int i = bid; i < 1024; i += G) conformer_tile(p, l, i, smem);
#endif
#ifdef RP2_G
        for (int i = bid; i < 768; i += G) gemm_item_bf16(U + 2560, UC, W + W_UQ, 256, 256, 3, i, (bf16_t*)((unsigned char*)p.out + QRAW_IN_OUT), 384, nullptr, 0, 0.f, smem);
        for (int i = bid; i < 1024; i += G) gemm_item_bf16(U + 2816, UC, W + W_UKV, 128, 256, 4, i, (bf16_t*)((unsigned char*)p.out + KVRAW_IN_OUT), 512, nullptr, 0, 0.f, smem);
#endif
#ifdef RP2_SC
        for (int i = bid; i < 512; i += G) shortconv_tile(p, l, i);
#endif
        for (int i = bid; i < 768; i += G) gemm_item_bf16(U + 2560, UC, W + W_UQ, 256, 256, 3, i, (bf16_t*)((unsigned char*)p.out + QRAW_IN_OUT), 384, nullptr, 0, 0.f, smem);
        for (int i = bid; i < 1024; i += G) gemm_item_bf16(U + 2816, UC, W + W_UKV, 128, 256, 4, i, (bf16_t*)((unsigned char*)p.out + KVRAW_IN_OUT), 512, nullptr, 0, 0.f, smem);
        for (int i = bid; i < 512; i += G) shortconv_tile(p, l, i);
        if (l == 0) { for (int i = bid; i < 128; i += G) memkv_finish_tile(p, i, smem); }
    } break;
    case PH_P3: {
        for (int i = bid; i < 1024; i += G) hgrn_scan_item(p, i);
        for (int i = bid; i < 512; i += G) mla_finish_tile(p, l, i, smem);
#ifdef RP3_MF
        for (int i = bid; i < 512; i += G) mla_finish_tile(p, l, i, smem);
#endif
#ifdef RP3_SC
        for (int i = bid; i < 1024; i += G) hgrn_scan_dummy(p, i);
#endif
    } break;
    case PH_P4: {
        const float c2 = 0.10206207261596575f * 1.4426950408889634f;
        float mb;
        {
            const int ln = tidx() & 63;
            float gq = fmaxf(fabsf(p.in[I_MQNG][l * 96 + ln]), ln < 32 ? fabsf(p.in[I_MQNG][l * 96 + 64 + ln]) : 0.f);
            float gk = fmaxf(fabsf(p.in[I_MKNG][l * 96 + ln]), ln < 32 ? fabsf(p.in[I_MKNG][l * 96 + 64 + ln]) : 0.f);
#pragma unroll
            for (int o = 32; o > 0; o >>= 1) { gq = fmaxf(gq, __shfl_xor(gq, o)); gk = fmaxf(gk, __shfl_xor(gk, o)); }
            mb = 96.f * gq * gk * c2;
        }
        for (int it0 = bid; it0 < 1024; it0 += G) {
            const int xcd = blockIdx.x & 7, jx = ((blockIdx.x >> 3) << 1) + vb, loc = (it0 / G) * 64 + jx;
            const int it = (G == 512) ? (xcd * 128 + loc) : it0;
            const int bh = it >> 5, qt = it & 31, b = bh >> 2, h = bh & 3;
            const size_t tok0 = (size_t)b * SEQ + qt * 128;
            attn_tile<96, false>((const bf16_t*)(p.ws + OFF_MQ) + tok0 * 384 + h * 96, 384, (const bf16_t*)(p.ws + OFF_MK) + (size_t)b * SEQ * 384 + h * 96, 384,
                                 (const bf16_t*)(p.ws + OFF_MVT) + (size_t)bh * 64 * SEQ, SEQ, SEQ, c2, mb, nullptr,
                                 (bf16_t*)(p.ws + OFF_CAT) + tok0 * DM + 256 + h * 64, DM, (float*)(p.ws + OFF_SSQD) + tok0 * 4 + h, 4, smem);
        }
        for (int i = bid; i < 2048; i += G) hgrn_out_tile(p, l, i, smem);
#ifdef REPEAT_HGOUT
        for (int i = bid; i < 2048; i += G) hgrn_out_tile(p, l, i, smem);
#endif
    } break;
    case PH_P5: {
        pg8::Gemm g{(const bf16_t*)(p.ws + OFF_CAT), W + W_OUT, T_TOK, DM, DM}; pg8::StaticOrder S; S.init(T_TOK, DM, gridDim.x, blockIdx.x);
        pg8::EpiResid E{(bf16_t*)(p.ws + OFF_XB), (float*)(p.ws + OFF_ROWSQ), nullptr};
        pg8::gemm_phase<pg8::EpiResid, true>((PG8_LAS unsigned char*)smem0, g, S, E, (const float*)(p.ws + OFF_SSQB), (const float*)(p.ws + OFF_SSQD));
    } break;
    case PH_P6: {
        for (int it = bid; it < 512; it += G) gemm_item_bf16(XB, DM, W + W_XQ, DM, 256, 2, it, (bf16_t*)(p.ws + OFF_XQ), 256, ROWSQ, 16, 1.f / DM, smem);
    } break;
    case PH_P7: {
        const float c2 = 0.125f * 1.4426950408889634f;
        float mb;
        {
            const int ln = tidx() & 63;
            float gq = fabsf(p.in[I_XQNG][l * 64 + ln]), gk = fabsf(p.in[I_XKNG][l * 64 + ln]);
#pragma unroll
            for (int o = 32; o > 0; o >>= 1) { gq = fmaxf(gq, __shfl_xor(gq, o)); gk = fmaxf(gk, __shfl_xor(gk, o)); }
            mb = 64.f * gq * gk * c2;
        }
        for (int it0 = bid; it0 < 1024; it0 += G) {
            const int xcd = blockIdx.x & 7, jx = ((blockIdx.x >> 3) << 1) + vb, loc = (it0 / G) * 64 + jx;
            const int it = (G == 512) ? (xcd * 128 + loc) : it0;
            const int bh = it >> 5, qt = it & 31, b = bh >> 2, h = bh & 3;
            const size_t tok0 = (size_t)b * SEQ + qt * 128;
            attn_tile<64, true>((const bf16_t*)(p.ws + OFF_XQ) + tok0 * 256 + h * 64, 256, (const bf16_t*)(p.ws + OFF_XK) + ((size_t)(l * 8 + b) * 4 + h) * 256 * 64, 64,
                                (const bf16_t*)(p.ws + OFF_XVT) + ((size_t)(l * 8 + b) * 4 + h) * 64 * 256, 256, 256, c2, mb, p.in[I_XQNG] + l * 64,
                                (bf16_t*)(p.ws + OFF_XO) + tok0 * 256 + h * 64, 256, nullptr, 0, smem);
        }
    } break;
    case PH_P8: {
        pg8::Gemm g{(const bf16_t*)(p.ws + OFF_XO), W + W_XO, T_TOK, DM, 256}; pg8::StaticOrder S; S.init(T_TOK, DM, gridDim.x, blockIdx.x);
        pg8::EpiResid E{(bf16_t*)(p.ws + OFF_XB), (float*)(p.ws + OFF_ROWSQ), nullptr};
        pg8::gemm_phase<pg8::EpiResid>((PG8_LAS unsigned char*)smem0, g, S, E);
    } break;
    case PH_P9: {
        pg8::Gemm g{XB, W + W_13, T_TOK, 2 * DFF, DM}; pg8::StaticOrder S; S.init(T_TOK, 2 * DFF, gridDim.x, blockIdx.x);
        pg8::EpiSwiglu E{(bf16_t*)(p.ws + OFF_HFF), ROWSQ};
        pg8::gemm_phase<pg8::EpiSwiglu>((PG8_LAS unsigned char*)smem0, g, S, E);
    } break;
    case PH_P10: {
        pg8::Gemm g{(const bf16_t*)(p.ws + OFF_HFF), W + W_2, T_TOK, DM, DFF}; pg8::StaticOrder S; S.init(T_TOK, DM, gridDim.x, blockIdx.x);
        pg8::EpiResid E{(bf16_t*)(p.ws + OFF_XB), (float*)(p.ws + OFF_ROWSQ), (l == NL - 1) ? p.out : nullptr};
        pg8::gemm_phase<pg8::EpiResid>((PG8_LAS unsigned char*)smem0, g, S, E);
    } break;
    }
}

#define XB_TMO      128
#define XB_XCNT(j)  (256  + 64 * (j))
#define XB_XSUB(j)  (1280 + 64 * (j))
#define XB_XGEN(j)  (2304 + 64 * (j))
#define XB_TOP      3328
#define XB_TOPGEN   3392
#define XCD_BAR_WORDS 3456
#define XB_SPIN_CAP (1u << 22)
#define LAS __attribute__((address_space(3)))
DI unsigned xb_ld(unsigned* p)              { return __hip_atomic_load(p, __ATOMIC_RELAXED, __HIP_MEMORY_SCOPE_AGENT); }
DI unsigned xb_add(unsigned* p, unsigned v) { return __hip_atomic_fetch_add(p, v, __ATOMIC_RELAXED, __HIP_MEMORY_SCOPE_AGENT); }
DI unsigned xb_xcc_id() { return (unsigned)__builtin_amdgcn_s_getreg((3 << 11) | 20) & 0xFu; }
#define XB_SPIN(cond, bar) do { unsigned _sp = 0; while (cond) { __builtin_amdgcn_s_sleep(1); \
    if ((++_sp & 255u) == 0u) { if (xb_ld(&(bar)[XB_TMO])) break; if (_sp > XB_SPIN_CAP) { atomicAdd(&(bar)[XB_TMO], 1u); break; } } } } while (0)
struct XcdBarrier { unsigned* bar; unsigned x; volatile LAS unsigned* st; };
DI XcdBarrier xcd_barrier_post(unsigned* bar, volatile LAS unsigned* st) {
    XcdBarrier b; b.bar = bar; b.x = xb_xcc_id(); b.st = st;
    if (threadIdx.x == 0) (void)xb_add(&bar[XB_XCNT(b.x)], 1u);
    return b;
}
DI void xcd_barrier_complete(unsigned* bar, unsigned x, unsigned& nloc, unsigned& nx) {
    const unsigned G = gridDim.x * gridDim.y * gridDim.z;
    unsigned sum, cnt, mine, sp = 0u;
    for (;;) {
        sum = 0u; cnt = 0u; mine = 0u;
#pragma unroll
        for (unsigned j = 0; j < 16; ++j) { const unsigned c = xb_ld(&bar[XB_XCNT(j)]); sum += c; cnt += (c > 0u) ? 1u : 0u; mine = (j == x) ? c : mine; }
        if (sum == G) break;
        __builtin_amdgcn_s_sleep(1);
        if ((++sp & 255u) == 0u) { if (xb_ld(&bar[XB_TMO])) break; if (sp > XB_SPIN_CAP) { atomicAdd(&bar[XB_TMO], 1u); break; } }
    }
    nloc = mine > 0u ? mine : 1u; nx = cnt > 0u ? cnt : 1u;
}
DI void xcd_barrier(const XcdBarrier& b) {
    asm volatile("s_waitcnt vmcnt(0)" ::: "memory");
    __syncthreads();
    if (threadIdx.x == 0) {
        unsigned* bar = b.bar;
        __builtin_amdgcn_s_waitcnt(0);
        unsigned nloc = b.st[0], nx = b.st[1];
        if (nloc == 0u) { xcd_barrier_complete(bar, b.x, nloc, nx); b.st[0] = nloc; b.st[1] = nx; }
        const unsigned old = xb_add(&bar[XB_XSUB(b.x)], 1u);
        const unsigned gen = old / nloc;
        if (old + 1u == (gen + 1u) * nloc) {
            __builtin_amdgcn_fence(__ATOMIC_RELEASE, "agent");
            asm volatile("s_waitcnt vmcnt(0)" ::: "memory");
            const unsigned og = xb_add(&bar[XB_TOP], 1u);
            const unsigned tg = og / nx;
            if (og + 1u == (tg + 1u) * nx) xb_add(&bar[XB_TOPGEN], 1u);
            else XB_SPIN(xb_ld(&bar[XB_TOPGEN]) == tg, bar);
            __builtin_amdgcn_fence(__ATOMIC_ACQUIRE, "agent");
            xb_add(&bar[XB_XGEN(b.x)], 1u);
            asm volatile("s_waitcnt vmcnt(0)" ::: "memory");
        } else {
            XB_SPIN(xb_ld(&bar[XB_XGEN(b.x)]) == gen, bar);
            __builtin_amdgcn_fence(__ATOMIC_ACQUIRE, "agent");
            asm volatile("s_waitcnt vmcnt(0)" ::: "memory");
        }
    }
    __syncthreads();
}

extern __shared__ __attribute__((aligned(16))) unsigned char dyn_smem[];

__global__ void __launch_bounds__(512, 2) mega_kernel(Params p) {
    cg::grid_group grid = cg::this_grid();
    volatile LAS unsigned* st = (volatile LAS unsigned*)(dyn_smem + 2 * LDS_BYTES);
    if (threadIdx.x == 0) { st[0] = 0u; st[1] = 0u; st[2] = 0u; st[3] = 0u; }
    __syncthreads();
    XcdBarrier xb = xcd_barrier_post((unsigned*)(p.ws + WS_BAR), st);
    const int nsteps = p.ph_hi;
    const bool single = (p.ph_hi - p.ph_lo) == 1;
    for (int step = p.ph_lo; step < nsteps; ++step) {
        int ph, l;
        if (step == 0) { ph = PH_PRO; l = 0; }
        else { l = (step - 1) / 11; ph = PH_CONV + (step - 1) % 11; }
        if (ph == PH_CONV && l == 0) continue;
        run_phase(p, ph, l, dyn_smem);
#ifdef REPEAT_PH
        if (ph == REPEAT_PH) { xcd_barrier(xb); run_phase(p, ph, l, dyn_smem); }
#endif
        if (single) break;
        if (p.pad == 0x5eed) grid.sync();
        if (step + 1 < nsteps) xcd_barrier(xb);
    }
}

extern "C" void kernel_launch(void* const* d_in, const int* in_sizes, int n_in, void* d_out, int out_size, void* d_ws, size_t ws_size, hipStream_t stream) {
    static int grid = 0;
    if (grid == 0) {
        if (n_in != N_IN || ws_size < WS_END + 256 || out_size != T_TOK * DM) { fprintf(stderr, "kernel_launch: unexpected sizes n_in %d ws %zu (need %zu) out %d\n", n_in, ws_size, (size_t)WS_END, out_size); grid = -1; return; }
        int dev = 0, cus = 0, per_cu = 0;
        (void)hipGetDevice(&dev);
        (void)hipDeviceGetAttribute(&cus, hipDeviceAttributeMultiprocessorCount, dev);
        (void)hipFuncSetAttribute((const void*)mega_kernel, hipFuncAttributeMaxDynamicSharedMemorySize, LDS_ALLOC);
        (void)hipOccupancyMaxActiveBlocksPerMultiprocessor(&per_cu, (const void*)mega_kernel, 512, LDS_ALLOC);
        if (per_cu < 1) fprintf(stderr, "kernel_launch: occupancy query says %d blocks per CU\n", per_cu);
        grid = cus;
        (void)hipGetLastError();
    }
    if (grid < 0) return;
    Params p{};
    for (int i = 0; i < N_IN; ++i) p.in[i] = (const float*)d_in[i];
    p.out = (float*)d_out; p.ws = (unsigned char*)d_ws;
    (void)hipMemsetAsync((unsigned char*)d_ws + WS_BAR, 0, XCD_BAR_WORDS * 4, stream);
    p.ph_lo = 0; p.ph_hi = 1 + NL * 11;
    void* args[] = {&p};
    hipError_t e = hipLaunchCooperativeKernel((const void*)mega_kernel, dim3(grid), dim3(512), args, LDS_ALLOC, stream);
    if (e != hipSuccess) fprintf(stderr, "cooperative launch failed: %s (grid %d)\n", hipGetErrorString(e), grid);
}
```

```cpp
#include <hip/hip_runtime.h>
#include <hip/hip_cooperative_groups.h>
#include <cstdio>
#include <cstdint>
namespace cg = cooperative_groups;

#ifndef MEGA
#define MEGA 1
#endif

typedef unsigned short bf16_t;
typedef short bf16x8 __attribute__((ext_vector_type(8)));
typedef float f32x4 __attribute__((ext_vector_type(4)));
typedef unsigned u32x4 __attribute__((ext_vector_type(4)));
typedef unsigned u32x2 __attribute__((ext_vector_type(2)));

#define DI __device__ __forceinline__
#define MFMA16(a, b, c) __builtin_amdgcn_mfma_f32_16x16x32_bf16((a), (b), (c), 0, 0, 0)

constexpr int T_TOK = 32768, SEQ = 4096, NB = 8, DM = 1024, NL = 4;
constexpr int UC = 3072;
constexpr int INC = 2976;
constexpr int DFF = 2816;
constexpr float EPS = 1e-6f;
constexpr int LDS_BYTES = 73728;
constexpr int LDS_ALLOC = 2 * LDS_BYTES + 16;

constexpr size_t SZ_W = 13533184ull * 2;
constexpr size_t OFF_W = 0;
constexpr size_t OFF_XWKV = OFF_W + SZ_W;
constexpr size_t OFF_XB = OFF_XWKV + 4ull * 512 * 1024 * 2;
constexpr size_t OFF_MEMB = OFF_XB + (size_t)T_TOK * 1024 * 2;
constexpr size_t OFF_U = OFF_MEMB + 2048ull * 1024 * 2;
constexpr size_t OFF_CAT = OFF_U + (size_t)T_TOK * UC * 2;
constexpr size_t OFF_MQ = OFF_CAT + (size_t)T_TOK * 1024 * 2;
constexpr size_t OFF_MK = OFF_MQ + (size_t)T_TOK * 384 * 2;
constexpr size_t OFF_MVT = OFF_MK + (size_t)T_TOK * 384 * 2;
constexpr size_t OFF_HST = OFF_MVT + (size_t)T_TOK * 256 * 2;
constexpr size_t OFF_HDEC = OFF_HST + 64ull * 64 * 4096 * 4;
constexpr size_t OFF_XK = OFF_HDEC + 64ull * 64 * 64 * 4;
constexpr size_t OFF_XVT = OFF_XK + 4ull * 8 * 4 * 256 * 64 * 2;
constexpr size_t OFF_ROPE = OFF_XVT + 4ull * 8 * 4 * 256 * 64 * 2;
constexpr size_t OFF_ROWSQ = OFF_ROPE + (size_t)T_TOK * 16 * 2 * 4;
constexpr size_t OFF_MEMSQ = OFF_ROWSQ + (size_t)T_TOK * 16 * 4;
constexpr size_t OFF_SSQB = OFF_MEMSQ + 2048 * 4;
constexpr size_t OFF_SSQD = OFF_SSQB + (size_t)T_TOK * 4 * 4;
constexpr size_t WS_BAR = OFF_SSQD + (size_t)T_TOK * 4 * 4;
constexpr size_t WS_END = WS_BAR + 16384;
constexpr size_t QRAW_IN_OUT = 0;
constexpr size_t KVRAW_IN_OUT = (size_t)T_TOK * 384 * 2;
constexpr size_t OFF_KVMEM = OFF_MQ;
constexpr size_t OFF_XQ = OFF_U;
constexpr size_t OFF_XO = OFF_U + (size_t)T_TOK * 256 * 2;
constexpr size_t OFF_HFF = OFF_U;
constexpr size_t W_IN = 0, W_OUT = 3145728, W_UQ = 4194304, W_UKV = 4292608, W_XQ = 4358144, W_XO = 4620288, W_13 = 4882432, W_2 = 10649600;

enum { I_X = 0, I_MEM, I_POS, I_GMIX, I_WIN, I_ADWW, I_ADWB, I_ALNG, I_ALNB, I_HGAM, I_HONG, I_CDWW, I_CDWB, I_MQAG, I_MWUQ, I_MKVAG,
       I_MWUKV, I_MQNG, I_MKNG, I_GBR, I_WOUT, I_GXQ, I_GMEM, I_XWQ, I_XWKV, I_XQNG, I_XKNG, I_XWO, I_GFFN, I_W13, I_W2, N_IN };

struct Params {
    const float* in[N_IN];
    float* out;
    unsigned char* ws;
    int ph_lo, ph_hi;
    int layer, pad;
};

typedef __bf16 bf2_t __attribute__((ext_vector_type(2)));
typedef float f2_t __attribute__((ext_vector_type(2)));
DI unsigned cvt_pk(float lo, float hi) { f2_t v = {lo, hi}; bf2_t b = __builtin_convertvector(v, bf2_t); return __builtin_bit_cast(unsigned, b); }
DI bf16_t f2bf(float x) { return (bf16_t)(cvt_pk(x, 0.f) & 0xffffu); }
DI float bf2f(bf16_t h) { return __uint_as_float(((unsigned)h) << 16); }
DI float bflo(unsigned w) { return __uint_as_float(w << 16); }
DI float bfhi(unsigned w) { return __uint_as_float(w & 0xffff0000u); }
DI float sigmoidf_(float x) { return __builtin_amdgcn_rcpf(1.f + __expf(-x)); }
DI int tidx() { int t = threadIdx.x & 255; asm volatile("" : "+v"(t)); return t; }
DI float wave_sum(float v) {
#pragma unroll
    for (int o = 32; o > 0; o >>= 1) v += __shfl_xor(v, o);
    return v;
}

DI int sw_off(int row, int chunk) { return row * 128 + ((chunk ^ ((row >> 1) & 7)) << 4); }

DI void scale_chunk(uint4& v, float s) {
    v.x = cvt_pk(bflo(v.x) * s, bfhi(v.x) * s); v.y = cvt_pk(bflo(v.y) * s, bfhi(v.y) * s);
    v.z = cvt_pk(bflo(v.z) * s, bfhi(v.z) * s); v.w = cvt_pk(bflo(v.w) * s, bfhi(v.w) * s);
}

template <bool ASC>
DI void gemm_mainloop(const bf16_t* __restrict__ A, int lda, const bf16_t* __restrict__ Bt, int K, int row0, int col0,
                      unsigned char* smem, f32x4 (&acc)[4][4]) {
    const int tid = tidx(), lane = tid & 63, w = tid >> 6, wr = w >> 1, wc = w & 1, l15 = lane & 15, quad = lane >> 4;
    const int lr = tid >> 3, lc = tid & 7;
    const bf16_t* Ap = A + (size_t)(row0 + lr) * lda + lc * 8;
    const bf16_t* Bp = Bt + (size_t)(col0 + lr) * K + lc * 8;
    const size_t as1 = (size_t)32 * lda, bs1 = (size_t)32 * K;
    const float* asc = (const float*)(smem + 66048);
    uint4 ra0, ra1, ra2, ra3, rb0, rb1, rb2, rb3;
#define G_LOAD(ko) do { ra0 = *(const uint4*)(Ap + (ko)); ra1 = *(const uint4*)(Ap + as1 + (ko)); ra2 = *(const uint4*)(Ap + 2 * as1 + (ko)); ra3 = *(const uint4*)(Ap + 3 * as1 + (ko)); \
                        rb0 = *(const uint4*)(Bp + (ko)); rb1 = *(const uint4*)(Bp + bs1 + (ko)); rb2 = *(const uint4*)(Bp + 2 * bs1 + (ko)); rb3 = *(const uint4*)(Bp + 3 * bs1 + (ko)); } while (0)
#define G_STORE(buf) do { unsigned char* Ad_ = smem + (buf) * 16384; unsigned char* Bd_ = smem + 32768 + (buf) * 16384; const int o_ = sw_off(lr, lc); \
                          *(uint4*)(Ad_ + o_) = ra0; *(uint4*)(Ad_ + o_ + 4096) = ra1; *(uint4*)(Ad_ + o_ + 8192) = ra2; *(uint4*)(Ad_ + o_ + 12288) = ra3; \
                          *(uint4*)(Bd_ + o_) = rb0; *(uint4*)(Bd_ + o_ + 4096) = rb1; *(uint4*)(Bd_ + o_ + 8192) = rb2; *(uint4*)(Bd_ + o_ + 12288) = rb3; } while (0)
    const int plc = (tid & 7) ^ ((tid >> 4) & 7);
    const bf16_t* Adp = A + (size_t)(row0 + lr) * lda + plc * 8;
    const bf16_t* Bdp = Bt + (size_t)(col0 + lr) * K + plc * 8;
#define D_STAGE(buf, ko) do { _Pragma("unroll") for (int i_ = 0; i_ < 4; ++i_) { \
        __builtin_amdgcn_global_load_lds((const unsigned*)(Adp + i_ * as1 + (ko)), (unsigned*)(smem + (buf) * 16384 + i_ * 4096 + tid * 16), 16, 0, 0); \
        __builtin_amdgcn_global_load_lds((const unsigned*)(Bdp + i_ * bs1 + (ko)), (unsigned*)(smem + 32768 + (buf) * 16384 + i_ * 4096 + tid * 16), 16, 0, 0); } } while (0)
    if (ASC) { G_LOAD(0); } else { D_STAGE(0, 0); }
#pragma unroll
    for (int m = 0; m < 4; ++m)
#pragma unroll
        for (int n = 0; n < 4; ++n) acc[m][n] = (f32x4){0.f, 0.f, 0.f, 0.f};
    if (ASC) { G_STORE(0); }
    __syncthreads();
    const int nk = K >> 6;
    for (int kt = 0; kt < nk; ++kt) {
        const int cur = kt & 1;
        const bool more = (kt + 1 < nk);
        if (more) { const int ko = (kt + 1) * 64; if (ASC) { G_LOAD(ko); } else { D_STAGE(cur ^ 1, ko); } }
        __builtin_amdgcn_sched_barrier(0);
        const unsigned char* As = smem + cur * 16384;
        const unsigned char* Bs = smem + 32768 + cur * 16384;
#pragma unroll
        for (int ks = 0; ks < 2; ++ks) {
            bf16x8 af[4], bfv[4];
#pragma unroll
            for (int m = 0; m < 4; ++m) af[m] = *(const bf16x8*)(As + sw_off(wr * 64 + m * 16 + l15, ks * 4 + quad));
#pragma unroll
            for (int n = 0; n < 4; ++n) bfv[n] = *(const bf16x8*)(Bs + sw_off(wc * 64 + n * 16 + l15, ks * 4 + quad));
#pragma unroll
            for (int m = 0; m < 4; ++m)
#pragma unroll
                for (int n = 0; n < 4; ++n) acc[m][n] = MFMA16(bfv[n], af[m], acc[m][n]);
        }
        __builtin_amdgcn_sched_barrier(0);
        if (ASC && more) {
            const int grp = ((kt + 1) * 64) >> 8;
            if (grp & 1) {
                const int which = grp >> 1;
                scale_chunk(ra0, asc[lr * 2 + which]); scale_chunk(ra1, asc[(lr + 32) * 2 + which]);
                scale_chunk(ra2, asc[(lr + 64) * 2 + which]); scale_chunk(ra3, asc[(lr + 96) * 2 + which]);
            }
            G_STORE(cur ^ 1);
        }
        __syncthreads();
    }
#undef G_LOAD
#undef G_STORE
#undef D_STAGE
}

DI void tile_order(int L, int nM, int nN, int& pm, int& pn) {
    const int nwg = nM * nN;
    int wgid = L;
    { const int q = nwg / 8, r = nwg % 8, xcd = wgid % 8, off = wgid / 8; wgid = (xcd < r ? xcd * (q + 1) : r * (q + 1) + (xcd - r) * q) + off; }
    const int WGM = 8;
    const int nig = WGM * nN, gid = wgid / nig, fm = gid * WGM, gsz = (nM - fm) < WGM ? (nM - fm) : WGM;
    pm = fm + ((wgid % nig) % gsz); pn = (wgid % nig) / gsz;
}

DI void fill_rs(unsigned char* smem, const float* part, int npart, int row0, float inv_n) {
    float* rs = (float*)(smem + 65536);
    const int tid = tidx();
    if (tid < 128) {
        float s = 0.f;
        for (int i = 0; i < npart; ++i) s += part[(size_t)(row0 + tid) * npart + i];
        rs[tid] = __builtin_amdgcn_rsqf(s * inv_n + EPS);
    }
}

DI void epi_bf16(const f32x4 (&acc)[4][4], bf16_t* O, int ldo, int row0, int col0, const float* rs) {
    const int lane = tidx() & 63, w = tidx() >> 6, wr = w >> 1, wc = w & 1, l15 = lane & 15, quad = lane >> 4;
#pragma unroll
    for (int m = 0; m < 4; ++m) {
        const int rl = wr * 64 + m * 16 + l15;
        const float sc = rs ? rs[rl] : 1.f;
        bf16_t* rowp = O + (size_t)(row0 + rl) * ldo + col0 + wc * 64 + quad * 4;
#pragma unroll
        for (int n = 0; n < 4; ++n) {
            u32x2 v; v.x = cvt_pk(acc[m][n][0] * sc, acc[m][n][1] * sc); v.y = cvt_pk(acc[m][n][2] * sc, acc[m][n][3] * sc);
            *(u32x2*)(rowp + n * 16) = v;
        }
    }
}
DI void epi_resid(const f32x4 (&acc)[4][4], float* X, bf16_t* XB, float* rowsq, int row0, int col0) {
    const int lane = tidx() & 63, w = tidx() >> 6, wr = w >> 1, wc = w & 1, l15 = lane & 15, quad = lane >> 4;
    const int pn = col0 >> 7;
#pragma unroll
    for (int m = 0; m < 4; ++m) {
        const int row = row0 + wr * 64 + m * 16 + l15;
        float ss = 0.f;
#pragma unroll
        for (int n = 0; n < 4; ++n) {
            const int col = col0 + wc * 64 + n * 16 + quad * 4;
            float4* xp = (float4*)(X + (size_t)row * DM + col);
            float4 xv = *xp;
            xv.x += acc[m][n][0]; xv.y += acc[m][n][1]; xv.z += acc[m][n][2]; xv.w += acc[m][n][3];
            *xp = xv;
            u32x2 v; v.x = cvt_pk(xv.x, xv.y); v.y = cvt_pk(xv.z, xv.w);
            *(u32x2*)(XB + (size_t)row * DM + col) = v;
            ss += xv.x * xv.x + xv.y * xv.y + xv.z * xv.z + xv.w * xv.w;
        }
        ss += __shfl_xor(ss, 16); ss += __shfl_xor(ss, 32);
        if (quad == 0) rowsq[(size_t)row * 16 + pn * 2 + wc] = ss;
    }
}
DI void epi_swiglu(const f32x4 (&acc)[4][4], bf16_t* H, int row0, int col0, const float* rs) {
    const int lane = tidx() & 63, w = tidx() >> 6, wr = w >> 1, wc = w & 1, l15 = lane & 15, quad = lane >> 4;
#pragma unroll
    for (int m = 0; m < 4; ++m) {
        const int rl = wr * 64 + m * 16 + l15;
        const float sc = rs[rl];
        bf16_t* rowp = H + (size_t)(row0 + rl) * DFF + ((col0 + wc * 64) >> 1) + quad * 4;
#pragma unroll
        for (int np = 0; np < 2; ++np) {
            float h[4];
#pragma unroll
            for (int j = 0; j < 4; ++j) { const float a1 = acc[m][2 * np][j] * sc, a3 = acc[m][2 * np + 1][j] * sc; h[j] = a1 * sigmoidf_(a1) * a3; }
            u32x2 v; v.x = cvt_pk(h[0], h[1]); v.y = cvt_pk(h[2], h[3]);
            *(u32x2*)(rowp + np * 16) = v;
        }
    }
}

DI void conv_tile(const float* __restrict__ src, int K, int N, int Npad, const float* __restrict__ gain, int perm, bf16_t* __restrict__ dst, int tile, unsigned char* smem) {
    float* lds = (float*)smem;
    const int nkt = K >> 6, kt = tile % nkt, nt = tile / nkt, k0 = kt * 64, n0 = nt * 64;
    const int tid = tidx(), nl = tid & 63, kq = tid >> 6;
    const int R = n0 + nl;
    int sc = R;
    if (perm == 1) { const int g = R >> 5, j = R & 31; sc = (j < 16) ? (16 * g + j) : (DFF + 16 * g + j - 16); }
    const bool ok = R < N;
#pragma unroll
    for (int i = 0; i < 16; ++i) { const int kl = kq + 4 * i; lds[kl * 65 + nl] = ok ? src[(size_t)(k0 + kl) * N + sc] : 0.f; }
    __syncthreads();
    const int kc = tid & 7, nr = tid >> 3;
    int kd0 = k0;
    if (perm == 2) { const int g = k0 >> 8; const int gm = (g == 0) ? 2 : (g == 1) ? 0 : (g == 2) ? 3 : 1; kd0 = gm * 256 + (k0 & 255); }
    float g8[8];
#pragma unroll
    for (int j = 0; j < 8; ++j) g8[j] = gain ? gain[k0 + kc * 8 + j] : 1.f;
#pragma unroll
    for (int i = 0; i < 2; ++i) {
        const int nl2 = nr + 32 * i;
        float v[8];
#pragma unroll
        for (int j = 0; j < 8; ++j) v[j] = lds[(kc * 8 + j) * 65 + nl2] * g8[j];
        uint4 o; o.x = cvt_pk(v[0], v[1]); o.y = cvt_pk(v[2], v[3]); o.z = cvt_pk(v[4], v[5]); o.w = cvt_pk(v[6], v[7]);
        *(uint4*)(dst + (size_t)(n0 + nl2) * K + kd0 + kc * 8) = o;
    }
    __syncthreads();
}

constexpr int CONV_TILES = 768 + 256 + 24 + 16 + 64 + 64 + 1408 + 704;
DI void conv_layer_item(const Params& p, int l, int it, unsigned char* smem) {
    bf16_t* W = (bf16_t*)(p.ws + OFF_W);
    if (it < 768) { conv_tile(p.in[I_WIN] + (size_t)l * DM * INC, DM, INC, UC, p.in[I_GMIX] + l * DM, 0, W + W_IN, it, smem); return; } it -= 768;
    if (it < 256) { conv_tile(p.in[I_WOUT] + (size_t)l * DM * DM, DM, DM, DM, p.in[I_GBR] + l * DM, 2, W + W_OUT, it, smem); return; } it -= 256;
    if (it < 24) { conv_tile(p.in[I_MWUQ] + (size_t)l * 256 * 384, 256, 384, 384, p.in[I_MQAG] + l * 256, 0, W + W_UQ, it, smem); return; } it -= 24;
    if (it < 16) { conv_tile(p.in[I_MWUKV] + (size_t)l * 128 * 512, 128, 512, 512, p.in[I_MKVAG] + l * 128, 0, W + W_UKV, it, smem); return; } it -= 16;
    if (it < 64) { conv_tile(p.in[I_XWQ] + (size_t)l * DM * 256, DM, 256, 256, p.in[I_GXQ] + l * DM, 0, W + W_XQ, it, smem); return; } it -= 64;
    if (it < 64) { conv_tile(p.in[I_XWO] + (size_t)l * 256 * DM, 256, DM, DM, nullptr, 0, W + W_XO, it, smem); return; } it -= 64;
    if (it < 1408) { conv_tile(p.in[I_W13] + (size_t)l * DM * 2 * DFF, DM, 2 * DFF, 2 * DFF, p.in[I_GFFN] + l * DM, 1, W + W_13, it, smem); return; } it -= 1408;
    conv_tile(p.in[I_W2] + (size_t)l * DFF * DM, DFF, DM, DM, nullptr, 0, W + W_2, it, smem);
}

DI void pro_rows(const float* __restrict__ src, float* __restrict__ cpy, bf16_t* __restrict__ dstb, float* __restrict__ sq, int sqstride, int item) {
    const int w = tidx() >> 6, lane = tidx() & 63;
    for (int r = 0; r < 4; ++r) {
        const int row = item * 16 + w * 4 + r;
        const float4* s4 = (const float4*)(src + (size_t)row * DM);
        float s = 0.f;
#pragma unroll
        for (int i = 0; i < 4; ++i) {
            const float4 v = s4[lane + 64 * i];
            if (cpy) ((float4*)(cpy + (size_t)row * DM))[lane + 64 * i] = v;
            u32x2 o; o.x = cvt_pk(v.x, v.y); o.y = cvt_pk(v.z, v.w);
            *(u32x2*)(dstb + (size_t)row * DM + (lane + 64 * i) * 4) = o;
            s += v.x * v.x + v.y * v.y + v.z * v.z + v.w * v.w;
        }
        s = wave_sum(s);
        if (lane < sqstride) sq[(size_t)row * sqstride + lane] = (lane == 0) ? s : 0.f;
    }
}
DI void pro_rope(const Params& p, int item) {
    const int tok = item * 256 + tidx();
    const int* pos = (const int*)p.in[I_POS];
    float* cs = (float*)(p.ws + OFF_ROPE);
    float* sn = cs + (size_t)T_TOK * 16;
    const float pf = (float)pos[tok];
#pragma unroll
    for (int i = 0; i < 16; ++i) {
        const float inv = powf(10000.0f, -(float)(2 * i) / 32.0f);
        const float ang = pf * inv;
        cs[(size_t)tok * 16 + i] = cosf(ang);
        sn[(size_t)tok * 16 + i] = sinf(ang);
    }
}

DI void conformer_tile(const Params& p, int l, int tile, unsigned char* smem) {
    float* hs = (float*)smem;
    const bf16_t* U = (const bf16_t*)(p.ws + OFF_U);
    bf16_t* CAT = (bf16_t*)(p.ws + OFF_CAT);
    const int tid = tidx(), b = tile >> 7, t0 = (tile & 127) * 32;
    {
        const int c2 = (tid & 127) * 2, half = tid >> 7;
        for (int r0 = half; r0 < 62; r0 += 32) {
            unsigned av[16], gv[16];
#pragma unroll
            for (int k = 0; k < 16; ++k) {
                const int r = r0 + 2 * k, t = t0 - 15 + r;
                av[k] = 0u; gv[k] = 0u;
                if (r < 62 && t >= 0 && t < SEQ) {
                    const bf16_t* up = U + (size_t)(b * SEQ + t) * UC;
                    av[k] = *(const unsigned*)(up + c2); gv[k] = *(const unsigned*)(up + 256 + c2);
                }
            }
#pragma unroll
            for (int k = 0; k < 16; ++k) {
                const int r = r0 + 2 * k;
                if (r < 62) {
                    hs[r * 256 + c2] = bflo(av[k]) * sigmoidf_(bflo(gv[k]));
                    hs[r * 256 + c2 + 1] = bfhi(av[k]) * sigmoidf_(bfhi(gv[k]));
                }
            }
        }
    }
    __syncthreads();
    {
        const int c = tid;
        float wv[31];
        const float* wp = p.in[I_ADWW] + (size_t)l * 31 * 256 + c;
#pragma unroll
        for (int j = 0; j < 31; ++j) wv[j] = wp[j * 256];
        const float bias = p.in[I_ADWB][l * 256 + c];
        for (int t = 0; t < 32; ++t) {
            float y = bias;
#pragma unroll
            for (int j = 0; j < 31; ++j) y += wv[j] * hs[(t + j) * 256 + c];
            hs[t * 256 + c] = y;
        }
    }
    __syncthreads();
    {
        const int w = tid >> 6, lane = tid & 63;
        const float4 g4 = *(const float4*)(p.in[I_ALNG] + l * 256 + lane * 4), b4 = *(const float4*)(p.in[I_ALNB] + l * 256 + lane * 4);
        for (int r = 0; r < 8; ++r) {
            const int t = w * 8 + r;
            float4 v = *(const float4*)(hs + t * 256 + lane * 4);
            const float mu = wave_sum(v.x + v.y + v.z + v.w) * (1.f / 256.f);
            v.x -= mu; v.y -= mu; v.z -= mu; v.w -= mu;
            const float var = wave_sum(v.x * v.x + v.y * v.y + v.z * v.z + v.w * v.w) * (1.f / 256.f);
            const float rstd = __builtin_amdgcn_rsqf(var + EPS);
            float y0 = v.x * rstd * g4.x + b4.x, y1 = v.y * rstd * g4.y + b4.y, y2 = v.z * rstd * g4.z + b4.z, y3 = v.w * rstd * g4.w + b4.w;
            y0 *= sigmoidf_(y0); y1 *= sigmoidf_(y1); y2 *= sigmoidf_(y2); y3 *= sigmoidf_(y3);
            const float ss = wave_sum(y0 * y0 + y1 * y1 + y2 * y2 + y3 * y3);
            const float rb = __builtin_amdgcn_rsqf(ss * (1.f / 256.f) + EPS);
            u32x2 o; o.x = cvt_pk(y0 * rb, y1 * rb); o.y = cvt_pk(y2 * rb, y3 * rb);
            *(u32x2*)(CAT + (size_t)(b * SEQ + t0 + t) * DM + 512 + lane * 4) = o;
        }
    }
    __syncthreads();
}

DI void shortconv_tile(const Params& p, int l, int tile) {
    const bf16_t* U = (const bf16_t*)(p.ws + OFF_U);
    bf16_t* CAT = (bf16_t*)(p.ws + OFF_CAT);
    const int w = tidx() >> 6, lane = tidx() & 63, c = lane * 4;
    const float* wp = p.in[I_CDWW] + (size_t)l * 3 * 256 + c;
    const float4 w0 = *(const float4*)(wp), w1 = *(const float4*)(wp + 256), w2 = *(const float4*)(wp + 512);
    const float4 bb = *(const float4*)(p.in[I_CDWB] + l * 256 + c);
#pragma unroll 4
    for (int r = 0; r < 16; ++r) {
        const int tok = tile * 64 + w * 16 + r, s = tok & (SEQ - 1);
        float pr[3][4];
#pragma unroll
        for (int j = 0; j < 3; ++j) {
            const int sj = s + j - 1;
            if (sj >= 0 && sj < SEQ) {
                const bf16_t* up = U + (size_t)(tok + j - 1) * UC;
                const u32x2 gc = *(const u32x2*)(up + 2048 + c), xi = *(const u32x2*)(up + 2304 + c);
                pr[j][0] = bflo(gc.x) * bflo(xi.x); pr[j][1] = bfhi(gc.x) * bfhi(xi.x); pr[j][2] = bflo(gc.y) * bflo(xi.y); pr[j][3] = bfhi(gc.y) * bfhi(xi.y);
            } else { pr[j][0] = pr[j][1] = pr[j][2] = pr[j][3] = 0.f; }
        }
        const u32x2 gb = *(const u32x2*)(U + (size_t)tok * UC + 1792 + c);
        const float y0 = bflo(gb.x) * (bb.x + w0.x * pr[0][0] + w1.x * pr[1][0] + w2.x * pr[2][0]);
        const float y1 = bfhi(gb.x) * (bb.y + w0.y * pr[0][1] + w1.y * pr[1][1] + w2.y * pr[2][1]);
        const float y2 = bflo(gb.y) * (bb.z + w0.z * pr[0][2] + w1.z * pr[1][2] + w2.z * pr[2][2]);
        const float y3 = bfhi(gb.y) * (bb.w + w0.w * pr[0][3] + w1.w * pr[1][3] + w2.w * pr[2][3]);
        const float ss = wave_sum(y0 * y0 + y1 * y1 + y2 * y2 + y3 * y3);
        const float rb = __builtin_amdgcn_rsqf(ss * (1.f / 256.f) + EPS);
        u32x2 o; o.x = cvt_pk(y0 * rb, y1 * rb); o.y = cvt_pk(y2 * rb, y3 * rb);
        *(u32x2*)(CAT + (size_t)tok * DM + 768 + c) = o;
    }
}

DI float hgrn_lower(const Params& p, int l, int dir, int ch) {
    const float* g = p.in[I_HGAM] + (size_t)dir * NL * 256 + ch;
    const float g0 = g[0], g1 = g[256], g2 = g[512], g3 = g[768];
    const float mx = fmaxf(fmaxf(g0, g1), fmaxf(g2, g3));
    const float e0 = __expf(g0 - mx), e1 = __expf(g1 - mx), e2 = __expf(g2 - mx), e3 = __expf(g3 - mx);
    const float inv = 1.f / (e0 + e1 + e2 + e3);
    float lb = 0.f;
    if (l >= 1) lb += e1; if (l >= 2) lb += e2; if (l >= 3) lb += e3;
    return lb * inv;
}

DI void hgrn_local_tile(const Params& p, int l, int item, unsigned char* smem) {
    const bf16_t* U = (const bf16_t*)(p.ws + OFF_U);
    bf16_t* HST = (bf16_t*)(p.ws + OFF_HST);
    float* HDEC = (float*)(p.ws + OFF_HDEC);
    const int dir = item >> 9, b = (item >> 6) & 7, c = item & 63;
    const int h = tidx() >> 6, lane = tidx() & 63, l15 = lane & 15, quad = lane >> 4;
    bf16_t* kT = (bf16_t*)(smem + h * 18432);
    bf16_t* vT = kT + 64 * 72;
    const float lb = hgrn_lower(p, l, dir, h * 64 + lane);
    const int tokbase = b * SEQ + c * 64;
    const bf16_t* zp = U + (size_t)tokbase * UC + 768 + dir * 256 + h * 64 + lane;
    const bf16_t* vp = U + (size_t)tokbase * UC + 1280 + h * 64 + lane;
    float suf = 0.f;
    {
        const int step = dir ? UC : -UC, di = dir ? 1 : -1;
        int i = dir ? 0 : 63;
        zp += (size_t)i * UC; vp += (size_t)i * UC;
        bf16_t* kw = kT + lane * 72 + i; bf16_t* vw = vT + lane * 72 + i;
        for (int hb = 0; hb < 2; ++hb) {
            bf16_t zz[32], vv[32];
#pragma unroll
            for (int ii = 0; ii < 32; ++ii) { zz[ii] = zp[(ptrdiff_t)ii * step]; vv[ii] = vp[(ptrdiff_t)ii * step]; }
            zp += (ptrdiff_t)32 * step; vp += (ptrdiff_t)32 * step;
#pragma unroll
            for (int ii = 0; ii < 32; ++ii) {
                const float z = bf2f(zz[ii]);
                const float sg = sigmoidf_(z), f = sg + lb * (1.f - sg), kk = (1.f - lb) * (1.f - sg);
                kw[ii * di] = f2bf(kk * __expf(suf));
                vw[ii * di] = vv[ii];
                suf += __logf(f);
            }
            kw += 32 * di; vw += 32 * di;
        }
    }
    const int seq = (dir * 8 + b) * 4 + h, cs = dir ? 63 - c : c;
    HDEC[((size_t)seq * 64 + cs) * 64 + lane] = __expf(suf);
    __syncthreads();
    f32x4 acc[4][4];
#pragma unroll
    for (int et = 0; et < 4; ++et)
#pragma unroll
        for (int dt = 0; dt < 4; ++dt) acc[et][dt] = (f32x4){0.f, 0.f, 0.f, 0.f};
#pragma unroll
    for (int ks = 0; ks < 2; ++ks) {
        bf16x8 av[4], bk[4];
#pragma unroll
        for (int t = 0; t < 4; ++t) {
            av[t] = *(const bf16x8*)(vT + (t * 16 + l15) * 72 + ks * 32 + quad * 8);
            bk[t] = *(const bf16x8*)(kT + (t * 16 + l15) * 72 + ks * 32 + quad * 8);
        }
#pragma unroll
        for (int et = 0; et < 4; ++et)
#pragma unroll
            for (int dt = 0; dt < 4; ++dt) acc[et][dt] = MFMA16(bk[dt], av[et], acc[et][dt]);
    }
    bf16_t* sp = HST + ((size_t)seq * 64 + cs) * 4096;
#pragma unroll
    for (int et = 0; et < 4; ++et)
#pragma unroll
        for (int dt = 0; dt < 4; ++dt) {
            u32x2 v; v.x = cvt_pk(acc[et][dt][0], acc[et][dt][1]); v.y = cvt_pk(acc[et][dt][2], acc[et][dt][3]);
            *(u32x2*)(sp + (et * 16 + l15) * 64 + dt * 16 + quad * 4) = v;
        }
    __syncthreads();
}

DI void hgrn_scan_item(const Params& p, int item) {
    unsigned* HSTU = (unsigned*)(p.ws + OFF_HST);
    const float* HDEC = (const float*)(p.ws + OFF_HDEC);
    const int gid = item * 256 + tidx(), seq = gid >> 11, pr = gid & 2047, d = (pr * 2) & 63;
    unsigned* sp = HSTU + (size_t)seq * 64 * 2048 + pr;
    const float* dp = HDEC + (size_t)seq * 64 * 64 + d;
    float s0 = 0.f, s1 = 0.f;
    for (int c0 = 0; c0 < 64; c0 += 8) {
        unsigned loc[8]; float2 dec[8];
#pragma unroll
        for (int j = 0; j < 8; ++j) { loc[j] = sp[(size_t)(c0 + j) * 2048]; dec[j] = *(const float2*)(dp + (c0 + j) * 64); }
#pragma unroll
        for (int j = 0; j < 8; ++j) { sp[(size_t)(c0 + j) * 2048] = cvt_pk(s0, s1); s0 = dec[j].x * s0 + bflo(loc[j]); s1 = dec[j].y * s1 + bfhi(loc[j]); }
    }
}

DI bf16x8 hg_frag(const bf16_t* qk, const float* bc, const float* ref, bool qside) {
    const uint4 x = *(const uint4*)qk;
    const float4 b0 = *(const float4*)bc, b1 = *(const float4*)(bc + 4);
    float4 r0 = {0.f, 0.f, 0.f, 0.f}, r1 = {0.f, 0.f, 0.f, 0.f};
    if (ref) { r0 = *(const float4*)ref; r1 = *(const float4*)(ref + 4); }
    float e[8] = {b0.x - r0.x, b0.y - r0.y, b0.z - r0.z, b0.w - r0.w, b1.x - r1.x, b1.y - r1.y, b1.z - r1.z, b1.w - r1.w};
    if (!qside) {
#pragma unroll
        for (int j = 0; j < 8; ++j) e[j] = -e[j];
    }
    u32x4 o;
    o.x = cvt_pk(bflo(x.x) * __expf(e[0]), bfhi(x.x) * __expf(e[1]));
    o.y = cvt_pk(bflo(x.y) * __expf(e[2]), bfhi(x.y) * __expf(e[3]));
    o.z = cvt_pk(bflo(x.z) * __expf(e[4]), bfhi(x.z) * __expf(e[5]));
    o.w = cvt_pk(bflo(x.w) * __expf(e[6]), bfhi(x.w) * __expf(e[7]));
    return __builtin_bit_cast(bf16x8, o);
}

DI void hgrn_out_tile(const Params& p, int l, int item, unsigned char* smem) {
    const bf16_t* U = (const bf16_t*)(p.ws + OFF_U);
    const bf16_t* HST = (const bf16_t*)(p.ws + OFF_HST);
    bf16_t* CAT = (bf16_t*)(p.ws + OFF_CAT);
    float* SSQB = (float*)(p.ws + OFF_SSQB);
    const int h = item & 3, c = (item >> 2) & 63, b = item >> 8;
    const int w = tidx() >> 6, lane = tidx() & 63, l15 = lane & 15, quad = lane >> 4;
    float* bc = (float*)smem;
    bf16_t* kk = (bf16_t*)(smem + 34816);
    bf16_t* qq = (bf16_t*)(smem + 34816 + 18432);
    bf16_t* vT = (bf16_t*)(smem + 34816 + 18432 + 9216);
    const int tokbase = b * SEQ + c * 64;
    u32x4 sfr[2][4];
    {
        const int dirp = w & 1;
        const int seqp = (dirp * 8 + b) * 4 + h, csp = dirp ? 63 - c : c;
        const bf16_t* sinp = HST + ((size_t)seqp * 64 + csp) * 4096;
#pragma unroll
        for (int ks = 0; ks < 2; ++ks)
#pragma unroll
            for (int et = 0; et < 4; ++et) sfr[ks][et] = *(const u32x4*)(sinp + (et * 16 + l15) * 64 + ks * 32 + quad * 8);
    }
    if (w < 2) {
        const int dir = w;
        const float lb = hgrn_lower(p, l, dir, h * 64 + lane);
        const bf16_t* zp = U + (size_t)tokbase * UC + 768 + dir * 256 + h * 64 + lane;
        float run = 0.f;
        const int step = dir ? -UC : UC, di = dir ? -1 : 1;
        int i = dir ? 63 : 0;
        zp += (size_t)i * UC;
        float* bw = bc + (dir * 64 + i) * 68 + lane; bf16_t* kw = kk + (dir * 64 + i) * 72 + lane;
        {
            bf16_t zz[64];
#pragma unroll
            for (int ii = 0; ii < 64; ++ii) zz[ii] = zp[(ptrdiff_t)ii * step];
#pragma unroll
            for (int ii = 0; ii < 64; ++ii) {
                const float z = bf2f(zz[ii]);
                const float sg = sigmoidf_(z), f = sg + lb * (1.f - sg);
                run += __logf(f);
                bw[ii * di * 68] = run; kw[ii * di * 72] = f2bf((1.f - lb) * (1.f - sg));
            }
        }
    } else if (w == 2) {
        const bf16_t* qp = U + (size_t)tokbase * UC + 512 + h * 64 + lane;
        {
            bf16_t t[64];
#pragma unroll
            for (int i = 0; i < 64; ++i) t[i] = qp[(size_t)i * UC];
#pragma unroll
            for (int i = 0; i < 64; ++i) qq[i * 72 + lane] = t[i];
        }
    } else {
        const bf16_t* vp = U + (size_t)tokbase * UC + 1280 + h * 64 + lane;
        {
            bf16_t t[64];
#pragma unroll
            for (int i = 0; i < 64; ++i) t[i] = vp[(size_t)i * UC];
#pragma unroll
            for (int i = 0; i < 64; ++i) vT[lane * 72 + i] = t[i];
        }
    }
    __syncthreads();
    const int dir = w & 1, iset = w >> 1;
    const int seq = (dir * 8 + b) * 4 + h, cs = dir ? 63 - c : c;
    const float* bcd = bc + dir * 64 * 68;
    const bf16_t* kkd = kk + dir * 64 * 72;
    f32x4 o[4][2];
#pragma unroll
    for (int et = 0; et < 4; ++et) { o[et][0] = (f32x4){0.f, 0.f, 0.f, 0.f}; o[et][1] = (f32x4){0.f, 0.f, 0.f, 0.f}; }
#pragma unroll
    for (int ii = 0; ii < 2; ++ii) {
        const int I = iset == 0 ? (ii == 0 ? 0 : 3) : (ii == 0 ? 1 : 2);
        const int irow = 16 * I + l15;
#pragma unroll
        for (int ks = 0; ks < 2; ++ks) {
            const int d0 = ks * 32 + quad * 8;
            const bf16x8 bq = hg_frag(qq + irow * 72 + d0, bcd + irow * 68 + d0, nullptr, true);
#pragma unroll
            for (int et = 0; et < 4; ++et) o[et][ii] = MFMA16(__builtin_bit_cast(bf16x8, sfr[ks][et]), bq, o[et][ii]);
        }
#pragma unroll
        for (int kk2 = 0; kk2 < 2; ++kk2) {
            f32x4 at[2];
            bool any = false;
#pragma unroll
            for (int jj = 0; jj < 2; ++jj) {
                const int J = 2 * kk2 + jj;
                at[jj] = (f32x4){0.f, 0.f, 0.f, 0.f};
                const bool active = dir == 0 ? (J <= I) : (J >= I);
                if (active) {
                    any = true;
                    const float* ref = nullptr;
                    if (dir == 0) { if (J > 0) ref = bcd + (16 * J - 1) * 68; } else { if (J < 3) ref = bcd + (16 * J + 16) * 68; }
                    const int srow = 16 * J + l15;
#pragma unroll
                    for (int ks = 0; ks < 2; ++ks) {
                        const int d0 = ks * 32 + quad * 8;
                        const bf16x8 ak = hg_frag(kkd + srow * 72 + d0, bcd + srow * 68 + d0, ref ? ref + d0 : nullptr, false);
                        const bf16x8 bq = hg_frag(qq + irow * 72 + d0, bcd + irow * 68 + d0, ref ? ref + d0 : nullptr, true);
                        at[jj] = MFMA16(ak, bq, at[jj]);
                    }
                    if (J == I) {
#pragma unroll
                        for (int r = 0; r < 4; ++r) {
                            const int sl = quad * 4 + r;
                            const bool keep = dir == 0 ? (sl <= l15) : (sl >= l15);
                            if (!keep) at[jj][r] = 0.f;
                        }
                    }
                }
            }
            if (any) {
                u32x4 pbw; pbw.x = cvt_pk(at[0][0], at[0][1]); pbw.y = cvt_pk(at[0][2], at[0][3]); pbw.z = cvt_pk(at[1][0], at[1][1]); pbw.w = cvt_pk(at[1][2], at[1][3]);
                const bf16x8 pb = __builtin_bit_cast(bf16x8, pbw);
#pragma unroll
                for (int et = 0; et < 4; ++et) {
                    const bf16_t* vp = vT + (et * 16 + l15) * 72 + kk2 * 32 + quad * 4;
                    const u32x2 lo = *(const u32x2*)vp, hi = *(const u32x2*)(vp + 16);
                    u32x4 a; a.x = lo.x; a.y = lo.y; a.z = hi.x; a.w = hi.y;
                    o[et][ii] = MFMA16(__builtin_bit_cast(bf16x8, a), pb, o[et][ii]);
                }
            }
        }
    }
    __syncthreads();
    float* ob = (float*)smem;
    if (dir == 1) {
#pragma unroll
        for (int ii = 0; ii < 2; ++ii) {
            const int I = iset == 0 ? (ii == 0 ? 0 : 3) : (ii == 0 ? 1 : 2);
#pragma unroll
            for (int et = 0; et < 4; ++et) *(f32x4*)(ob + (16 * I + l15) * 68 + et * 16 + quad * 4) = o[et][ii];
        }
    }
    __syncthreads();
    if (dir == 0) {
#pragma unroll
        for (int ii = 0; ii < 2; ++ii) {
            const int I = iset == 0 ? (ii == 0 ? 0 : 3) : (ii == 0 ? 1 : 2);
            const int tok = tokbase + 16 * I + l15;
            float ss = 0.f;
#pragma unroll
            for (int et = 0; et < 4; ++et) {
                o[et][ii] += *(const f32x4*)(ob + (16 * I + l15) * 68 + et * 16 + quad * 4);
                ss += o[et][ii][0] * o[et][ii][0] + o[et][ii][1] * o[et][ii][1] + o[et][ii][2] * o[et][ii][2] + o[et][ii][3] * o[et][ii][3];
            }
            ss += __shfl_xor(ss, 16); ss += __shfl_xor(ss, 32);
            const float rh = __builtin_amdgcn_rsqf(ss * (1.f / 64.f) + EPS);
            float ssy = 0.f;
#pragma unroll
            for (int et = 0; et < 4; ++et) {
                const int e = et * 16 + quad * 4;
                const u32x2 gg = *(const u32x2*)(U + (size_t)tok * UC + 1536 + h * 64 + e);
                const float4 og = *(const float4*)(p.in[I_HONG] + l * 256 + h * 64 + e);
                const float g0 = bflo(gg.x), g1 = bfhi(gg.x), g2 = bflo(gg.y), g3 = bfhi(gg.y);
                const float y0 = o[et][ii][0] * rh * og.x * g0 * sigmoidf_(g0), y1 = o[et][ii][1] * rh * og.y * g1 * sigmoidf_(g1);
                const float y2 = o[et][ii][2] * rh * og.z * g2 * sigmoidf_(g2), y3 = o[et][ii][3] * rh * og.w * g3 * sigmoidf_(g3);
                ssy += y0 * y0 + y1 * y1 + y2 * y2 + y3 * y3;
                u32x2 ov; ov.x = cvt_pk(y0, y1); ov.y = cvt_pk(y2, y3);
                *(u32x2*)(CAT + (size_t)tok * DM + h * 64 + e) = ov;
            }
            ssy += __shfl_xor(ssy, 16); ssy += __shfl_xor(ssy, 32);
            if (quad == 0) SSQB[(size_t)tok * 4 + h] = ssy;
        }
    }
    __syncthreads();
}

DI void mla_finish_tile(const Params& p, int l, int item, unsigned char* smem) {
    const bf16_t* U = (const bf16_t*)(p.ws + OFF_U);
    const bf16_t* QR = (const bf16_t*)((const unsigned char*)p.out + QRAW_IN_OUT);
    const bf16_t* KVR = (const bf16_t*)((const unsigned char*)p.out + KVRAW_IN_OUT);
    bf16_t* MQ = (bf16_t*)(p.ws + OFF_MQ);
    bf16_t* MK = (bf16_t*)(p.ws + OFF_MK);
    bf16_t* MVT = (bf16_t*)(p.ws + OFF_MVT);
    const float* CS = (const float*)(p.ws + OFF_ROPE);
    const float* SN = CS + (size_t)T_TOK * 16;
    bf16_t* vbuf = (bf16_t*)smem;
    const int w = tidx() >> 6, lane = tidx() & 63, h = lane >> 4, j = lane & 15;
    const float4 qg = *(const float4*)(p.in[I_MQNG] + l * 96 + 4 * j), kg = *(const float4*)(p.in[I_MKNG] + l * 96 + 4 * j);
    const float qg1 = p.in[I_MQNG][l * 96 + 64 + j], qg2 = p.in[I_MQNG][l * 96 + 80 + j];
    const float kg1 = p.in[I_MKNG][l * 96 + 64 + j], kg2 = p.in[I_MKNG][l * 96 + 80 + j];
#pragma unroll 4
    for (int r = 0; r < 16; ++r) {
        const int tl = w * 16 + r, tok = item * 64 + tl;
        const bf16_t* up = U + (size_t)tok * UC;
        float sq, skv;
        { const u32x2 a = *(const u32x2*)(up + 2560 + lane * 4);
          const float a0 = bflo(a.x), a1 = bfhi(a.x), a2 = bflo(a.y), a3 = bfhi(a.y);
          sq = __builtin_amdgcn_rsqf(wave_sum(a0 * a0 + a1 * a1 + a2 * a2 + a3 * a3) * (1.f / 256.f) + EPS);
          const unsigned c = *(const unsigned*)(up + 2816 + lane * 2);
          const float c0 = bflo(c), c1 = bfhi(c);
          skv = __builtin_amdgcn_rsqf(wave_sum(c0 * c0 + c1 * c1) * (1.f / 128.f) + EPS); }
        const float cs = CS[(size_t)tok * 16 + j], sn = SN[(size_t)tok * 16 + j];
        {
            const bf16_t* qp = QR + (size_t)tok * 384 + h * 96;
            const u32x2 a = *(const u32x2*)(qp + 4 * j);
            float q0 = bflo(a.x) * sq, q1 = bfhi(a.x) * sq, q2 = bflo(a.y) * sq, q3 = bfhi(a.y) * sq;
            float x1 = bf2f(qp[64 + j]) * sq, x2 = bf2f(qp[80 + j]) * sq;
            float ss = q0 * q0 + q1 * q1 + q2 * q2 + q3 * q3 + x1 * x1 + x2 * x2;
            ss += __shfl_xor(ss, 1); ss += __shfl_xor(ss, 2); ss += __shfl_xor(ss, 4); ss += __shfl_xor(ss, 8);
            const float rn = __builtin_amdgcn_rsqf(ss * (1.f / 96.f) + EPS);
            q0 *= rn * qg.x; q1 *= rn * qg.y; q2 *= rn * qg.z; q3 *= rn * qg.w; x1 *= rn * qg1; x2 *= rn * qg2;
            bf16_t* op = MQ + (size_t)tok * 384 + h * 96;
            u32x2 ov; ov.x = cvt_pk(q0, q1); ov.y = cvt_pk(q2, q3);
            *(u32x2*)(op + 4 * j) = ov;
            op[64 + j] = f2bf(x1 * cs - x2 * sn); op[80 + j] = f2bf(x2 * cs + x1 * sn);
        }
        {
            const bf16_t* kp = KVR + (size_t)tok * 512 + h * 128;
            const u32x2 a = *(const u32x2*)(kp + 4 * j);
            float k0 = bflo(a.x) * skv, k1 = bfhi(a.x) * skv, k2 = bflo(a.y) * skv, k3 = bfhi(a.y) * skv;
            float x1 = bf2f(up[2944 + j]), x2 = bf2f(up[2960 + j]);
            float ss = k0 * k0 + k1 * k1 + k2 * k2 + k3 * k3 + x1 * x1 + x2 * x2;
            ss += __shfl_xor(ss, 1); ss += __shfl_xor(ss, 2); ss += __shfl_xor(ss, 4); ss += __shfl_xor(ss, 8);
            const float rn = __builtin_amdgcn_rsqf(ss * (1.f / 96.f) + EPS);
            k0 *= rn * kg.x; k1 *= rn * kg.y; k2 *= rn * kg.z; k3 *= rn * kg.w; x1 *= rn * kg1; x2 *= rn * kg2;
            bf16_t* op = MK + (size_t)tok * 384 + h * 96;
            u32x2 ov; ov.x = cvt_pk(k0, k1); ov.y = cvt_pk(k2, k3);
            *(u32x2*)(op + 4 * j) = ov;
            op[64 + j] = f2bf(x1 * cs - x2 * sn); op[80 + j] = f2bf(x2 * cs + x1 * sn);
            const u32x2 vv = *(const u32x2*)(kp + 64 + 4 * j);
            u32x2 vo; vo.x = cvt_pk(bflo(vv.x) * skv, bfhi(vv.x) * skv); vo.y = cvt_pk(bflo(vv.y) * skv, bfhi(vv.y) * skv);
            *(u32x2*)(vbuf + tl * 256 + h * 64 + 4 * j) = vo;
        }
    }
    __syncthreads();
    {
        const int tid = tidx(), b = (item * 64) / SEQ, s0 = (item * 64) % SEQ, hh = tid >> 6, e = tid & 63;
        bf16_t* dst = MVT + ((size_t)(b * 4 + hh) * 64 + e) * SEQ + s0;
#pragma unroll
        for (int c8 = 0; c8 < 8; ++c8) {
            unsigned wds[4];
#pragma unroll
            for (int k = 0; k < 4; ++k) wds[k] = (unsigned)vbuf[(c8 * 8 + 2 * k) * 256 + tid] | ((unsigned)vbuf[(c8 * 8 + 2 * k + 1) * 256 + tid] << 16);
            uint4 o; o.x = wds[0]; o.y = wds[1]; o.z = wds[2]; o.w = wds[3];
            *(uint4*)(dst + c8 * 8) = o;
        }
    }
    __syncthreads();
}

DI void memkv_finish_tile(const Params& p, int item, unsigned char* smem) {
    const bf16_t* KVM = (const bf16_t*)(p.ws + OFF_KVMEM);
    bf16_t* XK = (bf16_t*)(p.ws + OFF_XK);
    bf16_t* XVT = (bf16_t*)(p.ws + OFF_XVT);
    bf16_t* vbuf = (bf16_t*)smem;
    const int l = item >> 5, b = (item >> 2) & 7, h = item & 3;
    const int w = tidx() >> 6, lane = tidx() & 63;
    const float kg = p.in[I_XKNG][l * 64 + lane];
    for (int r = 0; r < 64; ++r) {
        const int m = w * 64 + r;
        const bf16_t* src = KVM + ((size_t)l * 2048 + b * 256 + m) * 512 + h * 128;
        const float k = bf2f(src[lane]);
        const float rn = __builtin_amdgcn_rsqf(wave_sum(k * k) * (1.f / 64.f) + EPS);
        XK[(((size_t)(l * 8 + b) * 4 + h) * 256 + m) * 64 + lane] = f2bf(k * rn * kg);
        vbuf[m * 64 + lane] = src[64 + lane];
    }
    __syncthreads();
    {
        const int tid = tidx(), e = tid & 63, mq = tid >> 6;
        bf16_t* dst = XVT + (((size_t)(l * 8 + b) * 4 + h) * 64 + e) * 256 + mq * 64;
#pragma unroll
        for (int c8 = 0; c8 < 8; ++c8) {
            unsigned wds[4];
#pragma unroll
            for (int k = 0; k < 4; ++k) wds[k] = (unsigned)vbuf[(mq * 64 + c8 * 8 + 2 * k) * 64 + e] | ((unsigned)vbuf[(mq * 64 + c8 * 8 + 2 * k + 1) * 64 + e] << 16);
            uint4 o; o.x = wds[0]; o.y = wds[1]; o.z = wds[2]; o.w = wds[3];
            *(uint4*)(dst + c8 * 8) = o;
        }
    }
    __syncthreads();
}

template <int DQK, bool QNORM>
DI void attn_tile(const bf16_t* __restrict__ Q, int qs, const bf16_t* __restrict__ Kp, int kstr, const bf16_t* __restrict__ Vt, int vstr, int nkeys,
                  float c2, float mbound, const float* __restrict__ qgain, bf16_t* __restrict__ O, int os, float* __restrict__ ssq, int ssq_stride, unsigned char* smem) {
    constexpr int NKS = DQK / 32, KP = DQK * 2 + 16, KCH = DQK / 8, KB = 64 * KP, VB = 64 * 144, STG = KB + VB, NKL = (64 * KCH) / 256;
    const int tid = tidx(), w = tid >> 6, lane = tid & 63, l15 = lane & 15, quad = lane >> 4;
    bf16x8 bq[2][NKS];
#pragma unroll
    for (int qt = 0; qt < 2; ++qt) {
        const bf16_t* qp = Q + (size_t)(w * 32 + qt * 16 + l15) * qs + quad * 8;
        if (QNORM) {
            float v[NKS][8]; float ss = 0.f;
#pragma unroll
            for (int ks = 0; ks < NKS; ++ks) {
                const uint4 x = *(const uint4*)(qp + ks * 32);
                v[ks][0] = bflo(x.x); v[ks][1] = bfhi(x.x); v[ks][2] = bflo(x.y); v[ks][3] = bfhi(x.y); v[ks][4] = bflo(x.z); v[ks][5] = bfhi(x.z); v[ks][6] = bflo(x.w); v[ks][7] = bfhi(x.w);
#pragma unroll
                for (int j = 0; j < 8; ++j) ss += v[ks][j] * v[ks][j];
            }
            ss += __shfl_xor(ss, 16); ss += __shfl_xor(ss, 32);
            const float rn = __builtin_amdgcn_rsqf(ss * (1.f / DQK) + EPS);
#pragma unroll
            for (int ks = 0; ks < NKS; ++ks) {
                const float* gp = qgain + ks * 32 + quad * 8;
                u32x4 o;
                o.x = cvt_pk(v[ks][0] * rn * gp[0], v[ks][1] * rn * gp[1]); o.y = cvt_pk(v[ks][2] * rn * gp[2], v[ks][3] * rn * gp[3]);
                o.z = cvt_pk(v[ks][4] * rn * gp[4], v[ks][5] * rn * gp[5]); o.w = cvt_pk(v[ks][6] * rn * gp[6], v[ks][7] * rn * gp[7]);
                bq[qt][ks] = __builtin_bit_cast(bf16x8, o);
            }
        } else {
#pragma unroll
            for (int ks = 0; ks < NKS; ++ks) bq[qt][ks] = *(const bf16x8*)(qp + ks * 32);
        }
    }
    f32x4 o[4][2];
    float lrun[2];
#pragma unroll
    for (int qt = 0; qt < 2; ++qt) {
        lrun[qt] = 0.f;
#pragma unroll
        for (int et = 0; et < 4; ++et) o[et][qt] = (f32x4){0.f, 0.f, 0.f, 0.f};
    }
    uint4 ak0, ak1, ak2, av0, av1, bk0, bk1, bk2, bv0, bv1;
    ak2 = make_uint4(0u, 0u, 0u, 0u); bk2 = ak2;
    const int kr0 = tid / KCH, kc0 = tid % KCH, kr1 = (tid + 256) / KCH, kc1 = (tid + 256) % KCH, kr2 = (tid + 512) / KCH, kc2 = (tid + 512) % KCH;
    const int vr0 = tid >> 3, vc0 = tid & 7, vr1 = vr0 + 32;
#define A_LOAD(S, key0) do { S##k0 = *(const uint4*)(Kp + (size_t)((key0) + kr0) * kstr + kc0 * 8); S##k1 = *(const uint4*)(Kp + (size_t)((key0) + kr1) * kstr + kc1 * 8); \
                          if (NKL > 2) S##k2 = *(const uint4*)(Kp + (size_t)((key0) + kr2) * kstr + kc2 * 8); \
                          S##v0 = *(const uint4*)(Vt + (size_t)vr0 * vstr + (key0) + vc0 * 8); S##v1 = *(const uint4*)(Vt + (size_t)vr1 * vstr + (key0) + vc0 * 8); } while (0)
#define A_STORE(S, buf) do { unsigned char* kb_ = smem + (buf) * STG; unsigned char* vb_ = kb_ + KB; \
                          *(uint4*)(kb_ + kr0 * KP + kc0 * 16) = S##k0; *(uint4*)(kb_ + kr1 * KP + kc1 * 16) = S##k1; if (NKL > 2) *(uint4*)(kb_ + kr2 * KP + kc2 * 16) = S##k2; \
                          *(uint4*)(vb_ + vr0 * 144 + vc0 * 16) = S##v0; *(uint4*)(vb_ + vr1 * 144 + vc0 * 16) = S##v1; } while (0)
    const int nkb = nkeys >> 6;
    A_LOAD(a, 0); A_STORE(a, 0);
    A_LOAD(b, 64);
    if (2 < nkb) A_LOAD(a, 128);
    __syncthreads();
#define A_COMPUTE(cur) do { \
        const unsigned char* kb = smem + cur * STG; const unsigned char* vb = kb + KB; \
        f32x4 s[4][2]; \
_Pragma("unroll")         for (int kt = 0; kt < 4; ++kt) { s[kt][0] = (f32x4){0.f, 0.f, 0.f, 0.f}; s[kt][1] = (f32x4){0.f, 0.f, 0.f, 0.f}; } \
_Pragma("unroll")         for (int ks = 0; ks < NKS; ++ks) { \
            bf16x8 ak[4]; \
_Pragma("unroll")             for (int kt = 0; kt < 4; ++kt) ak[kt] = *(const bf16x8*)(kb + (kt * 16 + l15) * KP + ks * 64 + quad * 16); \
_Pragma("unroll")             for (int kt = 0; kt < 4; ++kt) { s[kt][0] = MFMA16(ak[kt], bq[0][ks], s[kt][0]); s[kt][1] = MFMA16(ak[kt], bq[1][ks], s[kt][1]); } \
        } \
        bf16x8 pb[2][2]; \
_Pragma("unroll")         for (int qt = 0; qt < 2; ++qt) { \
            float ls = 0.f; \
            float pv[4][4]; \
_Pragma("unroll")             for (int kt = 0; kt < 4; ++kt) \
_Pragma("unroll")                 for (int r = 0; r < 4; ++r) { pv[kt][r] = __builtin_amdgcn_exp2f(s[kt][qt][r] * c2 - mbound); ls += pv[kt][r]; } \
            lrun[qt] += ls; \
_Pragma("unroll")             for (int k2 = 0; k2 < 2; ++k2) { \
                u32x4 pw; pw.x = cvt_pk(pv[2 * k2][0], pv[2 * k2][1]); pw.y = cvt_pk(pv[2 * k2][2], pv[2 * k2][3]); \
                pw.z = cvt_pk(pv[2 * k2 + 1][0], pv[2 * k2 + 1][1]); pw.w = cvt_pk(pv[2 * k2 + 1][2], pv[2 * k2 + 1][3]); \
                pb[qt][k2] = __builtin_bit_cast(bf16x8, pw); \
            } \
        } \
_Pragma("unroll")         for (int k2 = 0; k2 < 2; ++k2) \
_Pragma("unroll")             for (int et = 0; et < 4; ++et) { \
                const unsigned char* vp = vb + (et * 16 + l15) * 144 + k2 * 64 + quad * 8; \
                const u32x2 lo = *(const u32x2*)vp, hi = *(const u32x2*)(vp + 32); \
                u32x4 a; a.x = lo.x; a.y = lo.y; a.z = hi.x; a.w = hi.y; \
                const bf16x8 av = __builtin_bit_cast(bf16x8, a); \
                o[et][0] = MFMA16(av, pb[0][k2], o[et][0]); \
                o[et][1] = MFMA16(av, pb[1][k2], o[et][1]); \
            } \
    } while (0)
#pragma unroll 1
    for (int jb = 0; jb < nkb; jb += 2) {
        A_STORE(b, 1);
        if (jb + 3 < nkb) A_LOAD(b, (jb + 3) * 64);
        __builtin_amdgcn_sched_barrier(0);
        A_COMPUTE(0);
        __syncthreads();
        if (jb + 2 < nkb) A_STORE(a, 0);
        if (jb + 4 < nkb) A_LOAD(a, (jb + 4) * 64);
        __builtin_amdgcn_sched_barrier(0);
        A_COMPUTE(1);
        __syncthreads();
    }
#undef A_COMPUTE
#undef A_LOAD
#undef A_STORE
#pragma unroll
    for (int qt = 0; qt < 2; ++qt) {
        float lt = lrun[qt]; lt += __shfl_xor(lt, 16); lt += __shfl_xor(lt, 32);
        const float inv = 1.f / lt;
        const int q = w * 32 + qt * 16 + l15;
        float ss = 0.f;
#pragma unroll
        for (int et = 0; et < 4; ++et) {
            const float y0 = o[et][qt][0] * inv, y1 = o[et][qt][1] * inv, y2 = o[et][qt][2] * inv, y3 = o[et][qt][3] * inv;
            ss += y0 * y0 + y1 * y1 + y2 * y2 + y3 * y3;
            u32x2 ov; ov.x = cvt_pk(y0, y1); ov.y = cvt_pk(y2, y3);
            *(u32x2*)(O + (size_t)q * os + et * 16 + quad * 4) = ov;
        }
        if (ssq) { ss += __shfl_xor(ss, 16); ss += __shfl_xor(ss, 32); if (quad == 0) ssq[(size_t)q * ssq_stride] = ss; }
    }
}

namespace pg8 {
#define PG8_LAS __attribute__((address_space(3)))
constexpr int BM = 256, BK = 64, HALF = 128, HTB = HALF * BK * 2, STAGE_BYTES = 8 * HTB, NXCD = 8, WGM = 8;
DI int lds_byte(int r, int c) { const int st = (r >> 4) * 2 + (c >> 5), rr = r & 15, cc = c & 31, ob = rr * 64 + cc * 2; return st * 1024 + (ob ^ (((ob >> 9) & 1) << 5)); }
DI void stage_rc(int b, int& R, int& C) { const int st = b / 1024, sb = b % 1024, swz = sb ^ (((sb >> 9) & 1) << 5); R = (st >> 1) * 16 + swz / 64; C = (st & 1) * 32 + (swz % 64) / 2; }
struct Unit { int pm, pn; };
struct Gemm { const bf16_t* A; const bf16_t* Bt; int M, N, K; };
struct StaticOrder {
    int nM, nN, nwg, G, c;
    DI void init(int M, int N, int G_, int c_) { nM = M / BM; nN = N / BM; nwg = nM * nN; G = G_; c = c_; }
    DI bool next(int i, Unit& u) const {
        const long L = (long)i * G + c; if (L >= nwg) return false;
        int wgid = (int)L; { const int q = nwg / NXCD, r = nwg % NXCD, xcd = wgid % NXCD, off = wgid / NXCD; wgid = (xcd < r ? xcd * (q + 1) : r * (q + 1) + (xcd - r) * q) + off; }
        const int nig = WGM * nN, gid = wgid / nig, fm = gid * WGM, gsz = (nM - fm) < WGM ? (nM - fm) : WGM;
        u.pm = fm + ((wgid % nig) % gsz); u.pn = (wgid % nig) / gsz; return true;
    }
};
DI float row_rstd(const float* part, int row) {
    const float4* p4 = (const float4*)(part + (size_t)row * 16);
    const float4 a = p4[0], b = p4[1], c = p4[2], d = p4[3];
    const float s = (a.x + a.y + a.z + a.w) + (b.x + b.y + b.z + b.w) + (c.x + c.y + c.z + c.w) + (d.x + d.y + d.z + d.w);
    return __builtin_amdgcn_rsqf(s * (1.f / DM) + EPS);
}
struct EpiScaled {
    bf16_t* O; int ldo; const float* part; int ncols;
    DI void operator()(const f32x4 (&acc)[2][2][4][2], const Unit& u, int wr, int wc, int fr, int fq) const {
#pragma unroll
        for (int ai = 0; ai < 2; ++ai)
#pragma unroll
            for (int m = 0; m < 4; ++m) {
                const int row = u.pm * BM + ai * HALF + wr * 64 + m * 16 + fr;
                const float sc = row_rstd(part, row);
                bf16_t* rowp = O + (size_t)row * ldo + u.pn * BM + wc * 32 + fq * 4;
#pragma unroll
                for (int bj = 0; bj < 2; ++bj) {
                    if (u.pn * BM + bj * HALF + wc * 32 >= ncols) continue;
#pragma unroll
                    for (int n = 0; n < 2; ++n) {
                        u32x2 v; v.x = cvt_pk(acc[ai][bj][m][n][0] * sc, acc[ai][bj][m][n][1] * sc); v.y = cvt_pk(acc[ai][bj][m][n][2] * sc, acc[ai][bj][m][n][3] * sc);
                        *(u32x2*)(rowp + bj * HALF + n * 16) = v;
                    }
                }
            }
    }
};
struct EpiSwiglu {
    bf16_t* H; const float* part;
    DI void operator()(const f32x4 (&acc)[2][2][4][2], const Unit& u, int wr, int wc, int fr, int fq) const {
#pragma unroll
        for (int ai = 0; ai < 2; ++ai)
#pragma unroll
            for (int m = 0; m < 4; ++m) {
                const int row = u.pm * BM + ai * HALF + wr * 64 + m * 16 + fr;
                const float sc = row_rstd(part, row);
                bf16_t* rowp = H + (size_t)row * DFF + ((u.pn * BM + wc * 32) >> 1) + fq * 4;
#pragma unroll
                for (int bj = 0; bj < 2; ++bj) {
                    float h[4];
#pragma unroll
                    for (int j = 0; j < 4; ++j) { const float a1 = acc[ai][bj][m][0][j] * sc, a3 = acc[ai][bj][m][1][j] * sc; h[j] = a1 * sigmoidf_(a1) * a3; }
                    u32x2 v; v.x = cvt_pk(h[0], h[1]); v.y = cvt_pk(h[2], h[3]);
                    *(u32x2*)(rowp + bj * (HALF / 2)) = v;
                }
            }
    }
};
struct EpiResid {
    bf16_t* XB; float* rowsq; float* OUT;
    DI void operator()(const f32x4 (&acc)[2][2][4][2], const Unit& u, int wr, int wc, int fr, int fq) const {
#pragma unroll
        for (int ai = 0; ai < 2; ++ai)
#pragma unroll
            for (int m = 0; m < 4; ++m) {
                const int row = u.pm * BM + ai * HALF + wr * 64 + m * 16 + fr;
                float ss = 0.f;
#pragma unroll
                for (int bj = 0; bj < 2; ++bj)
#pragma unroll
                    for (int n = 0; n < 2; ++n) {
                        const int col = u.pn * BM + bj * HALF + wc * 32 + n * 16 + fq * 4;
                        u32x2* xp = (u32x2*)(XB + (size_t)row * DM + col);
                        const u32x2 xo = *xp;
                        const float x0 = bflo(xo.x) + acc[ai][bj][m][n][0], x1 = bfhi(xo.x) + acc[ai][bj][m][n][1];
                        const float x2 = bflo(xo.y) + acc[ai][bj][m][n][2], x3 = bfhi(xo.y) + acc[ai][bj][m][n][3];
                        if (OUT) *(f32x4*)(OUT + (size_t)row * DM + col) = (f32x4){x0, x1, x2, x3};
                        else { u32x2 v; v.x = cvt_pk(x0, x1); v.y = cvt_pk(x2, x3); *xp = v; }
                        ss += x0 * x0 + x1 * x1 + x2 * x2 + x3 * x3;
                    }
                ss += __shfl_xor(ss, 16); ss += __shfl_xor(ss, 32);
                if (fq == 0 && !OUT) rowsq[(size_t)row * 16 + u.pn * 4 + wc] = ss;
            }
    }
};

template <class Epi, bool SCALED = false>
DI void gemm_phase(PG8_LAS unsigned char* lds, const Gemm g, const StaticOrder& S, const Epi& E, const float* ssq0 = nullptr, const float* ssq1 = nullptr) {
    int tid = threadIdx.x; asm volatile("" : "+v"(tid));
    const int wid = __builtin_amdgcn_readfirstlane(tid >> 6), lane = tid & 63, wr = wid >> 2, wc = wid & 3, fr = lane & 15, fq = lane >> 4;
    const int K = g.K, nt = K / BK;
    unsigned voffA[2];
#pragma unroll
    for (int i = 0; i < 2; ++i) { int R, C; stage_rc(tid * 16 + i * 8192, R, C); voffA[i] = (unsigned)(R * K + C) * 2u; }
    const size_t kstep = (size_t)(BK * 2);
    const size_t hstep = (size_t)HALF * K * 2;
    const size_t tstep = 2 * hstep;
    const unsigned ldsw = (unsigned)wid * 1024u;
    const int aoff = lds_byte(wr * 64 + fr, fq * 8), boff = lds_byte(wc * 32 + fr, fq * 8);
#define PG8_SA(b, h) (((b) * 2 + (h)) * HTB)
#define PG8_SB(b, h) ((4 + (b) * 2 + (h)) * HTB)
#define PG8_STAGE(bufoff, gbase) do { _Pragma("unroll") for (int _i = 0; _i < 2; ++_i) \
        __builtin_amdgcn_global_load_lds((const unsigned*)((const char*)(gbase) + voffA[_i]), (PG8_LAS unsigned*)(lds + (bufoff) + ldsw + _i * 8192), 16, 0, 0); } while (0)
#define PG8_LDA(dst, b, h) do { _Pragma("unroll") for (int m = 0; m < 4; ++m) _Pragma("unroll") for (int k = 0; k < 2; ++k) dst[m][k] = *(const PG8_LAS bf16x8*)(lds + PG8_SA(b, h) + aoff + m * 2048 + k * 1024); } while (0)
#define PG8_LDB(dst, b, h) do { _Pragma("unroll") for (int n = 0; n < 2; ++n) _Pragma("unroll") for (int k = 0; k < 2; ++k) dst[n][k] = *(const PG8_LAS bf16x8*)(lds + PG8_SB(b, h) + boff + n * 2048 + k * 1024); } while (0)
#define PG8_MMA(ai, bj, At, Bt) do { __builtin_amdgcn_s_setprio(1); _Pragma("unroll") for (int m = 0; m < 4; ++m) _Pragma("unroll") for (int n = 0; n < 2; ++n) _Pragma("unroll") for (int k = 0; k < 2; ++k) \
        acc[ai][bj][m][n] = __builtin_amdgcn_mfma_f32_16x16x32_bf16(Bt[n][k], At[m][k], acc[ai][bj][m][n], 0, 0, 0); __builtin_amdgcn_s_setprio(0); } while (0)
#define PG8_WAIT_V(n) asm volatile("s_waitcnt vmcnt(" #n ")" ::: "memory")
#define PG8_WAIT_L(n) asm volatile("s_waitcnt lgkmcnt(" #n ")" ::: "memory")
#define PG8_BAR __builtin_amdgcn_s_barrier()
#define PG8_SCHED __builtin_amdgcn_sched_barrier(0)
    Unit cur, nxt; int ui = 0;
    if (!S.next(0, cur)) return;
    f32x4 acc[2][2][4][2];
#pragma unroll
    for (int a = 0; a < 2; ++a)
#pragma unroll
        for (int b = 0; b < 2; ++b)
#pragma unroll
            for (int m = 0; m < 4; ++m)
#pragma unroll
                for (int n = 0; n < 2; ++n) acc[a][b][m][n] = (f32x4){0.f, 0.f, 0.f, 0.f};
    bf16x8 At[4][2], B0[2][2], B1[2][2];
    const char* cA = (const char*)g.A + (size_t)cur.pm * tstep; const char* cB = (const char*)g.Bt + (size_t)cur.pn * tstep;
#define PG8_FTAB(unit) do { if (SCALED && tid < 256) { const int row_ = (unit).pm * BM + tid; \
        const float4 sb_ = *(const float4*)(ssq0 + (size_t)row_ * 4), sd_ = *(const float4*)(ssq1 + (size_t)row_ * 4); \
        const float rB_ = __builtin_amdgcn_rsqf((sb_.x + sb_.y + sb_.z + sb_.w) * (1.f / 256.f) + EPS), rD_ = __builtin_amdgcn_rsqf((sd_.x + sd_.y + sd_.z + sd_.w) * (1.f / 256.f) + EPS); \
        PG8_LAS float* ft_ = (PG8_LAS float*)(lds + STAGE_BYTES); ft_[tid] = rB_ / rD_; ft_[256 + tid] = rD_; } } while (0)
    PG8_FTAB(cur);
    PG8_STAGE(PG8_SB(0, 0), cB); PG8_STAGE(PG8_SB(0, 1), cB + hstep); PG8_STAGE(PG8_SA(0, 0), cA); PG8_STAGE(PG8_SA(0, 1), cA + hstep);
    if (wr == 1) PG8_BAR;
    PG8_WAIT_V(2); PG8_BAR;
    PG8_STAGE(PG8_SB(1, 0), cB + kstep); PG8_STAGE(PG8_SA(1, 0), cA + kstep); PG8_STAGE(PG8_SB(1, 1), cB + hstep + kstep);
    PG8_WAIT_V(6); PG8_BAR;
    for (;;) {
        const bool has_next = S.next(ui + 1, nxt);
        const char* nA = has_next ? (const char*)g.A + (size_t)nxt.pm * tstep : cA; const char* nB = has_next ? (const char*)g.Bt + (size_t)nxt.pn * tstep : cB;
        for (int t = 0; t < nt; t += 2) {
            const bool last = (t == nt - 2);
            const char* a1 = cA + (size_t)(t + 1) * kstep;
            const char* a2 = last ? nA : cA + (size_t)(t + 2) * kstep; const char* b2 = last ? nB : cB + (size_t)(t + 2) * kstep;
            const char* a3 = a2 + kstep; const char* b3 = b2 + kstep;
            if (SCALED && (t == 4 || t == 8)) {
                const PG8_LAS float* ft = (const PG8_LAS float*)(lds + STAGE_BYTES) + (t == 8 ? 256 : 0);
#pragma unroll
                for (int ai = 0; ai < 2; ++ai)
#pragma unroll
                    for (int m = 0; m < 4; ++m) {
                        const float f = ft[ai * HALF + wr * 64 + m * 16 + fr];
#pragma unroll
                        for (int bj = 0; bj < 2; ++bj)
#pragma unroll
                            for (int n = 0; n < 2; ++n) acc[ai][bj][m][n] *= f;
                    }
            }
            PG8_LDB(B0, 0, 0); PG8_LDB(B1, 0, 1); PG8_SCHED; PG8_LDA(At, 0, 0); PG8_STAGE(PG8_SA(1, 1), a1 + hstep);
            PG8_WAIT_V(8); PG8_WAIT_L(0); PG8_BAR; PG8_MMA(0, 0, At, B0); PG8_MMA(0, 1, At, B1); PG8_BAR; PG8_SCHED;
            PG8_LDA(At, 0, 1); PG8_STAGE(PG8_SB(0, 0), b2); PG8_STAGE(PG8_SB(0, 1), b2 + hstep); PG8_STAGE(PG8_SA(0, 0), a2);
            PG8_WAIT_V(8); PG8_WAIT_L(0); PG8_BAR; PG8_MMA(1, 0, At, B0); PG8_MMA(1, 1, At, B1); PG8_BAR; PG8_SCHED;
            PG8_LDB(B0, 1, 0); PG8_LDB(B1, 1, 1); PG8_SCHED; PG8_LDA(At, 1, 0); PG8_STAGE(PG8_SA(0, 1), a2 + hstep);
            PG8_WAIT_V(8); PG8_WAIT_L(0); PG8_BAR; PG8_MMA(0, 0, At, B0); PG8_MMA(0, 1, At, B1); PG8_BAR; PG8_SCHED;
            PG8_LDA(At, 1, 1); PG8_STAGE(PG8_SB(1, 0), b3); PG8_STAGE(PG8_SB(1, 1), b3 + hstep); PG8_STAGE(PG8_SA(1, 0), a3);
            PG8_WAIT_V(8); PG8_WAIT_L(0); PG8_BAR; PG8_MMA(1, 0, At, B0); PG8_MMA(1, 1, At, B1); PG8_BAR; PG8_SCHED;
        }
        if (wr == 0) PG8_BAR;
        E(acc, cur, wr, wc, fr, fq);
        if (!has_next) break;
#pragma unroll
        for (int a = 0; a < 2; ++a)
#pragma unroll
            for (int b = 0; b < 2; ++b)
#pragma unroll
                for (int m = 0; m < 4; ++m)
#pragma unroll
                    for (int n = 0; n < 2; ++n) acc[a][b][m][n] = (f32x4){0.f, 0.f, 0.f, 0.f};
        cur = nxt; cA = nA; cB = nB; ++ui;
        if (wr == 1) PG8_BAR;
        PG8_FTAB(cur);
    }
    PG8_WAIT_V(0);
    PG8_BAR;
#undef PG8_FTAB
#undef PG8_SA
#undef PG8_SB
#undef PG8_STAGE
#undef PG8_LDA
#undef PG8_LDB
#undef PG8_MMA
#undef PG8_WAIT_V
#undef PG8_WAIT_L
#undef PG8_BAR
#undef PG8_SCHED
}
}

enum { PH_PRO = 0, PH_CONV, PH_P1, PH_P2, PH_P3, PH_P4, PH_P5, PH_P6, PH_P7, PH_P8, PH_P9, PH_P10, PH_COUNT };

DI void gemm_item_bf16(const bf16_t* A, int lda, const bf16_t* Bt, int K, int nM, int nN, int L, bf16_t* O, int ldo, const float* part, int npart, float inv_n, unsigned char* smem) {
    int pm, pn; tile_order(L, nM, nN, pm, pn);
    if (part) fill_rs(smem, part, npart, pm * 128, inv_n);
    f32x4 acc[4][4];
    gemm_mainloop<false>(A, lda, Bt, K, pm * 128, pn * 128, smem, acc);
    epi_bf16(acc, O, ldo, pm * 128, pn * 128, part ? (const float*)(smem + 65536) : nullptr);
    __syncthreads();
}
template <bool ASC>
DI void gemm_item_resid(const Params& p, const bf16_t* A, int lda, const bf16_t* Bt, int K, int L, unsigned char* smem) {
    int pm, pn; tile_order(L, 256, 8, pm, pn);
    if (ASC) {
        float* asc = (float*)(smem + 66048);
        const float* sb = (const float*)(p.ws + OFF_SSQB); const float* sd = (const float*)(p.ws + OFF_SSQD);
        const int tid = tidx();
        if (tid < 128) {
            const float4 a = *(const float4*)(sb + (size_t)(pm * 128 + tid) * 4), d = *(const float4*)(sd + (size_t)(pm * 128 + tid) * 4);
            asc[tid * 2] = __builtin_amdgcn_rsqf((a.x + a.y + a.z + a.w) * (1.f / 256.f) + EPS);
            asc[tid * 2 + 1] = __builtin_amdgcn_rsqf((d.x + d.y + d.z + d.w) * (1.f / 256.f) + EPS);
        }
    }
    f32x4 acc[4][4];
    gemm_mainloop<ASC>(A, lda, Bt, K, pm * 128, pn * 128, smem, acc);
    epi_resid(acc, p.out, (bf16_t*)(p.ws + OFF_XB), (float*)(p.ws + OFF_ROWSQ), pm * 128, pn * 128);
    __syncthreads();
}

DI void run_phase(const Params& p, int ph, int l, unsigned char* smem0) {
    const int vb = __builtin_amdgcn_readfirstlane((int)(threadIdx.x >> 8));
    unsigned char* smem = smem0 + vb * LDS_BYTES;
    const int G = gridDim.x * 2, bid = blockIdx.x * 2 + vb;
    const bf16_t* W = (const bf16_t*)(p.ws + OFF_W);
    const bf16_t* XB = (const bf16_t*)(p.ws + OFF_XB);
    bf16_t* U = (bf16_t*)(p.ws + OFF_U);
    const float* ROWSQ = (const float*)(p.ws + OFF_ROWSQ);
#ifdef ONLY_PH
    if (ph != ONLY_PH) return;
#endif
    switch (ph) {
    case PH_PRO: {
        for (int i = bid; i < 2048; i += G) pro_rows(p.in[I_X], nullptr, (bf16_t*)(p.ws + OFF_XB), (float*)(p.ws + OFF_ROWSQ), 16, i);
        for (int i = bid; i < 128; i += G) pro_rows(p.in[I_MEM], nullptr, (bf16_t*)(p.ws + OFF_MEMB), (float*)(p.ws + OFF_MEMSQ), 1, i);
        for (int i = bid; i < 128; i += G) pro_rope(p, i);
        for (int i = bid; i < 512; i += G) { const int ll = i >> 7; conv_tile(p.in[I_XWKV] + (size_t)ll * DM * 512, DM, 512, 512, p.in[I_GMEM] + ll * DM, 0, (bf16_t*)(p.ws + OFF_XWKV) + (size_t)ll * 512 * DM, i & 127, smem); }
        for (int i = bid; i < CONV_TILES; i += G) conv_layer_item(p, 0, i, smem);
    } break;
    case PH_CONV: {
        for (int it = bid; it < CONV_TILES; it += G) conv_layer_item(p, l, it, smem);
    } break;
    case PH_P1: {
        { pg8::Gemm g{XB, W + W_IN, T_TOK, UC, DM}; pg8::StaticOrder S; S.init(T_TOK, UC, gridDim.x, blockIdx.x);
          pg8::EpiScaled E{U, UC, ROWSQ, INC};
          pg8::gemm_phase<pg8::EpiScaled>((PG8_LAS unsigned char*)smem0, g, S, E); }
        if (l == 0) {
            for (int i = bid; i < 256; i += G) {
                const int ll = i >> 6;
                gemm_item_bf16((const bf16_t*)(p.ws + OFF_MEMB), DM, (const bf16_t*)(p.ws + OFF_XWKV) + (size_t)ll * 512 * DM, DM, 16, 4, i & 63,
                               (bf16_t*)(p.ws + OFF_KVMEM) + (size_t)ll * 2048 * 512, 512, (const float*)(p.ws + OFF_MEMSQ), 1, 1.f / DM, smem);
            }
        }
    } break;
    case PH_P2: {
        for (int i = bid; i < 1024; i += G) hgrn_local_tile(p, l, i, smem);
#ifdef RP2_HL
        for (int i = bid; i < 1024; i += G) hgrn_local_tile(p, l, i, smem);
#endif
        for (int i = bid; i < 1024; i += G) conformer_tile(p, l, i, smem);
#ifdef RP2_CF
        for (int i = bid; i < 1024; i += G) conformer_tile(p, l, i, smem);
#endif
#ifdef RP2_G
        for (int i = bid; i < 768; i += G) gemm_item_bf16(U + 2560, UC, W + W_UQ, 256, 256, 3, i, (bf16_t*)((unsigned char*)p.out + QRAW_IN_OUT), 384, nullptr, 0, 0.f, smem);
        for (int i = bid; i < 1024; i += G) gemm_item_bf16(U + 2816, UC, W + W_UKV, 128, 256, 4, i, (bf16_t*)((unsigned char*)p.out + KVRAW_IN_OUT), 512, nullptr, 0, 0.f, smem);
#endif
#ifdef RP2_SC
        for (int i = bid; i < 512; i += G) shortconv_tile(p, l, i);
#endif
        for (int i = bid; i < 768; i += G) gemm_item_bf16(U + 2560, UC, W + W_UQ, 256, 256, 3, i, (bf16_t*)((unsigned char*)p.out + QRAW_IN_OUT), 384, nullptr, 0, 0.f, smem);
        for (int i = bid; i < 1024; i += G) gemm_item_bf16(U + 2816, UC, W + W_UKV, 128, 256, 4, i, (bf16_t*)((unsigned char*)p.out + KVRAW_IN_OUT), 512, nullptr, 0, 0.f, smem);
        for (int i = bid; i < 512; i += G) shortconv_tile(p, l, i);
        if (l == 0) { for (int i = bid; i < 128; i += G) memkv_finish_tile(p, i, smem); }
    } break;
    case PH_P3: {
        for (int i = bid; i < 512; i += G) hgrn_scan_item(p, i);
        for (int i = bid; i < 512; i += G) mla_finish_tile(p, l, i, smem);
#ifdef RP3_MF
        for (int i = bid; i < 512; i += G) mla_finish_tile(p, l, i, smem);
#endif
    } break;
    case PH_P4: {
        const float c2 = 0.10206207261596575f * 1.4426950408889634f;
        float mb;
        {
            const int ln = tidx() & 63;
            float gq = fmaxf(fabsf(p.in[I_MQNG][l * 96 + ln]), ln < 32 ? fabsf(p.in[I_MQNG][l * 96 + 64 + ln]) : 0.f);
            float gk = fmaxf(fabsf(p.in[I_MKNG][l * 96 + ln]), ln < 32 ? fabsf(p.in[I_MKNG][l * 96 + 64 + ln]) : 0.f);
#pragma unroll
            for (int o = 32; o > 0; o >>= 1) { gq = fmaxf(gq, __shfl_xor(gq, o)); gk = fmaxf(gk, __shfl_xor(gk, o)); }
            mb = 96.f * gq * gk * c2;
        }
        for (int it0 = bid; it0 < 1024; it0 += G) {
            const int xcd = blockIdx.x & 7, jx = ((blockIdx.x >> 3) << 1) + vb, loc = (it0 / G) * 64 + jx;
            const int it = (G == 512) ? (xcd * 128 + loc) : it0;
            const int bh = it >> 5, qt = it & 31, b = bh >> 2, h = bh & 3;
            const size_t tok0 = (size_t)b * SEQ + qt * 128;
            attn_tile<96, false>((const bf16_t*)(p.ws + OFF_MQ) + tok0 * 384 + h * 96, 384, (const bf16_t*)(p.ws + OFF_MK) + (size_t)b * SEQ * 384 + h * 96, 384,
                                 (const bf16_t*)(p.ws + OFF_MVT) + (size_t)bh * 64 * SEQ, SEQ, SEQ, c2, mb, nullptr,
                                 (bf16_t*)(p.ws + OFF_CAT) + tok0 * DM + 256 + h * 64, DM, (float*)(p.ws + OFF_SSQD) + tok0 * 4 + h, 4, smem);
        }
        for (int i = bid; i < 2048; i += G) hgrn_out_tile(p, l, i, smem);
#ifdef REPEAT_HGOUT
        for (int i = bid; i < 2048; i += G) hgrn_out_tile(p, l, i, smem);
#endif
    } break;
    case PH_P5: {
        pg8::Gemm g{(const bf16_t*)(p.ws + OFF_CAT), W + W_OUT, T_TOK, DM, DM}; pg8::StaticOrder S; S.init(T_TOK, DM, gridDim.x, blockIdx.x);
        pg8::EpiResid E{(bf16_t*)(p.ws + OFF_XB), (float*)(p.ws + OFF_ROWSQ), nullptr};
        pg8::gemm_phase<pg8::EpiResid, true>((PG8_LAS unsigned char*)smem0, g, S, E, (const float*)(p.ws + OFF_SSQB), (const float*)(p.ws + OFF_SSQD));
    } break;
    case PH_P6: {
        for (int it = bid; it < 512; it += G) gemm_item_bf16(XB, DM, W + W_XQ, DM, 256, 2, it, (bf16_t*)(p.ws + OFF_XQ), 256, ROWSQ, 16, 1.f / DM, smem);
    } break;
    case PH_P7: {
        const float c2 = 0.125f * 1.4426950408889634f;
        float mb;
        {
            const int ln = tidx() & 63;
            float gq = fabsf(p.in[I_XQNG][l * 64 + ln]), gk = fabsf(p.in[I_XKNG][l * 64 + ln]);
#pragma unroll
            for (int o = 32; o > 0; o >>= 1) { gq = fmaxf(gq, __shfl_xor(gq, o)); gk = fmaxf(gk, __shfl_xor(gk, o)); }
            mb = 64.f * gq * gk * c2;
        }
        for (int it0 = bid; it0 < 1024; it0 += G) {
            const int xcd = blockIdx.x & 7, jx = ((blockIdx.x >> 3) << 1) + vb, loc = (it0 / G) * 64 + jx;
            const int it = (G == 512) ? (xcd * 128 + loc) : it0;
            const int bh = it >> 5, qt = it & 31, b = bh >> 2, h = bh & 3;
            const size_t tok0 = (size_t)b * SEQ + qt * 128;
            attn_tile<64, true>((const bf16_t*)(p.ws + OFF_XQ) + tok0 * 256 + h * 64, 256, (const bf16_t*)(p.ws + OFF_XK) + ((size_t)(l * 8 + b) * 4 + h) * 256 * 64, 64,
                                (const bf16_t*)(p.ws + OFF_XVT) + ((size_t)(l * 8 + b) * 4 + h) * 64 * 256, 256, 256, c2, mb, p.in[I_XQNG] + l * 64,
                                (bf16_t*)(p.ws + OFF_XO) + tok0 * 256 + h * 64, 256, nullptr, 0, smem);
        }
    } break;
    case PH_P8: {
        pg8::Gemm g{(const bf16_t*)(p.ws + OFF_XO), W + W_XO, T_TOK, DM, 256}; pg8::StaticOrder S; S.init(T_TOK, DM, gridDim.x, blockIdx.x);
        pg8::EpiResid E{(bf16_t*)(p.ws + OFF_XB), (float*)(p.ws + OFF_ROWSQ), nullptr};
        pg8::gemm_phase<pg8::EpiResid>((PG8_LAS unsigned char*)smem0, g, S, E);
    } break;
    case PH_P9: {
        pg8::Gemm g{XB, W + W_13, T_TOK, 2 * DFF, DM}; pg8::StaticOrder S; S.init(T_TOK, 2 * DFF, gridDim.x, blockIdx.x);
        pg8::EpiSwiglu E{(bf16_t*)(p.ws + OFF_HFF), ROWSQ};
        pg8::gemm_phase<pg8::EpiSwiglu>((PG8_LAS unsigned char*)smem0, g, S, E);
    } break;
    case PH_P10: {
        pg8::Gemm g{(const bf16_t*)(p.ws + OFF_HFF), W + W_2, T_TOK, DM, DFF}; pg8::StaticOrder S; S.init(T_TOK, DM, gridDim.x, blockIdx.x);
        pg8::EpiResid E{(bf16_t*)(p.ws + OFF_XB), (float*)(p.ws + OFF_ROWSQ), (l == NL - 1) ? p.out : nullptr};
        pg8::gemm_phase<pg8::EpiResid>((PG8_LAS unsigned char*)smem0, g, S, E);
    } break;
    }
}

#define XB_TMO      128
#define XB_XCNT(j)  (256  + 64 * (j))
#define XB_XSUB(j)  (1280 + 64 * (j))
#define XB_XGEN(j)  (2304 + 64 * (j))
#define XB_TOP      3328
#define XB_TOPGEN   3392
#define XCD_BAR_WORDS 3456
#define XB_SPIN_CAP (1u << 22)
#define LAS __attribute__((address_space(3)))
DI unsigned xb_ld(unsigned* p)              { return __hip_atomic_load(p, __ATOMIC_RELAXED, __HIP_MEMORY_SCOPE_AGENT); }
DI unsigned xb_add(unsigned* p, unsigned v) { return __hip_atomic_fetch_add(p, v, __ATOMIC_RELAXED, __HIP_MEMORY_SCOPE_AGENT); }
DI unsigned xb_xcc_id() { return (unsigned)__builtin_amdgcn_s_getreg((3 << 11) | 20) & 0xFu; }
#define XB_SPIN(cond, bar) do { unsigned _sp = 0; while (cond) { __builtin_amdgcn_s_sleep(1); \
    if ((++_sp & 255u) == 0u) { if (xb_ld(&(bar)[XB_TMO])) break; if (_sp > XB_SPIN_CAP) { atomicAdd(&(bar)[XB_TMO], 1u); break; } } } } while (0)
struct XcdBarrier { unsigned* bar; unsigned x; volatile LAS unsigned* st; };
DI XcdBarrier xcd_barrier_post(unsigned* bar, volatile LAS unsigned* st) {
    XcdBarrier b; b.bar = bar; b.x = xb_xcc_id(); b.st = st;
    if (threadIdx.x == 0) (void)xb_add(&bar[XB_XCNT(b.x)], 1u);
    return b;
}
DI void xcd_barrier_complete(unsigned* bar, unsigned x, unsigned& nloc, unsigned& nx) {
    const unsigned G = gridDim.x * gridDim.y * gridDim.z;
    unsigned sum, cnt, mine, sp = 0u;
    for (;;) {
        sum = 0u; cnt = 0u; mine = 0u;
#pragma unroll
        for (unsigned j = 0; j < 16; ++j) { const unsigned c = xb_ld(&bar[XB_XCNT(j)]); sum += c; cnt += (c > 0u) ? 1u : 0u; mine = (j == x) ? c : mine; }
        if (sum == G) break;
        __builtin_amdgcn_s_sleep(1);
        if ((++sp & 255u) == 0u) { if (xb_ld(&bar[XB_TMO])) break; if (sp > XB_SPIN_CAP) { atomicAdd(&bar[XB_TMO], 1u); break; } }
    }
    nloc = mine > 0u ? mine : 1u; nx = cnt > 0u ? cnt : 1u;
}
DI void xcd_barrier(const XcdBarrier& b) {
    asm volatile("s_waitcnt vmcnt(0)" ::: "memory");
    __syncthreads();
    if (threadIdx.x == 0) {
        unsigned* bar = b.bar;
        __builtin_amdgcn_s_waitcnt(0);
        unsigned nloc = b.st[0], nx = b.st[1];
        if (nloc == 0u) { xcd_barrier_complete(bar, b.x, nloc, nx); b.st[0] = nloc; b.st[1] = nx; }
        const unsigned old = xb_add(&bar[XB_XSUB(b.x)], 1u);
        const unsigned gen = old / nloc;
        if (old + 1u == (gen + 1u) * nloc) {
            __builtin_amdgcn_fence(__ATOMIC_RELEASE, "agent");
            asm volatile("s_waitcnt vmcnt(0)" ::: "memory");
            const unsigned og = xb_add(&bar[XB_TOP], 1u);
            const unsigned tg = og / nx;
            if (og + 1u == (tg + 1u) * nx) xb_add(&bar[XB_TOPGEN], 1u);
            else XB_SPIN(xb_ld(&bar[XB_TOPGEN]) == tg, bar);
            __builtin_amdgcn_fence(__ATOMIC_ACQUIRE, "agent");
            xb_add(&bar[XB_XGEN(b.x)], 1u);
            asm volatile("s_waitcnt vmcnt(0)" ::: "memory");
        } else {
            XB_SPIN(xb_ld(&bar[XB_XGEN(b.x)]) == gen, bar);
            __builtin_amdgcn_fence(__ATOMIC_ACQUIRE, "agent");
            asm volatile("s_waitcnt vmcnt(0)" ::: "memory");
        }
    }
    __syncthreads();
}

extern __shared__ __attribute__((aligned(16))) unsigned char dyn_smem[];

__global__ void __launch_bounds__(512, 2) mega_kernel(Params p) {
    cg::grid_group grid = cg::this_grid();
    volatile LAS unsigned* st = (volatile LAS unsigned*)(dyn_smem + 2 * LDS_BYTES);
    if (threadIdx.x == 0) { st[0] = 0u; st[1] = 0u; st[2] = 0u; st[3] = 0u; }
    __syncthreads();
    XcdBarrier xb = xcd_barrier_post((unsigned*)(p.ws + WS_BAR), st);
    const int nsteps = p.ph_hi;
    const bool single = (p.ph_hi - p.ph_lo) == 1;
    for (int step = p.ph_lo; step < nsteps; ++step) {
        int ph, l;
        if (step == 0) { ph = PH_PRO; l = 0; }
        else { l = (step - 1) / 11; ph = PH_CONV + (step - 1) % 11; }
        if (ph == PH_CONV && l == 0) continue;
        run_phase(p, ph, l, dyn_smem);
#ifdef REPEAT_PH
        if (ph == REPEAT_PH) { xcd_barrier(xb); run_phase(p, ph, l, dyn_smem); }
#endif
        if (single) break;
        if (p.pad == 0x5eed) grid.sync();
        if (step + 1 < nsteps) xcd_barrier(xb);
    }
}

extern "C" void kernel_launch(void* const* d_in, const int* in_sizes, int n_in, void* d_out, int out_size, void* d_ws, size_t ws_size, hipStream_t stream) {
    static int grid = 0;
    if (grid == 0) {
        if (n_in != N_IN || ws_size < WS_END + 256 || out_size != T_TOK * DM) { fprintf(stderr, "kernel_launch: unexpected sizes n_in %d ws %zu (need %zu) out %d\n", n_in, ws_size, (size_t)WS_END, out_size); grid = -1; return; }
        int dev = 0, cus = 0, per_cu = 0;
        (void)hipGetDevice(&dev);
        (void)hipDeviceGetAttribute(&cus, hipDeviceAttributeMultiprocessorCount, dev);
        (void)hipFuncSetAttribute((const void*)mega_kernel, hipFuncAttributeMaxDynamicSharedMemorySize, LDS_ALLOC);
        (void)hipOccupancyMaxActiveBlocksPerMultiprocessor(&per_cu, (const void*)mega_kernel, 512, LDS_ALLOC);
        if (per_cu < 1) fprintf(stderr, "kernel_launch: occupancy query says %d blocks per CU\n", per_cu);
        grid = cus;
        (void)hipGetLastError();
    }
    if (grid < 0) return;
    Params p{};
    for (int i = 0; i < N_IN; ++i) p.in[i] = (const float*)d_in[i];
    p.out = (float*)d_out; p.ws = (unsigned char*)d_ws;
    (void)hipMemsetAsync((unsigned char*)d_ws + WS_BAR, 0, XCD_BAR_WORDS * 4, stream);
    p.ph_lo = 0; p.ph_hi = 1 + NL * 11;
    void* args[] = {&p};
    hipError_t e = hipLaunchCooperativeKernel((const void*)mega_kernel, dim3(grid), dim3(512), args, LDS_ALLOC, stream);
    if (e != hipSuccess) fprintf(stderr, "cooperative launch failed: %s (grid %d)\n", hipGetErrorString(e), grid);
}
```
